# Optimizing an MI355X kernel written in HIP

```python
import math
import jax, jax.numpy as jnp
from jax import lax
import numpy as np

D_MODEL = 1024
BATCH = 4
SEQ = 4096
DEPTH = 2
DEC_BATCH = 8
DEC_SEQ = 4096
PAST_LEN = 128

N_META = 16
N_MIXERS = 2
N_GDN_LAYERS = (DEPTH + 1) // 2
N_MLA_LAYERS = DEPTH // 2
NORM_EPS = 1e-6

GDN_HEADS = 8
GDN_DK = 128
GDN_DV = 256
GDN_CONV = 5
GDN_CHUNK = 64
GDN_QK_WIDTH = GDN_HEADS * GDN_DK
GDN_V_WIDTH = GDN_HEADS * GDN_DV
GDN_CONV_CH = 2 * GDN_QK_WIDTH + GDN_V_WIDTH
GDN_IN = GDN_CONV_CH + GDN_V_WIDTH + 4 * GDN_HEADS

MLA_HEADS = 16
MLA_Q_LORA = 512
MLA_KV_LORA = 256
MLA_NOPE = 128
MLA_ROPE = 64
MLA_DQK = MLA_NOPE + MLA_ROPE
MLA_DV = 128
MLA_V_WIDTH = MLA_HEADS * MLA_DV
MLA_IN = MLA_Q_LORA + MLA_KV_LORA + MLA_ROPE + MLA_V_WIDTH
ROPE_THETA = 10000.0
Q_BLOCK = 128

kernel_name = 'hybrid_gdn_mla_bidir_encoder'


def _rmsnorm(x, g):
    xf = x.astype(jnp.float32)
    y = xf * lax.rsqrt(jnp.mean(xf * xf, axis=-1, keepdims=True) + NORM_EPS)
    return (y * g.astype(jnp.float32)).astype(x.dtype)


def _l2norm(x):
    xf = x.astype(jnp.float32)
    return xf * lax.rsqrt(jnp.sum(xf * xf, axis=-1, keepdims=True) + NORM_EPS)


def _gated_delta_chunked(q, k, v, beta, g):
    B, T, H, DK = q.shape
    DV = v.shape[-1]
    C = GDN_CHUNK
    N = T // C

    def blk(t):
        t = jnp.moveaxis(t, 2, 1)
        return t.reshape((B, H, N, C) + t.shape[3:])

    q, k, v, beta, g = blk(q), blk(k), blk(v), blk(beta), blk(g)
    gc = jnp.cumsum(g, axis=-1)
    gl = gc[..., -1]
    diff = gc[..., :, None] - gc[..., None, :]
    idx = jnp.arange(C)
    strict = idx[:, None] > idx[None, :]
    incl = idx[:, None] >= idx[None, :]
    decay_strict = jnp.exp(jnp.where(strict, diff, -jnp.inf))
    decay_incl = jnp.exp(jnp.where(incl, diff, -jnp.inf))
    kb = k * beta[..., None]
    a = jnp.einsum('bhnid,bhnjd->bhnij', kb, k) * decay_strict + jnp.eye(C, dtype=q.dtype)
    rhs = jnp.concatenate([v * beta[..., None], kb * jnp.exp(gc)[..., None]], axis=-1)
    sol = lax.linalg.triangular_solve(a, rhs, left_side=True, lower=True, unit_diagonal=True)
    u, w = sol[..., :DV], sol[..., DV:]
    attn = jnp.einsum('bhnid,bhnjd->bhnij', q, k) * decay_incl
    qg = q * jnp.exp(gc)[..., None]
    kd = k * jnp.exp(gl[..., None] - gc)[..., None]

    def step(S, inp):
        qg_c, w_c, u_c, kd_c, attn_c, gl_c = inp
        v_new = u_c - jnp.einsum('bhcd,bhde->bhce', w_c, S)
        o = jnp.einsum('bhcd,bhde->bhce', qg_c, S) + jnp.einsum('bhij,bhje->bhie', attn_c, v_new)
        S = S * jnp.exp(gl_c)[..., None, None] + jnp.einsum('bhcd,bhce->bhde', kd_c, v_new)
        return S, o

    xs = (jnp.moveaxis(qg, 2, 0), jnp.moveaxis(w, 2, 0), jnp.moveaxis(u, 2, 0),
          jnp.moveaxis(kd, 2, 0), jnp.moveaxis(attn, 2, 0), jnp.moveaxis(gl, 2, 0))
    S0 = jnp.zeros((B, H, DK, DV), q.dtype)
    _, o = lax.scan(step, S0, xs)
    o = jnp.moveaxis(o, 0, 2).reshape(B, H, T, DV)
    return jnp.moveaxis(o, 1, 2)


def _pad_seq(t, front, back):
    return jnp.pad(t, ((0, 0), (front, back)) + ((0, 0),) * (t.ndim - 2))


def _bidir_gated_delta(q, k, v, beta, g):
    L = q.shape[1]
    P = (-N_META) % GDN_CHUNK
    fwd = _gated_delta_chunked(_pad_seq(q, P, 0), _pad_seq(k, P, 0), _pad_seq(v, P, 0),
                               _pad_seq(beta[:, :, 0], P, 0), _pad_seq(g[:, :, 0], P, 0))[:, P:]
    qr, kr, vr = jnp.flip(q, 1), jnp.flip(k, 1), jnp.flip(v, 1)
    br, grv = jnp.flip(beta[:, :, 1], 1), jnp.flip(g[:, :, 1], 1)
    bwd = _gated_delta_chunked(_pad_seq(qr, 0, P), _pad_seq(kr, 0, P), _pad_seq(vr, 0, P),
                               _pad_seq(br, 0, P), _pad_seq(grv, 0, P))[:, :L]
    return fwd + jnp.flip(bwd, 1)


def _gdn_mixer(h, w_in, conv_w, a_log, dt_bias, o_norm_g, w_out):
    B, L, _ = h.shape
    proj = h @ w_in
    qkv = proj[..., :GDN_CONV_CH]
    z = proj[..., GDN_CONV_CH:GDN_CONV_CH + GDN_V_WIDTH]
    ba = proj[..., GDN_CONV_CH + GDN_V_WIDTH:].reshape(B, L, 2, 2, GDN_HEADS)
    half = GDN_CONV // 2
    qkv_p = jnp.pad(qkv, ((0, 0), (half, half), (0, 0)))
    conv = qkv_p[:, 0:L] * conv_w[0]
    for j in range(1, GDN_CONV):
        conv = conv + qkv_p[:, j:j + L] * conv_w[j]
    qkv = jax.nn.silu(conv)
    q = _l2norm(qkv[..., :GDN_QK_WIDTH].reshape(B, L, GDN_HEADS, GDN_DK)) * (GDN_DK ** -0.5)
    k = _l2norm(qkv[..., GDN_QK_WIDTH:2 * GDN_QK_WIDTH].reshape(B, L, GDN_HEADS, GDN_DK))
    v = qkv[..., 2 * GDN_QK_WIDTH:].reshape(B, L, GDN_HEADS, GDN_DV).astype(jnp.float32)
    beta = jax.nn.sigmoid(ba[:, :, 0].astype(jnp.float32))
    g = -jnp.exp(a_log.astype(jnp.float32)) * jax.nn.softplus(
        ba[:, :, 1].astype(jnp.float32) + dt_bias.astype(jnp.float32))
    o = _bidir_gated_delta(q, k, v, beta, g)
    o = _rmsnorm(o, o_norm_g).astype(h.dtype)
    y = o.reshape(B, L, GDN_V_WIDTH) * jax.nn.silu(z)
    return y @ w_out


def _rope(x, cos, sin):
    r = x.shape[-1] // 2
    x1, x2 = x[..., :r], x[..., r:]
    return jnp.concatenate([x1 * cos - x2 * sin, x2 * cos + x1 * sin], axis=-1).astype(x.dtype)


def _block_attention(q, k, v):
    B, L, H, Dq = q.shape
    nb = -(-L // Q_BLOCK)
    qp = _pad_seq(q, 0, nb * Q_BLOCK - L)
    qb = jnp.moveaxis(qp.reshape(B, nb, Q_BLOCK, H, Dq), 1, 0)
    scale = Dq ** -0.5

    def one(qblk):
        s = jnp.einsum('bqhd,bkhd->bhqk', qblk, k, preferred_element_type=jnp.float32) * scale
        p = jax.nn.softmax(s, axis=-1)
        return jnp.einsum('bhqk,bkhd->bqhd', p.astype(v.dtype), v)

    o = lax.map(one, qb)
    return jnp.moveaxis(o, 0, 1).reshape(B, nb * Q_BLOCK, H, v.shape[-1])[:, :L]


def _mla_mixer(h, w_in, q_norm_g, kv_norm_g, w_uq, w_ukv, qk_q_g, qk_k_g, w_out):
    B, L, _ = h.shape
    proj = h @ w_in
    o1 = MLA_Q_LORA
    o2 = o1 + MLA_KV_LORA
    o3 = o2 + MLA_ROPE
    cq = _rmsnorm(proj[..., :o1], q_norm_g)
    ckv = _rmsnorm(proj[..., o1:o2], kv_norm_g)
    k_pe = proj[..., o2:o3]
    z = proj[..., o3:]
    q = (cq @ w_uq).reshape(B, L, MLA_HEADS, MLA_DQK)
    kv = (ckv @ w_ukv).reshape(B, L, MLA_HEADS, MLA_NOPE + MLA_DV)
    k_nope, v = kv[..., :MLA_NOPE], kv[..., MLA_NOPE:]
    k = jnp.concatenate([k_nope, jnp.broadcast_to(k_pe[:, :, None, :], (B, L, MLA_HEADS, MLA_ROPE))], axis=-1)
    q = _rmsnorm(q, qk_q_g)
    k = _rmsnorm(k, qk_k_g)
    pos = jnp.arange(L, dtype=jnp.float32)
    inv = ROPE_THETA ** (-jnp.arange(0, MLA_ROPE, 2, dtype=jnp.float32) / MLA_ROPE)
    ang = pos[:, None] * inv[None, :]
    cos = jnp.cos(ang)[:, None, :]
    sin = jnp.sin(ang)[:, None, :]
    q = jnp.concatenate([q[..., :MLA_NOPE], _rope(q[..., MLA_NOPE:], cos, sin)], axis=-1)
    k = jnp.concatenate([k[..., :MLA_NOPE], _rope(k[..., MLA_NOPE:], cos, sin)], axis=-1)
    o = _block_attention(q, k, v)
    y = o.reshape(B, L, MLA_V_WIDTH) * jax.nn.silu(z)
    return y @ w_out


def _trunk(x, meta_tokens, ln_g, gdn_w_in, gdn_conv_w, gdn_a_log, gdn_dt_bias, gdn_o_norm_g, gdn_w_out,
           mla_w_in, mla_q_norm_g, mla_kv_norm_g, mla_w_uq, mla_w_ukv, mla_qk_q_g, mla_qk_k_g, mla_w_out):
    B = x.shape[0]
    meta = jnp.broadcast_to(meta_tokens[None].astype(x.dtype), (B, N_META, D_MODEL))
    h = jnp.concatenate([meta, x], axis=1)
    for i in range(DEPTH):
        hn = _rmsnorm(h, ln_g[i])
        j = i // N_MIXERS
        if i % N_MIXERS == 0:
            out = _gdn_mixer(hn, gdn_w_in[j], gdn_conv_w[j], gdn_a_log[j], gdn_dt_bias[j],
                             gdn_o_norm_g[j], gdn_w_out[j])
        else:
            out = _mla_mixer(hn, mla_w_in[j], mla_q_norm_g[j], mla_kv_norm_g[j], mla_w_uq[j],
                             mla_w_ukv[j], mla_qk_q_g[j], mla_qk_k_g[j], mla_w_out[j])
        h = h + out
    return h[:, N_META:]


def setup_inputs(seed: int = 0) -> dict:
    key = jax.random.key(seed)
    ks = jax.random.split(key, 20)
    f32 = jnp.float32

    def nrm(k, shape, scale):
        return jax.random.normal(k, shape, f32) * scale

    def gain(k, shape):
        return 1.0 + 0.02 * jax.random.normal(k, shape, f32)

    dt = jnp.exp(jax.random.uniform(ks[6], (N_GDN_LAYERS, 2, GDN_HEADS), f32,
                                    math.log(0.001), math.log(0.1)))
    dt_bias = dt + jnp.log(-jnp.expm1(-dt))
    a_log = jnp.log(jax.random.uniform(ks[5], (N_GDN_LAYERS, 2, GDN_HEADS), f32, 1.0, 16.0))
    return {
        'x_prompt': nrm(ks[0], (BATCH, SEQ, D_MODEL), 1.0),
        'x_sample': nrm(ks[1], (DEC_BATCH, DEC_SEQ, D_MODEL), 1.0),
        'meta_tokens': nrm(ks[2], (N_META, D_MODEL), 1.0),
        'ln_g': gain(ks[3], (DEPTH, D_MODEL)),
        'gdn_w_in': nrm(ks[4], (N_GDN_LAYERS, D_MODEL, GDN_IN), D_MODEL ** -0.5),
        'gdn_conv_w': nrm(ks[7], (N_GDN_LAYERS, GDN_CONV, GDN_CONV_CH), GDN_CONV ** -0.5),
        'gdn_a_log': a_log,
        'gdn_dt_bias': dt_bias,
        'gdn_o_norm_g': gain(ks[8], (N_GDN_LAYERS, GDN_DV)),
        'gdn_w_out': nrm(ks[9], (N_GDN_LAYERS, GDN_V_WIDTH, D_MODEL), GDN_V_WIDTH ** -0.5),
        'mla_w_in': nrm(ks[10], (N_MLA_LAYERS, D_MODEL, MLA_IN), D_MODEL ** -0.5),
        'mla_q_norm_g': gain(ks[11], (N_MLA_LAYERS, MLA_Q_LORA)),
        'mla_kv_norm_g': gain(ks[12], (N_MLA_LAYERS, MLA_KV_LORA)),
        'mla_w_uq': nrm(ks[13], (N_MLA_LAYERS, MLA_Q_LORA, MLA_HEADS * MLA_DQK), MLA_Q_LORA ** -0.5),
        'mla_w_ukv': nrm(ks[14], (N_MLA_LAYERS, MLA_KV_LORA, MLA_HEADS * (MLA_NOPE + MLA_DV)), MLA_KV_LORA ** -0.5),
        'mla_qk_q_g': gain(ks[15], (N_MLA_LAYERS, MLA_DQK)),
        'mla_qk_k_g': gain(ks[16], (N_MLA_LAYERS, MLA_DQK)),
        'mla_w_out': nrm(ks[17], (N_MLA_LAYERS, MLA_V_WIDTH, D_MODEL), MLA_V_WIDTH ** -0.5),
    }


def reference(x_prompt, x_sample, meta_tokens, ln_g, gdn_w_in, gdn_conv_w, gdn_a_log, gdn_dt_bias,
              gdn_o_norm_g, gdn_w_out, mla_w_in, mla_q_norm_g, mla_kv_norm_g, mla_w_uq, mla_w_ukv,
              mla_qk_q_g, mla_qk_k_g, mla_w_out):
    y_prompt = _trunk(x_prompt, meta_tokens, ln_g, gdn_w_in, gdn_conv_w, gdn_a_log, gdn_dt_bias,
                      gdn_o_norm_g, gdn_w_out, mla_w_in, mla_q_norm_g, mla_kv_norm_g, mla_w_uq,
                      mla_w_ukv, mla_qk_q_g, mla_qk_k_g, mla_w_out)
    y_sample = _trunk(x_sample, meta_tokens, ln_g, gdn_w_in, gdn_conv_w, gdn_a_log, gdn_dt_bias,
                      gdn_o_norm_g, gdn_w_out, mla_w_in, mla_q_norm_g, mla_kv_norm_g, mla_w_uq,
                      mla_w_ukv, mla_qk_q_g, mla_qk_k_g, mla_w_out)
    return (y_prompt, y_sample)
```

```cpp
#include <hip/hip_runtime.h>
#include <hip/hip_cooperative_groups.h>
#include <cstdio>
#include <cstdint>
namespace cg = cooperative_groups;

typedef unsigned short u16;
typedef __bf16 bf2_t __attribute__((ext_vector_type(2)));
typedef float f2_t __attribute__((ext_vector_type(2)));
using bf16x8 = __attribute__((ext_vector_type(8))) short;
using s16x4  = __attribute__((ext_vector_type(4))) short;
using f32x16 = __attribute__((ext_vector_type(16))) float;
using f32x4  = __attribute__((ext_vector_type(4))) float;
using u32x4  = __attribute__((ext_vector_type(4))) unsigned;
using u32x2  = __attribute__((ext_vector_type(2))) unsigned;
#define DI __device__ __forceinline__
#define SBAR() __builtin_amdgcn_sched_barrier(0)

DI unsigned pk2(float a, float b) { f2_t v = {a, b}; bf2_t r = __builtin_convertvector(v, bf2_t); return __builtin_bit_cast(unsigned, r); }
DI u16 f2bf(float a) { return (u16)(pk2(a, 0.f) & 0xffffu); }
DI float bf2f(u16 v) { return __uint_as_float(((unsigned)v) << 16); }
DI float bflo(unsigned v) { return __uint_as_float(v << 16); }
DI float bfhi(unsigned v) { return __uint_as_float(v & 0xffff0000u); }
DI int otid() { int t = __builtin_amdgcn_workitem_id_x(); asm volatile("" : "+v"(t)); return t; }
DI int crow(int r, int hi) { return (r & 3) + 8 * (r >> 2) + 4 * hi; }
DI float wave_sum(float v) {
#pragma unroll
  for (int m = 32; m >= 1; m >>= 1) v += __shfl_xor(v, m, 64);
  return v;
}
DI float silu(float x) { return x / (1.f + __expf(-x)); }

constexpr int D = 1024, TP = 4160, GS = 4, GR = GS * TP, NGRP = 3, PADR = 48, SEQ = 4096;
constexpr int GIN = 6176, GINP = 6400, MIN_ = 2880, MINP = 2944;
constexpr float EPS = 1e-6f;
constexpr int NCHUNK = 65;

constexpr size_t al256(size_t x) { return (x + 255) / 256 * 256; }
constexpr size_t OFF_WGIN  = 0;
constexpr size_t OFF_WGOUT = OFF_WGIN  + al256((size_t)GINP * 1024 * 2);
constexpr size_t OFF_WMIN  = OFF_WGOUT + al256((size_t)1024 * 2048 * 2);
constexpr size_t OFF_WUQ   = OFF_WMIN  + al256((size_t)MINP * 1024 * 2);
constexpr size_t OFF_WUKV  = OFF_WUQ   + al256((size_t)3072 * 512 * 2);
constexpr size_t OFF_WMOUT = OFF_WUKV  + al256((size_t)4096 * 256 * 2);
constexpr size_t OFF_ROPE  = OFF_WMOUT + al256((size_t)1024 * 2048 * 2);
constexpr size_t OFF_H1M   = OFF_ROPE  + al256((size_t)4112 * 64 * 4);
constexpr size_t OFF_HN    = OFF_H1M   + al256((size_t)12 * 16 * 1024 * 4);
constexpr size_t OFF_Z     = OFF_HN    + al256((size_t)GR * 1024 * 2);
constexpr size_t OFF_R     = OFF_Z     + al256((size_t)GR * 2048 * 2);
constexpr size_t OFF_P     = OFF_R;
constexpr size_t OFF_HALO  = OFF_P     + al256((size_t)GR * 4096 * 2);
constexpr size_t OFF_BA    = OFF_HALO  + al256((size_t)(GR / 64) * 4 * 4096 * 2);
constexpr size_t OFF_BG    = OFF_BA    + al256((size_t)GR * 32 * 4);
constexpr size_t OFF_OF    = OFF_BG    + al256((size_t)GR * 32 * 4);
constexpr size_t OFF_OB    = OFF_OF    + al256((size_t)GR * 2048 * 2);
constexpr size_t END_GDN   = OFF_OB    + al256((size_t)GR * 2048 * 2);
constexpr size_t OFF_CQ    = OFF_R;
constexpr size_t OFF_CKV   = OFF_CQ    + al256((size_t)GR * 512 * 2);
constexpr size_t OFF_KPE   = OFF_CKV   + al256((size_t)GR * 256 * 2);
constexpr size_t OFF_ROWST = OFF_KPE   + al256((size_t)GR * 64 * 4);
constexpr size_t OFF_KPER  = OFF_ROWST + al256((size_t)GR * 4 * 4);
constexpr size_t OFF_QM    = OFF_KPER  + al256((size_t)GR * 64 * 4);
constexpr size_t OFF_KM    = OFF_QM    + al256((size_t)GR * 16 * 192 * 2);
constexpr size_t OFF_VM    = OFF_KM    + al256((size_t)GR * 16 * 192 * 2);
constexpr size_t OFF_Y     = OFF_VM    + al256((size_t)GR * 16 * 128 * 2);
constexpr size_t END_MLA   = OFF_Y     + al256((size_t)GR * 2048 * 2);
constexpr size_t WS_NEED   = END_MLA > END_GDN ? END_MLA : END_GDN;

constexpr int LDS_BYTES = 160 * 1024;

struct Params {
  const float *xp, *xs, *meta, *ln_g, *g_win, *g_conv, *g_alog, *g_dtb, *g_onorm, *g_wout;
  const float *m_win, *m_qn, *m_kvn, *m_wuq, *m_wukv, *m_qg, *m_kg, *m_wout;
  float* out; char* ws;
};

DI const float* h0_row(const Params& p, int sg, int pos) {
  return pos < 16 ? p.meta + (long)pos * D
                  : (sg < 4 ? p.xp + ((long)sg * SEQ + pos - 16) * D : p.xs + ((long)(sg - 4) * SEQ + pos - 16) * D);
}

DI void transpose_cvt(const float* __restrict__ src, u16* __restrict__ dst, int K, int N, int Npad,
                      const float* __restrict__ gain, int gmod, float* lds) {
  const int tid = otid();
  const int tK = K / 64, tN = Npad / 64;
  for (int tile = blockIdx.x; tile < tK * tN; tile += gridDim.x) {
    const int tk = tile % tK, tn = tile / tK;
#pragma unroll
    for (int i = 0; i < 2; ++i) {
      int kk = (tid >> 4) + 32 * i, nn = (tid & 15) * 4;
      int k = tk * 64 + kk, n = tn * 64 + nn;
      float4 v = make_float4(0.f, 0.f, 0.f, 0.f);
      if (n < N) v = *(const float4*)(src + (long)k * N + n);
      float gsc = gain ? gain[k % gmod] : 1.f;
      lds[kk * 65 + nn + 0] = v.x * gsc; lds[kk * 65 + nn + 1] = v.y * gsc;
      lds[kk * 65 + nn + 2] = v.z * gsc; lds[kk * 65 + nn + 3] = v.w * gsc;
    }
    __syncthreads();
    {
      int n = tid >> 3, k8 = (tid & 7) * 8;
      float f[8];
#pragma unroll
      for (int j = 0; j < 8; ++j) f[j] = lds[(k8 + j) * 65 + n];
      u32x4 w = {pk2(f[0], f[1]), pk2(f[2], f[3]), pk2(f[4], f[5]), pk2(f[6], f[7])};
      *(u32x4*)(dst + (long)(tn * 64 + n) * K + tk * 64 + k8) = w;
    }
    __syncthreads();
  }
}

DI void phase_prep(const Params& p, char* lds) {
  float* l = (float*)lds;
  transpose_cvt(p.g_win, (u16*)(p.ws + OFF_WGIN), 1024, GIN, GINP, p.ln_g, 1024, l);
  transpose_cvt(p.g_wout, (u16*)(p.ws + OFF_WGOUT), 2048, 1024, 1024, p.g_onorm, 256, l);
  transpose_cvt(p.m_win, (u16*)(p.ws + OFF_WMIN), 1024, MIN_, MINP, p.ln_g + 1024, 1024, l);
  transpose_cvt(p.m_wuq, (u16*)(p.ws + OFF_WUQ), 512, 3072, 3072, p.m_qn, 512, l);
  transpose_cvt(p.m_wukv, (u16*)(p.ws + OFF_WUKV), 256, 4096, 4096, p.m_kvn, 256, l);
  transpose_cvt(p.m_wout, (u16*)(p.ws + OFF_WMOUT), 2048, 1024, 1024, nullptr, 1, l);
  float* rope = (float*)(p.ws + OFF_ROPE);
  for (int i = blockIdx.x * 512 + otid(); i < 4112 * 32; i += gridDim.x * 512) {
    int pos = i >> 5, j = i & 31;
    float inv = __builtin_amdgcn_exp2f(-(float)j * (13.287712379549449f / 32.f));
    float ang = (float)pos * inv;
    float n = rintf(ang * 0.15915494309189535f);
    float rr = fmaf(-n, 6.28318548202514648f, ang); rr = fmaf(-n, -1.7484555e-7f, rr);
    float s = __sinf(rr), c = __cosf(rr);
    rope[pos * 64 + j] = c; rope[pos * 64 + 32 + j] = s;
  }
}

DI void phase_hn(const Params& p, int g, int layer) {
  const int lane = otid() & 63, wv = otid() >> 6;
  u16* HN = (u16*)(p.ws + OFF_HN);
  const float* h1m = (const float*)(p.ws + OFF_H1M);
  for (int row = blockIdx.x * 8 + wv; row < GR; row += gridDim.x * 8) {
    int seq = row / TP, r = row % TP, pos = r - PADR, sg = g * GS + seq;
    u16* dst = HN + (long)row * D;
    if (pos < 0) {
      u32x2 z = {0u, 0u};
#pragma unroll
      for (int i = 0; i < 4; ++i) *(u32x2*)(dst + i * 256 + lane * 4) = z;
      continue;
    }
    const float* src;
    if (layer == 0) src = h0_row(p, sg, pos);
    else src = pos < 16 ? h1m + ((long)sg * 16 + pos) * D : p.out + ((long)sg * SEQ + pos - 16) * D;
    float4 v[4]; float ss = 0.f;
#pragma unroll
    for (int i = 0; i < 4; ++i) { v[i] = *(const float4*)(src + i * 256 + lane * 4); ss += v[i].x * v[i].x + v[i].y * v[i].y + v[i].z * v[i].z + v[i].w * v[i].w; }
    ss = wave_sum(ss);
    float rs = rsqrtf(ss * (1.f / 1024.f) + EPS);
#pragma unroll
    for (int i = 0; i < 4; ++i) { u32x2 w = {pk2(v[i].x * rs, v[i].y * rs), pk2(v[i].z * rs, v[i].w * rs)}; *(u32x2*)(dst + i * 256 + lane * 4) = w; }
  }
}

template <int WM, int WN, int MT, int NT, class Epi>
DI void gemm_tile(const u16* __restrict__ A, int lda, const u16* __restrict__ Bt, int ldb, int K, int m0, int n0, char* lds, const Epi& epi) {
  constexpr int BM = WM * MT * 32, BN = WN * NT * 32, NA = BM * 8 / 512, NB = BN * 8 / 512;
  static_assert(WM * WN == 8, "8 waves");
  const int tid = otid(), lane = tid & 63, wid = tid >> 6, r32 = lane & 31, hi = lane >> 5;
  const int wm = wid / WN, wn = wid % WN;
  char* As = lds; char* Bs = lds + 2 * BM * 128;
  f32x16 acc[MT][NT];
#pragma unroll
  for (int a = 0; a < MT; ++a)
#pragma unroll
    for (int b = 0; b < NT; ++b)
#pragma unroll
      for (int r = 0; r < 16; ++r) acc[a][b][r] = 0.f;
  u32x4 ra[NA], rb[NB];
  const int nk = K / 64;
#define GLOAD(kt) do { _Pragma("unroll") for (int i = 0; i < NA; ++i) { int q = tid + 512 * i; int row = q >> 3, c = q & 7; \
      ra[i] = *(const u32x4*)(A + (long)(m0 + row) * lda + (kt) * 64 + c * 8); } \
    _Pragma("unroll") for (int i = 0; i < NB; ++i) { int q = tid + 512 * i; int row = q >> 3, c = q & 7; \
      rb[i] = *(const u32x4*)(Bt + (long)(n0 + row) * ldb + (kt) * 64 + c * 8); } } while (0)
#define SWRITE(buf) do { _Pragma("unroll") for (int i = 0; i < NA; ++i) { int q = tid + 512 * i; int row = q >> 3, c = q & 7; \
      *(u32x4*)(As + (buf) * BM * 128 + row * 128 + ((c ^ (row & 7)) << 4)) = ra[i]; } \
    _Pragma("unroll") for (int i = 0; i < NB; ++i) { int q = tid + 512 * i; int row = q >> 3, c = q & 7; \
      *(u32x4*)(Bs + (buf) * BN * 128 + row * 128 + ((c ^ (row & 7)) << 4)) = rb[i]; } } while (0)
  GLOAD(0); SWRITE(0); if (nk > 1) GLOAD(1);
  __syncthreads();
  for (int kt = 0; kt < nk; ++kt) {
    const int cur = kt & 1;
#pragma unroll
    for (int ks = 0; ks < 4; ++ks) {
      bf16x8 af[MT], bfr[NT];
      const int c = ks * 2 + hi;
#pragma unroll
      for (int a = 0; a < MT; ++a) { int row = (wm * MT + a) * 32 + r32; af[a] = *(const bf16x8*)(As + cur * BM * 128 + row * 128 + ((c ^ (row & 7)) << 4)); }
#pragma unroll
      for (int b = 0; b < NT; ++b) { int row = (wn * NT + b) * 32 + r32; bfr[b] = *(const bf16x8*)(Bs + cur * BN * 128 + row * 128 + ((c ^ (row & 7)) << 4)); }
#pragma unroll
      for (int a = 0; a < MT; ++a)
#pragma unroll
        for (int b = 0; b < NT; ++b) acc[a][b] = __builtin_amdgcn_mfma_f32_32x32x16_bf16(af[a], bfr[b], acc[a][b], 0, 0, 0);
    }
    if (kt + 1 < nk) { SWRITE(cur ^ 1); if (kt + 2 < nk) GLOAD(kt + 2); }
    __syncthreads();
  }
#undef GLOAD
#undef SWRITE
  epi(acc, m0 + wm * MT * 32, n0 + wn * NT * 32, lane);
}

struct EpiGin { u16 *P, *HALO, *Z; float* BA;
  DI void operator()(f32x16 (&acc)[2][2], int m0, int n0, int lane) const {
    const int r32 = lane & 31, hi = lane >> 5;
#pragma unroll
    for (int a = 0; a < 2; ++a)
#pragma unroll
      for (int b = 0; b < 2; ++b) {
        const int col = n0 + b * 32 + r32;
#pragma unroll
        for (int r = 0; r < 16; ++r) {
          const int row = m0 + a * 32 + crow(r, hi); const float v = acc[a][b][r];
          if (col < 4096) { u16 bv = f2bf(v); P[(long)row * 4096 + col] = bv; int rm = row & 63;
            if (rm < 2 || rm >= 62) HALO[((long)(row >> 6) * 4 + (rm < 2 ? rm : rm - 60)) * 4096 + col] = bv; }
          else if (col < 6144) Z[(long)row * 2048 + col - 4096] = f2bf(v);
          else if (col < GIN) BA[(long)row * 32 + col - 6144] = v;
        }
      }
  } };

struct EpiGout { Params p; int g; float* h1m;
  DI void operator()(f32x16 (&acc)[2][2], int m0, int n0, int lane) const {
    const int r32 = lane & 31, hi = lane >> 5;
#pragma unroll
    for (int a = 0; a < 2; ++a)
#pragma unroll
      for (int r = 0; r < 16; ++r) {
        const int row = m0 + a * 32 + crow(r, hi);
        const int seq = row / TP, rr = row % TP, pos = rr - PADR, sg = g * GS + seq;
        if (pos < 0) continue;
        const float* h0 = h0_row(p, sg, pos);
        float* dst = pos < 16 ? h1m + ((long)sg * 16 + pos) * D : p.out + ((long)sg * SEQ + pos - 16) * D;
#pragma unroll
        for (int b = 0; b < 2; ++b) { const int col = n0 + b * 32 + r32; dst[col] = h0[col] + acc[a][b][r]; }
      }
  } };

struct EpiMin { u16 *CQ, *CKV, *Z; float* KPE;
  DI void operator()(f32x16 (&acc)[2][2], int m0, int n0, int lane) const {
    const int r32 = lane & 31, hi = lane >> 5;
#pragma unroll
    for (int a = 0; a < 2; ++a)
#pragma unroll
      for (int b = 0; b < 2; ++b) {
        const int col = n0 + b * 32 + r32;
#pragma unroll
        for (int r = 0; r < 16; ++r) {
          const int row = m0 + a * 32 + crow(r, hi); const float v = acc[a][b][r];
          if (col < 512) CQ[(long)row * 512 + col] = f2bf(v);
          else if (col < 768) CKV[(long)row * 256 + col - 512] = f2bf(v);
          else if (col < 832) KPE[(long)row * 64 + col - 768] = v;
          else if (col < MIN_) Z[(long)row * 2048 + col - 832] = f2bf(v);
        }
      }
  } };

struct EpiQ { const float *rowst, *gq, *rope; u16* Q;
  DI void operator()(f32x16 (&acc)[1][6], int m0, int n0, int lane) const {
    const int r32 = lane & 31, hi = lane >> 5, head = n0 / 192;
    float ss[16];
#pragma unroll
    for (int r = 0; r < 16; ++r) {
      const int row = m0 + crow(r, hi); const float rq = rowst[row * 4 + 0]; float s = 0.f;
#pragma unroll
      for (int b = 0; b < 6; ++b) { acc[0][b][r] *= rq; s += acc[0][b][r] * acc[0][b][r]; }
      ss[r] = s;
    }
#pragma unroll
    for (int r = 0; r < 16; ++r) {
#pragma unroll
      for (int m = 16; m >= 1; m >>= 1) ss[r] += __shfl_xor(ss[r], m, 64);
    }
    float gc[6];
#pragma unroll
    for (int b = 0; b < 6; ++b) gc[b] = gq[b * 32 + r32];
#pragma unroll
    for (int r = 0; r < 16; ++r) {
      const int row = m0 + crow(r, hi); const int seq = row / TP, rr = row % TP; int pos = rr - PADR; pos = pos < 0 ? 0 : pos;
      const float rs = rsqrtf(ss[r] * (1.f / 192.f) + EPS);
      const float c = rope[pos * 64 + r32], s = rope[pos * 64 + 32 + r32];
      float x[6];
#pragma unroll
      for (int b = 0; b < 6; ++b) x[b] = acc[0][b][r] * rs * gc[b];
      const float x1 = x[4] * c - x[5] * s, x2 = x[5] * c + x[4] * s; x[4] = x1; x[5] = x2;
      u16* dst = Q + ((long)(seq * 16 + head) * TP + rr) * 192;
#pragma unroll
      for (int b = 0; b < 6; ++b) dst[b * 32 + r32] = f2bf(x[b]);
    }
  } };

struct EpiKV { const float *rowst, *gk, *kper; u16 *Kd, *Vd;
  DI void operator()(f32x16 (&acc)[1][4], int m0, int n0, int lane) const {
    const int r32 = lane & 31, hi = lane >> 5, head = n0 >> 8, isv = (n0 >> 7) & 1;
    if (isv) {
#pragma unroll
      for (int r = 0; r < 16; ++r) {
        const int row = m0 + crow(r, hi); const int seq = row / TP, rr = row % TP; const float rk = rowst[row * 4 + 1];
        u16* vd = Vd + ((long)(seq * 16 + head) * TP + rr) * 128;
#pragma unroll
        for (int b = 0; b < 4; ++b) vd[b * 32 + r32] = f2bf(acc[0][b][r] * rk);
      }
      return;
    }
    float ss[16];
#pragma unroll
    for (int r = 0; r < 16; ++r) {
      const int row = m0 + crow(r, hi); const float rk = rowst[row * 4 + 1]; float s = 0.f;
#pragma unroll
      for (int b = 0; b < 4; ++b) { acc[0][b][r] *= rk; s += acc[0][b][r] * acc[0][b][r]; }
      ss[r] = s;
    }
#pragma unroll
    for (int r = 0; r < 16; ++r) {
#pragma unroll
      for (int m = 16; m >= 1; m >>= 1) ss[r] += __shfl_xor(ss[r], m, 64);
    }
    float gc[4];
#pragma unroll
    for (int b = 0; b < 4; ++b) gc[b] = gk[b * 32 + r32];
#pragma unroll
    for (int r = 0; r < 16; ++r) {
      const int row = m0 + crow(r, hi); const int seq = row / TP, rr = row % TP;
      const float rs = rsqrtf((ss[r] + rowst[row * 4 + 2]) * (1.f / 192.f) + EPS);
      u16* kd = Kd + ((long)(seq * 16 + head) * TP + rr) * 192;
#pragma unroll
      for (int b = 0; b < 4; ++b) kd[b * 32 + r32] = f2bf(acc[0][b][r] * rs * gc[b]);
      kd[128 + r32] = f2bf(kper[(long)row * 64 + r32] * rs);
      kd[160 + r32] = f2bf(kper[(long)row * 64 + 32 + r32] * rs);
    }
  } };

struct EpiMout { float* out; int g;
  DI void operator()(f32x16 (&acc)[2][2], int m0, int n0, int lane) const {
    const int r32 = lane & 31, hi = lane >> 5;
#pragma unroll
    for (int a = 0; a < 2; ++a)
#pragma unroll
      for (int r = 0; r < 16; ++r) {
        const int row = m0 + a * 32 + crow(r, hi);
        const int seq = row / TP, rr = row % TP, pos = rr - PADR, sg = g * GS + seq;
        if (pos < 16) continue;
        float* dst = out + ((long)sg * SEQ + pos - 16) * D;
#pragma unroll
        for (int b = 0; b < 2; ++b) { const int col = n0 + b * 32 + r32; dst[col] += acc[a][b][r]; }
      }
  } };

template <int WM, int WN, int MT, int NT, class Epi>
DI void gemm_phase(const u16* A, int lda, const u16* Bt, int ldb, int K, int Npad, char* lds, const Epi& epi) {
  constexpr int BM = WM * MT * 32, BN = WN * NT * 32;
  const int nM = GR / BM, nN = Npad / BN;
  for (int t = blockIdx.x; t < nM * nN; t += gridDim.x) {
    const int tm = t % nM, tn = t / nM;
    gemm_tile<WM, WN, MT, NT, Epi>(A, lda, Bt, ldb, K, tm * BM, tn * BN, lds, epi);
  }
}

DI void phase_conv(const Params& p, char* lds) {
  u16* P = (u16*)(p.ws + OFF_P); const u16* HALO = (const u16*)(p.ws + OFF_HALO);
  const float* BA = (const float*)(p.ws + OFF_BA); float* BG = (float*)(p.ws + OFF_BG);
  const int tid = otid(), cp = tid & 255, rh = tid >> 8, part = (tid >> 6) & 3;
  const int ch = cp * 2;
  for (int item = blockIdx.x; item < GS * 8 * NCHUNK; item += gridDim.x) {
    const int chunk = item % NCHUNK, h = (item / NCHUNK) % 8, seq = item / (NCHUNK * 8);
    const int col = ch < 128 ? h * 128 + ch : (ch < 256 ? 1024 + h * 128 + (ch - 128) : 2048 + h * 256 + (ch - 256));
    const int R0 = seq * TP + chunk * 64, cg_ = seq * NCHUNK + chunk;
    float w0[5], w1[5];
#pragma unroll
    for (int j = 0; j < 5; ++j) { w0[j] = p.g_conv[j * 4096 + col]; w1[j] = p.g_conv[j * 4096 + col + 1]; }
    unsigned x[36];
#pragma unroll
    for (int i = 0; i < 36; ++i) {
      const int rr = rh * 32 + i - 2;
      unsigned v = 0u;
      if (rr >= 0 && rr < 64) v = *(const unsigned*)(P + (long)(R0 + rr) * 4096 + col);
      else if (rr < 0) { if (cg_ > 0) v = *(const unsigned*)(HALO + ((long)(cg_ - 1) * 4 + 2 + (rr + 2)) * 4096 + col); }
      else { if (cg_ + 1 < GS * NCHUNK) v = *(const unsigned*)(HALO + ((long)(cg_ + 1) * 4 + (rr - 64)) * 4096 + col); }
      x[i] = v;
    }
    unsigned outv[32];
#pragma unroll
    for (int o = 0; o < 32; ++o) {
      float a0 = 0.f, a1 = 0.f;
#pragma unroll
      for (int j = 0; j < 5; ++j) { a0 += w0[j] * bflo(x[o + j]); a1 += w1[j] * bfhi(x[o + j]); }
      a0 = silu(a0); a1 = silu(a1);
      if (part < 2) {
        float ss = wave_sum(a0 * a0 + a1 * a1);
        float sc = rsqrtf(ss + EPS) * (part == 0 ? 0.08838834764831845f : 1.f);
        a0 *= sc; a1 *= sc;
      }
      const int row = rh * 32 + o;
      if (chunk == 0 && row < PADR) { a0 = 0.f; a1 = 0.f; }
      outv[o] = pk2(a0, a1);
    }
    __syncthreads();
#pragma unroll
    for (int o = 0; o < 32; ++o) *(unsigned*)(P + (long)(R0 + rh * 32 + o) * 4096 + col) = outv[o];
    if (tid < 128) {
      const int r = tid & 63, dir = tid >> 6; const long row = R0 + r;
      const float b = BA[row * 32 + dir * 8 + h], a = BA[row * 32 + 16 + dir * 8 + h];
      float beta = 1.f / (1.f + __expf(-b));
      float xx = a + p.g_dtb[dir * 8 + h];
      float sp = xx > 20.f ? xx : __logf(1.f + __expf(xx));
      float gg = -__expf(p.g_alog[dir * 8 + h]) * sp;
      if (chunk == 0 && r < PADR) { beta = 0.f; gg = 0.f; }
      BG[(row * 2 + dir) * 16 + h * 2 + 0] = beta; BG[(row * 2 + dir) * 16 + h * 2 + 1] = gg;
    }
  }
}

DI void phase_scan_naive(const Params& p, char* lds) {
  const u16* P = (const u16*)(p.ws + OFF_P); const float* BG = (const float*)(p.ws + OFF_BG);
  u16* qs = (u16*)lds;
  u16* ks = qs + 64 * 128;
  u16* vs = ks + 64 * 128;
  float* sc = (float*)(vs + 64 * 128);
  const int tid = otid(), col = tid >> 2, qd = tid & 3;
  for (int item = blockIdx.x; item < GS * 8 * 4; item += gridDim.x) {
    const int dir = item & 1, dvh = (item >> 1) & 1, h = (item >> 2) & 7, seq = item >> 5;
    u16* O = (u16*)(p.ws + (dir ? OFF_OB : OFF_OF));
    float S[32];
#pragma unroll
    for (int i = 0; i < 32; ++i) S[i] = 0.f;
#pragma unroll 1
    for (int c = 0; c < NCHUNK; ++c) {
      const int cc = dir ? NCHUNK - 1 - c : c; const long R0 = (long)seq * TP + cc * 64;
      __syncthreads();
#pragma unroll
      for (int i = 0; i < 2; ++i) {
        const int e = tid + 512 * i, row = e >> 4, c8 = (e & 15) * 8, t = dir ? 63 - row : row;
        *(u32x4*)(qs + t * 128 + c8) = *(const u32x4*)(P + (R0 + row) * 4096 + h * 128 + c8);
        *(u32x4*)(ks + t * 128 + c8) = *(const u32x4*)(P + (R0 + row) * 4096 + 1024 + h * 128 + c8);
        *(u32x4*)(vs + t * 128 + c8) = *(const u32x4*)(P + (R0 + row) * 4096 + 2048 + h * 256 + dvh * 128 + c8);
      }
      if (tid < 64) { const int row = tid, t = dir ? 63 - row : row;
        sc[t * 2 + 0] = BG[((R0 + row) * 2 + dir) * 16 + h * 2 + 0];
        sc[t * 2 + 1] = __expf(BG[((R0 + row) * 2 + dir) * 16 + h * 2 + 1]); }
      __syncthreads();
#pragma unroll 1
      for (int t = 0; t < 64; ++t) {
        const int row = dir ? 63 - t : t;
        const float v = bf2f(vs[t * 128 + col]);
        const float beta = sc[t * 2], eg = sc[t * 2 + 1];
        const u32x4* kk = (const u32x4*)(ks + t * 128 + qd * 32);
        const u32x4* qq = (const u32x4*)(qs + t * 128 + qd * 32);
        float kS = 0.f;
#pragma unroll
        for (int i = 0; i < 4; ++i) { u32x4 k4 = kk[i];
#pragma unroll
          for (int j = 0; j < 4; ++j) { S[i * 8 + 2 * j] *= eg; S[i * 8 + 2 * j + 1] *= eg;
            kS += bflo(k4[j]) * S[i * 8 + 2 * j] + bfhi(k4[j]) * S[i * 8 + 2 * j + 1]; } }
        kS += __shfl_xor(kS, 1, 64); kS += __shfl_xor(kS, 2, 64);
        const float u = beta * (v - kS);
        float o = 0.f;
#pragma unroll
        for (int i = 0; i < 4; ++i) { u32x4 k4 = kk[i]; u32x4 q4 = qq[i];
#pragma unroll
          for (int j = 0; j < 4; ++j) { S[i * 8 + 2 * j] += bflo(k4[j]) * u; S[i * 8 + 2 * j + 1] += bfhi(k4[j]) * u;
            o += bflo(q4[j]) * S[i * 8 + 2 * j] + bfhi(q4[j]) * S[i * 8 + 2 * j + 1]; } }
        o += __shfl_xor(o, 1, 64); o += __shfl_xor(o, 2, 64);
        if (qd == 0) O[(R0 + row) * 2048 + h * 256 + dvh * 128 + col] = f2bf(o);
      }
    }
  }
}

DI void phase_gate(const Params& p) {
  u16* OFp = (u16*)(p.ws + OFF_OF); const u16* OBp = (const u16*)(p.ws + OFF_OB); const u16* Z = (const u16*)(p.ws + OFF_Z);
  const int lane = otid() & 63, wv = otid() >> 6;
  for (int it = blockIdx.x * 8 + wv; it < GR * 8; it += gridDim.x * 8) {
    const long off = (long)it * 256 + lane * 4;
    u32x2 a = *(const u32x2*)(OFp + off), b = *(const u32x2*)(OBp + off), z = *(const u32x2*)(Z + off);
    float o0 = bflo(a[0]) + bflo(b[0]), o1 = bfhi(a[0]) + bfhi(b[0]), o2 = bflo(a[1]) + bflo(b[1]), o3 = bfhi(a[1]) + bfhi(b[1]);
    float ss = wave_sum(o0 * o0 + o1 * o1 + o2 * o2 + o3 * o3);
    float rs = rsqrtf(ss * (1.f / 256.f) + EPS);
    u32x2 w = {pk2(o0 * rs * silu(bflo(z[0])), o1 * rs * silu(bfhi(z[0]))), pk2(o2 * rs * silu(bflo(z[1])), o3 * rs * silu(bfhi(z[1])))};
    *(u32x2*)(OFp + off) = w;
  }
}

DI void phase_rowstats(const Params& p) {
  const u16* CQ = (const u16*)(p.ws + OFF_CQ); const u16* CKV = (const u16*)(p.ws + OFF_CKV); const float* KPE = (const float*)(p.ws + OFF_KPE);
  float* rowst = (float*)(p.ws + OFF_ROWST); float* kper = (float*)(p.ws + OFF_KPER); const float* rope = (const float*)(p.ws + OFF_ROPE);
  const int lane = otid() & 63, wv = otid() >> 6;
  for (int row = blockIdx.x * 8 + wv; row < GR; row += gridDim.x * 8) {
    u32x4 q = *(const u32x4*)(CQ + (long)row * 512 + lane * 8);
    float sq = 0.f;
#pragma unroll
    for (int j = 0; j < 4; ++j) { float a = bflo(q[j]), b = bfhi(q[j]); sq += a * a + b * b; }
    u32x2 kv = *(const u32x2*)(CKV + (long)row * 256 + lane * 4);
    float sk = 0.f;
#pragma unroll
    for (int j = 0; j < 2; ++j) { float a = bflo(kv[j]), b = bfhi(kv[j]); sk += a * a + b * b; }
    const float kp = KPE[(long)row * 64 + lane];
    sq = wave_sum(sq); sk = wave_sum(sk); const float sp = wave_sum(kp * kp);
    const float val = kp * p.m_kg[128 + lane];
    const float oth = __shfl_xor(val, 32, 64);
    int pos = row % TP - PADR; pos = pos < 0 ? 0 : pos;
    const int i = lane & 31; const float c = rope[pos * 64 + i], s = rope[pos * 64 + 32 + i];
    kper[(long)row * 64 + lane] = lane < 32 ? val * c - oth * s : val * c + oth * s;
    if (lane == 0) { f32x4 st = {rsqrtf(sq * (1.f / 512.f) + EPS), rsqrtf(sk * (1.f / 256.f) + EPS), sp, 0.f}; *(f32x4*)(rowst + (long)row * 4) = st; }
  }
}

constexpr float ATT_SCALE = 0.07216878364870322f;
constexpr float ATT_THR = 8.f;
constexpr int SHM_V = 64 * 128 * 2, SHM_K = 64 * 192 * 2;
DI int v_st(int k, int c) { const int kk = (k & ~0xC) | ((k & 4) << 1) | ((k & 8) >> 1); return ((kk >> 3) * 4 + (c >> 5)) * 512 + ((kk & 7) * 32 + (c & 31)) * 2; }
DI int v_rd_base(int lane) { return ((lane & 3) << 3) | (((lane >> 2) & 3) << 6) | (((lane >> 4) & 1) << 5) | (((lane >> 5) & 1) << 8); }
constexpr int v_rd_off(int d0, int ks, int half) { return d0 * 512 + ks * 4096 + half * 2048; }
template <int OFF> DI s16x4 tr_read(int vb) {
  s16x4 r; asm volatile("ds_read_b64_tr_b16 %0, %1 offset:%2" : "=&v"(r) : "v"(vb), "i"(OFF) : "memory"); return r;
}
template <int D0> DI void pv_one(f32x16& od, int vb, bf16x8 pa0, bf16x8 pa1, bf16x8 pa2, bf16x8 pa3) {
  const s16x4 l0 = tr_read<v_rd_off(D0, 0, 0)>(vb), h0 = tr_read<v_rd_off(D0, 0, 1)>(vb), l1 = tr_read<v_rd_off(D0, 1, 0)>(vb), h1 = tr_read<v_rd_off(D0, 1, 1)>(vb);
  const s16x4 l2 = tr_read<v_rd_off(D0, 2, 0)>(vb), h2 = tr_read<v_rd_off(D0, 2, 1)>(vb), l3 = tr_read<v_rd_off(D0, 3, 0)>(vb), h3 = tr_read<v_rd_off(D0, 3, 1)>(vb);
  asm volatile("s_waitcnt lgkmcnt(0)" ::: "memory"); SBAR();
#define PKV(L, H) (bf16x8){L[0], L[1], L[2], L[3], H[0], H[1], H[2], H[3]}
  od = __builtin_amdgcn_mfma_f32_32x32x16_bf16(pa0, PKV(l0, h0), od, 0, 0, 0);
  od = __builtin_amdgcn_mfma_f32_32x32x16_bf16(pa1, PKV(l1, h1), od, 0, 0, 0);
  od = __builtin_amdgcn_mfma_f32_32x32x16_bf16(pa2, PKV(l2, h2), od, 0, 0, 0);
  od = __builtin_amdgcn_mfma_f32_32x32x16_bf16(pa3, PKV(l3, h3), od, 0, 0, 0);
#undef PKV
}

DI void attn_item(const u16* __restrict__ Qb, const u16* __restrict__ Kh, const u16* __restrict__ Vh, int q0,
                  u16* __restrict__ Yb, const u16* __restrict__ Zb, char* lds) {
  const int tid = otid(), wid = tid >> 6, lane = tid & 63, r32 = lane & 31, hi = lane >> 5;
  char* V_lds = lds; char* K_lds = lds + 2 * SHM_V;
  float* wsf = (float*)(lds + 2 * SHM_V + 2 * SHM_K) + wid * 64; float* li_l = wsf; float* al_l = wsf + 32;
  constexpr float C = ATT_SCALE * 1.4426950408889634f;
  float m_reg = -1e30f, l_reg = 0.f;
  f32x16 o[4];
#pragma unroll
  for (int d = 0; d < 4; ++d)
#pragma unroll
    for (int r = 0; r < 16; ++r) o[d][r] = 0.f;
  bf16x8 qr[12];
  const int qrow = q0 + wid * 32 + r32;
#pragma unroll
  for (int d0 = 0; d0 < 12; ++d0) {
    bf16x8 z = {0, 0, 0, 0, 0, 0, 0, 0};
    qr[d0] = qrow < TP ? *(const bf16x8*)(Qb + (long)qrow * 192 + d0 * 16 + hi * 8) : z;
  }
  const int sr = tid >> 4, sc = (tid & 15) * 8, vst0 = v_st(sr, sc), vst1 = v_st(32 + sr, sc);
  const int vb0 = (int)(uintptr_t)V_lds + v_rd_base(lane);
  u32x4 kst[3], vst[2];
#define KLOAD(k0) do { _Pragma("unroll") for (int i = 0; i < 3; ++i) { int q = tid + 512 * i; int row = q / 24, c = q % 24; \
      kst[i] = *(const u32x4*)(Kh + (long)((k0) + row) * 192 + c * 8); } } while (0)
#define VLOAD(k0) do { vst[0] = *(const u32x4*)(Vh + (long)((k0) + sr) * 128 + sc); vst[1] = *(const u32x4*)(Vh + (long)((k0) + 32 + sr) * 128 + sc); } while (0)
#define KWRITE(b) do { _Pragma("unroll") for (int i = 0; i < 3; ++i) { int q = tid + 512 * i; int row = q / 24, c = q % 24; \
      *(u32x4*)(K_lds + (b) * SHM_K + row * 384 + ((c * 16) ^ ((row & 7) << 4))) = kst[i]; } } while (0)
#define VWRITE(b) do { *(u32x4*)(V_lds + (b) * SHM_V + vst0) = vst[0]; *(u32x4*)(V_lds + (b) * SHM_V + vst1) = vst[1]; } while (0)
  constexpr int NT = TP / 64;
  __syncthreads();
  KLOAD(0); VLOAD(0); KWRITE(0); VWRITE(0); VLOAD(64);
  __syncthreads();
#pragma unroll 1
  for (int j = 0; j < NT; ++j) {
    const int cur = j & 1;
    f32x16 p0, p1;
#pragma unroll
    for (int r = 0; r < 16; ++r) { p0[r] = 0.f; p1[r] = 0.f; }
    const char* Kc = K_lds + cur * SHM_K;
#pragma unroll
    for (int d0 = 0; d0 < 12; ++d0) {
      const int cb = (d0 * 16 + hi * 8) * 2;
      bf16x8 b0 = *(const bf16x8*)(Kc + r32 * 384 + (cb ^ ((r32 & 7) << 4)));
      bf16x8 b1 = *(const bf16x8*)(Kc + (32 + r32) * 384 + (cb ^ ((r32 & 7) << 4)));
      p0 = __builtin_amdgcn_mfma_f32_32x32x16_bf16(b0, qr[d0], p0, 0, 0, 0);
      p1 = __builtin_amdgcn_mfma_f32_32x32x16_bf16(b1, qr[d0], p1, 0, 0, 0);
      if ((d0 & 1) == 1) SBAR();
    }
    if (j + 1 < NT) { VWRITE(cur ^ 1); KLOAD((j + 1) * 64); }
    if (j == 0) {
#pragma unroll
      for (int r = 0; r < 16; ++r) p0[r] = -1e30f;
#pragma unroll
      for (int r = 0; r < 8; ++r) p1[r] = -1e30f;
    }
    float pmax = p0[0];
#pragma unroll
    for (int r = 1; r < 16; ++r) pmax = fmaxf(pmax, p0[r]);
#pragma unroll
    for (int r = 0; r < 16; ++r) pmax = fmaxf(pmax, p1[r]);
    { auto rr = __builtin_amdgcn_permlane32_swap(__float_as_uint(pmax), __float_as_uint(pmax), false, false);
      pmax = fmaxf(__uint_as_float(rr[0]), __uint_as_float(rr[1])); }
    float mn, alpha;
    if (__all(pmax - m_reg <= ATT_THR / ATT_SCALE)) { mn = m_reg; alpha = 1.f; }
    else { mn = fmaxf(m_reg, pmax); alpha = __builtin_amdgcn_exp2f((m_reg - mn) * C); m_reg = mn; }
    if (__any(alpha < 1.f)) {
      if (hi == 0) al_l[r32] = alpha;
      asm volatile("s_waitcnt lgkmcnt(0)" ::: "memory");
#pragma unroll
      for (int r = 0; r < 16; ++r) { const float a = al_l[crow(r, hi)];
#pragma unroll
        for (int d = 0; d < 4; ++d) o[d][r] *= a; }
    }
    const float mnC = -mn * C;
    float ps = 0.f;
#pragma unroll
    for (int r = 0; r < 16; ++r) { p0[r] = __builtin_amdgcn_exp2f(fmaf(p0[r], C, mnC)); p1[r] = __builtin_amdgcn_exp2f(fmaf(p1[r], C, mnC)); ps += p0[r] + p1[r]; }
    { auto rr = __builtin_amdgcn_permlane32_swap(__float_as_uint(ps), __float_as_uint(ps), false, false);
      ps = __uint_as_float(rr[0]) + __uint_as_float(rr[1]); }
    l_reg = l_reg * alpha + ps;
    bf16x8 pa0, pa1, pa2, pa3;
#define PK4(PP, BASE, OUT) do { unsigned a0 = pk2(PP[BASE + 0], PP[BASE + 1]), a1 = pk2(PP[BASE + 2], PP[BASE + 3]); \
    unsigned b0 = pk2(PP[BASE + 4], PP[BASE + 5]), b1 = pk2(PP[BASE + 6], PP[BASE + 7]); \
    auto r0 = __builtin_amdgcn_permlane32_swap(a0, b0, false, false); auto r1 = __builtin_amdgcn_permlane32_swap(a1, b1, false, false); \
    u32x4 w = {r0[0], r1[0], r0[1], r1[1]}; OUT = __builtin_bit_cast(bf16x8, w); } while (0)
    PK4(p0, 0, pa0); PK4(p0, 8, pa1); PK4(p1, 0, pa2); PK4(p1, 8, pa3);
#undef PK4
    const int vb = vb0 + cur * SHM_V;
    pv_one<0>(o[0], vb, pa0, pa1, pa2, pa3); pv_one<1>(o[1], vb, pa0, pa1, pa2, pa3);
    pv_one<2>(o[2], vb, pa0, pa1, pa2, pa3); pv_one<3>(o[3], vb, pa0, pa1, pa2, pa3);
    if (j + 1 < NT) { KWRITE(cur ^ 1); if (j + 2 < NT) VLOAD((j + 2) * 64); }
    __syncthreads();
  }
#undef KLOAD
#undef VLOAD
#undef KWRITE
#undef VWRITE
  if (hi == 0) li_l[r32] = l_reg;
  asm volatile("s_waitcnt lgkmcnt(0)" ::: "memory");
#pragma unroll
  for (int r = 0; r < 16; ++r) {
    const int orow = q0 + wid * 32 + crow(r, hi);
    const float rl = 1.f / li_l[crow(r, hi)];
    if (orow < TP) {
#pragma unroll
      for (int d0 = 0; d0 < 4; ++d0) {
        const long off = (long)orow * 2048 + d0 * 32 + r32;
        Yb[off] = f2bf(o[d0][r] * rl * silu(bf2f(Zb[off])));
      }
    }
  }
}

DI void phase_attn(const Params& p, char* lds) {
  const u16* QM = (const u16*)(p.ws + OFF_QM); const u16* KM = (const u16*)(p.ws + OFF_KM); const u16* VM = (const u16*)(p.ws + OFF_VM);
  u16* Y = (u16*)(p.ws + OFF_Y); const u16* Z = (const u16*)(p.ws + OFF_Z);
  const int b = blockIdx.x, x = b & 7, lb = b >> 3;
  if (gridDim.x == 256) {
    for (int it = 0; it < 5; ++it) {
      int pair, qb;
      if (it < 4) { pair = x + 8 * (2 * it + (lb >> 4)); qb = lb & 15; }
      else { if (b >= 64) break; pair = b; qb = 16; }
      const int seq = pair >> 4, head = pair & 15;
      attn_item(QM + (long)pair * TP * 192, KM + (long)pair * TP * 192, VM + (long)pair * TP * 128, qb * 256,
                Y + (long)seq * TP * 2048 + head * 128, Z + (long)seq * TP * 2048 + head * 128, lds);
    }
  } else {
    for (int item = b; item < 64 * 17; item += gridDim.x) {
      const int pair = item / 17, qb = item % 17; const int seq = pair >> 4, head = pair & 15;
      attn_item(QM + (long)pair * TP * 192, KM + (long)pair * TP * 192, VM + (long)pair * TP * 128, qb * 256,
                Y + (long)seq * TP * 2048 + head * 128, Z + (long)seq * TP * 2048 + head * 128, lds);
    }
  }
}

__global__ void __launch_bounds__(512) fwd_mega(Params p) {
  extern __shared__ __attribute__((aligned(16))) char lds[];
  cg::grid_group grid = cg::this_grid();
  char* ws = p.ws;
  phase_prep(p, lds);
  for (int g = 0; g < NGRP; ++g) {
    phase_hn(p, g, 0);
    grid.sync();
    { EpiGin e{(u16*)(ws + OFF_P), (u16*)(ws + OFF_HALO), (u16*)(ws + OFF_Z), (float*)(ws + OFF_BA)};
      gemm_phase<4, 2, 2, 2>((const u16*)(ws + OFF_HN), 1024, (const u16*)(ws + OFF_WGIN), 1024, 1024, GINP, lds, e); }
    grid.sync();
    phase_conv(p, lds);
    grid.sync();
    phase_scan_naive(p, lds);
    grid.sync();
    phase_gate(p);
    grid.sync();
    { EpiGout e{p, g, (float*)(ws + OFF_H1M)};
      gemm_phase<4, 2, 2, 2>((const u16*)(ws + OFF_OF), 2048, (const u16*)(ws + OFF_WGOUT), 2048, 2048, 1024, lds, e); }
    grid.sync();
    phase_hn(p, g, 1);
    grid.sync();
    { EpiMin e{(u16*)(ws + OFF_CQ), (u16*)(ws + OFF_CKV), (u16*)(ws + OFF_Z), (float*)(ws + OFF_KPE)};
      gemm_phase<4, 2, 2, 2>((const u16*)(ws + OFF_HN), 1024, (const u16*)(ws + OFF_WMIN), 1024, 1024, MINP, lds, e); }
    grid.sync();
    phase_rowstats(p);
    grid.sync();
    { EpiQ e{(const float*)(ws + OFF_ROWST), p.m_qg, (const float*)(ws + OFF_ROPE), (u16*)(ws + OFF_QM)};
      gemm_phase<8, 1, 1, 6>((const u16*)(ws + OFF_CQ), 512, (const u16*)(ws + OFF_WUQ), 512, 512, 3072, lds, e); }
    { EpiKV e{(const float*)(ws + OFF_ROWST), p.m_kg, (const float*)(ws + OFF_KPER), (u16*)(ws + OFF_KM), (u16*)(ws + OFF_VM)};
      gemm_phase<8, 1, 1, 4>((const u16*)(ws + OFF_CKV), 256, (const u16*)(ws + OFF_WUKV), 256, 256, 4096, lds, e); }
    grid.sync();
    phase_attn(p, lds);
    grid.sync();
    { EpiMout e{p.out, g};
      gemm_phase<4, 2, 2, 2>((const u16*)(ws + OFF_Y), 2048, (const u16*)(ws + OFF_WMOUT), 2048, 2048, 1024, lds, e); }
    grid.sync();
  }
}

extern "C" void kernel_launch(void* const* d_in, const int* in_sizes, int n_in,
                              void* d_out, int out_size, void* d_ws, size_t ws_size,
                              hipStream_t stream) {
  static int grid_blocks = 0;
  if (!grid_blocks) {
    int dev = 0, cus = 0, per_cu = 0;
    (void)hipGetDevice(&dev);
    (void)hipDeviceGetAttribute(&cus, hipDeviceAttributeMultiprocessorCount, dev);
    (void)hipFuncSetAttribute((const void*)fwd_mega, hipFuncAttributeMaxDynamicSharedMemorySize, LDS_BYTES);
    (void)hipOccupancyMaxActiveBlocksPerMultiprocessor(&per_cu, fwd_mega, 512, LDS_BYTES);
    if (per_cu < 1) { fprintf(stderr, "occupancy query returned %d\n", per_cu); per_cu = 1; }
    if (per_cu > 1) per_cu = 1;
    grid_blocks = cus * per_cu;
  }
  if (ws_size < WS_NEED) { fprintf(stderr, "workspace too small: %zu < %zu\n", ws_size, (size_t)WS_NEED); return; }
  Params p{};
  p.xp = (const float*)d_in[0]; p.xs = (const float*)d_in[1]; p.meta = (const float*)d_in[2]; p.ln_g = (const float*)d_in[3];
  p.g_win = (const float*)d_in[4]; p.g_conv = (const float*)d_in[5]; p.g_alog = (const float*)d_in[6]; p.g_dtb = (const float*)d_in[7];
  p.g_onorm = (const float*)d_in[8]; p.g_wout = (const float*)d_in[9]; p.m_win = (const float*)d_in[10]; p.m_qn = (const float*)d_in[11];
  p.m_kvn = (const float*)d_in[12]; p.m_wuq = (const float*)d_in[13]; p.m_wukv = (const float*)d_in[14]; p.m_qg = (const float*)d_in[15];
  p.m_kg = (const float*)d_in[16]; p.m_wout = (const float*)d_in[17]; p.out = (float*)d_out; p.ws = (char*)d_ws;
  void* args[] = {&p};
  hipError_t e = hipLaunchCooperativeKernel((void*)fwd_mega, dim3(grid_blocks), dim3(512), args, LDS_BYTES, stream);
  if (e != hipSuccess) fprintf(stderr, "cooperative launch failed: %s (grid %d)\n", hipGetErrorString(e), grid_blocks);
}
```

```cpp
#include <hip/hip_runtime.h>
#include <hip/hip_cooperative_groups.h>
#include <cstdio>
#include <cstdint>
namespace cg = cooperative_groups;

typedef unsigned short u16;
typedef __bf16 bf2_t __attribute__((ext_vector_type(2)));
typedef float f2_t __attribute__((ext_vector_type(2)));
using bf16x8 = __attribute__((ext_vector_type(8))) short;
using s16x4  = __attribute__((ext_vector_type(4))) short;
using f32x16 = __attribute__((ext_vector_type(16))) float;
using f32x4  = __attribute__((ext_vector_type(4))) float;
using u32x4  = __attribute__((ext_vector_type(4))) unsigned;
using u32x2  = __attribute__((ext_vector_type(2))) unsigned;
#define DI __device__ __forceinline__
#define SBAR() __builtin_amdgcn_sched_barrier(0)

DI unsigned pk2(float a, float b) { f2_t v = {a, b}; bf2_t r = __builtin_convertvector(v, bf2_t); return __builtin_bit_cast(unsigned, r); }
DI u16 f2bf(float a) { return (u16)(pk2(a, 0.f) & 0xffffu); }
DI float bf2f(u16 v) { return __uint_as_float(((unsigned)v) << 16); }
DI float bflo(unsigned v) { return __uint_as_float(v << 16); }
DI float bfhi(unsigned v) { return __uint_as_float(v & 0xffff0000u); }
DI int otid() { int t = __builtin_amdgcn_workitem_id_x(); asm volatile("" : "+v"(t)); return t; }
DI int crow(int r, int hi) { return (r & 3) + 8 * (r >> 2) + 4 * hi; }
DI float wave_sum(float v) {
#pragma unroll
  for (int m = 32; m >= 1; m >>= 1) v += __shfl_xor(v, m, 64);
  return v;
}
DI float silu(float x) { return x / (1.f + __expf(-x)); }

constexpr int D = 1024, TP = 4160, GS = 4, GR = GS * TP, NGRP = 3, PADR = 48, SEQ = 4096;
constexpr int GIN = 6176, GINP = 6400, MIN_ = 2880, MINP = 2944;
constexpr float EPS = 1e-6f;
constexpr int NCHUNK = 65;

constexpr size_t al256(size_t x) { return (x + 255) / 256 * 256; }
constexpr size_t OFF_WGIN  = 0;
constexpr size_t OFF_WGOUT = OFF_WGIN  + al256((size_t)GINP * 1024 * 2);
constexpr size_t OFF_WMIN  = OFF_WGOUT + al256((size_t)1024 * 2048 * 2);
constexpr size_t OFF_WUQ   = OFF_WMIN  + al256((size_t)MINP * 1024 * 2);
constexpr size_t OFF_WUKV  = OFF_WUQ   + al256((size_t)3072 * 512 * 2);
constexpr size_t OFF_WMOUT = OFF_WUKV  + al256((size_t)4096 * 256 * 2);
constexpr size_t OFF_ROPE  = OFF_WMOUT + al256((size_t)1024 * 2048 * 2);
constexpr size_t OFF_H1M   = OFF_ROPE  + al256((size_t)4112 * 64 * 4);
constexpr size_t OFF_HN    = OFF_H1M   + al256((size_t)12 * 16 * 1024 * 4);
constexpr size_t OFF_Z     = OFF_HN    + al256((size_t)GR * 1024 * 2);
constexpr size_t OFF_R     = OFF_Z     + al256((size_t)GR * 2048 * 2);
constexpr size_t OFF_P     = OFF_R;
constexpr size_t OFF_HALO  = OFF_P     + al256((size_t)GR * 4096 * 2);
constexpr size_t OFF_BA    = OFF_HALO  + al256((size_t)(GR / 64) * 4 * 4096 * 2);
constexpr size_t OFF_SC    = OFF_BA    + al256((size_t)GR * 32 * 4);
constexpr size_t OFF_TQ    = OFF_SC    + al256((size_t)GS * 8 * 2 * TP * 16);
constexpr size_t OFF_KT    = OFF_TQ    + al256((size_t)GS * 8 * 2 * NCHUNK * 16384);
constexpr size_t OFF_OF    = OFF_KT    + al256((size_t)GS * 8 * NCHUNK * 16384);
constexpr size_t OFF_OB    = OFF_OF    + al256((size_t)GR * 2048 * 2);
constexpr size_t END_GDN   = OFF_OB    + al256((size_t)GR * 2048 * 2);
constexpr size_t OFF_CQ    = OFF_R;
constexpr size_t OFF_CKV   = OFF_CQ    + al256((size_t)GR * 512 * 2);
constexpr size_t OFF_KPE   = OFF_CKV   + al256((size_t)GR * 256 * 2);
constexpr size_t OFF_ROWST = OFF_KPE   + al256((size_t)GR * 64 * 4);
constexpr size_t OFF_KPER  = OFF_ROWST + al256((size_t)GR * 4 * 4);
constexpr size_t OFF_QM    = OFF_KPER  + al256((size_t)GR * 64 * 4);
constexpr size_t OFF_KM    = OFF_QM    + al256((size_t)GR * 16 * 192 * 2);
constexpr size_t OFF_VM    = OFF_KM    + al256((size_t)GR * 16 * 192 * 2);
constexpr size_t OFF_Y     = OFF_VM    + al256((size_t)GR * 16 * 128 * 2);
constexpr size_t END_MLA   = OFF_Y     + al256((size_t)GR * 2048 * 2);
constexpr size_t WS_NEED   = END_MLA > END_GDN ? END_MLA : END_GDN;

constexpr int LDS_BYTES = 160 * 1024;

struct Params {
  const float *xp, *xs, *meta, *ln_g, *g_win, *g_conv, *g_alog, *g_dtb, *g_onorm, *g_wout;
  const float *m_win, *m_qn, *m_kvn, *m_wuq, *m_wukv, *m_qg, *m_kg, *m_wout;
  float* out; char* ws;
};

DI const float* h0_row(const Params& p, int sg, int pos) {
  return pos < 16 ? p.meta + (long)pos * D
                  : (sg < 4 ? p.xp + ((long)sg * SEQ + pos - 16) * D : p.xs + ((long)(sg - 4) * SEQ + pos - 16) * D);
}

DI void transpose_cvt(const float* __restrict__ src, u16* __restrict__ dst, int K, int N, int Npad,
                      const float* __restrict__ gain, int gmod, float* lds) {
  const int tid = otid();
  const int tK = K / 64, tN = Npad / 64;
  for (int tile = blockIdx.x; tile < tK * tN; tile += gridDim.x) {
    const int tk = tile % tK, tn = tile / tK;
#pragma unroll
    for (int i = 0; i < 2; ++i) {
      int kk = (tid >> 4) + 32 * i, nn = (tid & 15) * 4;
      int k = tk * 64 + kk, n = tn * 64 + nn;
      float4 v = make_float4(0.f, 0.f, 0.f, 0.f);
      if (n < N) v = *(const float4*)(src + (long)k * N + n);
      float gsc = gain ? gain[k % gmod] : 1.f;
      lds[kk * 65 + nn + 0] = v.x * gsc; lds[kk * 65 + nn + 1] = v.y * gsc;
      lds[kk * 65 + nn + 2] = v.z * gsc; lds[kk * 65 + nn + 3] = v.w * gsc;
    }
    __syncthreads();
    {
      int n = tid >> 3, k8 = (tid & 7) * 8;
      float f[8];
#pragma unroll
      for (int j = 0; j < 8; ++j) f[j] = lds[(k8 + j) * 65 + n];
      u32x4 w = {pk2(f[0], f[1]), pk2(f[2], f[3]), pk2(f[4], f[5]), pk2(f[6], f[7])};
      *(u32x4*)(dst + (long)(tn * 64 + n) * K + tk * 64 + k8) = w;
    }
    __syncthreads();
  }
}

DI void phase_prep(const Params& p, char* lds) {
  float* l = (float*)lds;
  transpose_cvt(p.g_win, (u16*)(p.ws + OFF_WGIN), 1024, GIN, GINP, p.ln_g, 1024, l);
  transpose_cvt(p.g_wout, (u16*)(p.ws + OFF_WGOUT), 2048, 1024, 1024, p.g_onorm, 256, l);
  transpose_cvt(p.m_win, (u16*)(p.ws + OFF_WMIN), 1024, MIN_, MINP, p.ln_g + 1024, 1024, l);
  transpose_cvt(p.m_wuq, (u16*)(p.ws + OFF_WUQ), 512, 3072, 3072, p.m_qn, 512, l);
  transpose_cvt(p.m_wukv, (u16*)(p.ws + OFF_WUKV), 256, 4096, 4096, p.m_kvn, 256, l);
  transpose_cvt(p.m_wout, (u16*)(p.ws + OFF_WMOUT), 2048, 1024, 1024, nullptr, 1, l);
  float* rope = (float*)(p.ws + OFF_ROPE);
  for (int i = blockIdx.x * 512 + otid(); i < 4112 * 32; i += gridDim.x * 512) {
    int pos = i >> 5, j = i & 31;
    float inv = __builtin_amdgcn_exp2f(-(float)j * (13.287712379549449f / 32.f));
    float ang = (float)pos * inv;
    float n = rintf(ang * 0.15915494309189535f);
    float rr = fmaf(-n, 6.28318548202514648f, ang); rr = fmaf(-n, -1.7484555e-7f, rr);
    float s = __sinf(rr), c = __cosf(rr);
    rope[pos * 64 + j] = c; rope[pos * 64 + 32 + j] = s;
  }
}

DI void phase_hn(const Params& p, int g, int layer) {
  const int lane = otid() & 63, wv = otid() >> 6;
  u16* HN = (u16*)(p.ws + OFF_HN);
  const float* h1m = (const float*)(p.ws + OFF_H1M);
  for (int row = blockIdx.x * 8 + wv; row < GR; row += gridDim.x * 8) {
    int seq = row / TP, r = row % TP, pos = r - PADR, sg = g * GS + seq;
    u16* dst = HN + (long)row * D;
    if (pos < 0) {
      u32x2 z = {0u, 0u};
#pragma unroll
      for (int i = 0; i < 4; ++i) *(u32x2*)(dst + i * 256 + lane * 4) = z;
      continue;
    }
    const float* src;
    if (layer == 0) src = h0_row(p, sg, pos);
    else src = pos < 16 ? h1m + ((long)sg * 16 + pos) * D : p.out + ((long)sg * SEQ + pos - 16) * D;
    float4 v[4]; float ss = 0.f;
#pragma unroll
    for (int i = 0; i < 4; ++i) { v[i] = *(const float4*)(src + i * 256 + lane * 4); ss += v[i].x * v[i].x + v[i].y * v[i].y + v[i].z * v[i].z + v[i].w * v[i].w; }
    ss = wave_sum(ss);
    float rs = rsqrtf(ss * (1.f / 1024.f) + EPS);
#pragma unroll
    for (int i = 0; i < 4; ++i) { u32x2 w = {pk2(v[i].x * rs, v[i].y * rs), pk2(v[i].z * rs, v[i].w * rs)}; *(u32x2*)(dst + i * 256 + lane * 4) = w; }
  }
}

template <int WM, int WN, int MT, int NT, class Epi>
DI void gemm_tile(const u16* __restrict__ A, int lda, const u16* __restrict__ Bt, int ldb, int K, int m0, int n0, char* lds, const Epi& epi) {
  constexpr int BM = WM * MT * 32, BN = WN * NT * 32, NA = BM * 8 / 512, NB = BN * 8 / 512;
  static_assert(WM * WN == 8, "8 waves");
  const int tid = otid(), lane = tid & 63, wid = tid >> 6, r32 = lane & 31, hi = lane >> 5;
  const int wm = wid / WN, wn = wid % WN;
  char* As = lds; char* Bs = lds + 2 * BM * 128;
  f32x16 acc[MT][NT];
#pragma unroll
  for (int a = 0; a < MT; ++a)
#pragma unroll
    for (int b = 0; b < NT; ++b)
#pragma unroll
      for (int r = 0; r < 16; ++r) acc[a][b][r] = 0.f;
  u32x4 ra[NA], rb[NB];
  const int nk = K / 64;
#define GLOAD(kt) do { _Pragma("unroll") for (int i = 0; i < NA; ++i) { int q = tid + 512 * i; int row = q >> 3, c = q & 7; \
      ra[i] = *(const u32x4*)(A + (long)(m0 + row) * lda + (kt) * 64 + c * 8); } \
    _Pragma("unroll") for (int i = 0; i < NB; ++i) { int q = tid + 512 * i; int row = q >> 3, c = q & 7; \
      rb[i] = *(const u32x4*)(Bt + (long)(n0 + row) * ldb + (kt) * 64 + c * 8); } } while (0)
#define SWRITE(buf) do { _Pragma("unroll") for (int i = 0; i < NA; ++i) { int q = tid + 512 * i; int row = q >> 3, c = q & 7; \
      *(u32x4*)(As + (buf) * BM * 128 + row * 128 + ((c ^ (row & 7)) << 4)) = ra[i]; } \
    _Pragma("unroll") for (int i = 0; i < NB; ++i) { int q = tid + 512 * i; int row = q >> 3, c = q & 7; \
      *(u32x4*)(Bs + (buf) * BN * 128 + row * 128 + ((c ^ (row & 7)) << 4)) = rb[i]; } } while (0)
  GLOAD(0); SWRITE(0); if (nk > 1) GLOAD(1);
  __syncthreads();
  for (int kt = 0; kt < nk; ++kt) {
    const int cur = kt & 1;
#pragma unroll
    for (int ks = 0; ks < 4; ++ks) {
      bf16x8 af[MT], bfr[NT];
      const int c = ks * 2 + hi;
#pragma unroll
      for (int a = 0; a < MT; ++a) { int row = (wm * MT + a) * 32 + r32; af[a] = *(const bf16x8*)(As + cur * BM * 128 + row * 128 + ((c ^ (row & 7)) << 4)); }
#pragma unroll
      for (int b = 0; b < NT; ++b) { int row = (wn * NT + b) * 32 + r32; bfr[b] = *(const bf16x8*)(Bs + cur * BN * 128 + row * 128 + ((c ^ (row & 7)) << 4)); }
#pragma unroll
      for (int a = 0; a < MT; ++a)
#pragma unroll
        for (int b = 0; b < NT; ++b) acc[a][b] = __builtin_amdgcn_mfma_f32_32x32x16_bf16(af[a], bfr[b], acc[a][b], 0, 0, 0);
    }
    if (kt + 1 < nk) { SWRITE(cur ^ 1); if (kt + 2 < nk) GLOAD(kt + 2); }
    __syncthreads();
  }
#undef GLOAD
#undef SWRITE
  epi(acc, m0 + wm * MT * 32, n0 + wn * NT * 32, lane);
}

struct EpiGin { u16 *P, *HALO, *Z; float* BA;
  DI void operator()(f32x16 (&acc)[2][2], int m0, int n0, int lane) const {
    const int r32 = lane & 31, hi = lane >> 5;
#pragma unroll
    for (int a = 0; a < 2; ++a)
#pragma unroll
      for (int b = 0; b < 2; ++b) {
        const int col = n0 + b * 32 + r32;
#pragma unroll
        for (int r = 0; r < 16; ++r) {
          const int row = m0 + a * 32 + crow(r, hi); const float v = acc[a][b][r];
          if (col < 4096) { u16 bv = f2bf(v); P[(long)row * 4096 + col] = bv; int rm = row & 63;
            if (rm < 2 || rm >= 62) HALO[((long)(row >> 6) * 4 + (rm < 2 ? rm : rm - 60)) * 4096 + col] = bv; }
          else if (col < 6144) Z[(long)row * 2048 + col - 4096] = f2bf(v);
          else if (col < GIN) BA[(long)row * 32 + col - 6144] = v;
        }
      }
  } };

struct EpiGout { Params p; int g; float* h1m;
  DI void operator()(f32x16 (&acc)[2][2], int m0, int n0, int lane) const {
    const int r32 = lane & 31, hi = lane >> 5;
#pragma unroll
    for (int a = 0; a < 2; ++a)
#pragma unroll
      for (int r = 0; r < 16; ++r) {
        const int row = m0 + a * 32 + crow(r, hi);
        const int seq = row / TP, rr = row % TP, pos = rr - PADR, sg = g * GS + seq;
        if (pos < 0) continue;
        const float* h0 = h0_row(p, sg, pos);
        float* dst = pos < 16 ? h1m + ((long)sg * 16 + pos) * D : p.out + ((long)sg * SEQ + pos - 16) * D;
#pragma unroll
        for (int b = 0; b < 2; ++b) { const int col = n0 + b * 32 + r32; dst[col] = h0[col] + acc[a][b][r]; }
      }
  } };

struct EpiMin { u16 *CQ, *CKV, *Z; float* KPE;
  DI void operator()(f32x16 (&acc)[2][2], int m0, int n0, int lane) const {
    const int r32 = lane & 31, hi = lane >> 5;
#pragma unroll
    for (int a = 0; a < 2; ++a)
#pragma unroll
      for (int b = 0; b < 2; ++b) {
        const int col = n0 + b * 32 + r32;
#pragma unroll
        for (int r = 0; r < 16; ++r) {
          const int row = m0 + a * 32 + crow(r, hi); const float v = acc[a][b][r];
          if (col < 512) CQ[(long)row * 512 + col] = f2bf(v);
          else if (col < 768) CKV[(long)row * 256 + col - 512] = f2bf(v);
          else if (col < 832) KPE[(long)row * 64 + col - 768] = v;
          else if (col < MIN_) Z[(long)row * 2048 + col - 832] = f2bf(v);
        }
      }
  } };

struct EpiQ { const float *rowst, *gq, *rope; u16* Q;
  DI void operator()(f32x16 (&acc)[1][6], int m0, int n0, int lane) const {
    const int r32 = lane & 31, hi = lane >> 5, head = n0 / 192;
    float ss[16];
#pragma unroll
    for (int r = 0; r < 16; ++r) {
      const int row = m0 + crow(r, hi); const float rq = rowst[row * 4 + 0]; float s = 0.f;
#pragma unroll
      for (int b = 0; b < 6; ++b) { acc[0][b][r] *= rq; s += acc[0][b][r] * acc[0][b][r]; }
      ss[r] = s;
    }
#pragma unroll
    for (int r = 0; r < 16; ++r) {
#pragma unroll
      for (int m = 16; m >= 1; m >>= 1) ss[r] += __shfl_xor(ss[r], m, 64);
    }
    float gc[6];
#pragma unroll
    for (int b = 0; b < 6; ++b) gc[b] = gq[b * 32 + r32];
#pragma unroll
    for (int r = 0; r < 16; ++r) {
      const int row = m0 + crow(r, hi); const int seq = row / TP, rr = row % TP; int pos = rr - PADR; pos = pos < 0 ? 0 : pos;
      const float rs = rsqrtf(ss[r] * (1.f / 192.f) + EPS);
      const float c = rope[pos * 64 + r32], s = rope[pos * 64 + 32 + r32];
      float x[6];
#pragma unroll
      for (int b = 0; b < 6; ++b) x[b] = acc[0][b][r] * rs * gc[b];
      const float x1 = x[4] * c - x[5] * s, x2 = x[5] * c + x[4] * s; x[4] = x1; x[5] = x2;
      u16* dst = Q + ((long)(seq * 16 + head) * TP + rr) * 192;
#pragma unroll
      for (int b = 0; b < 6; ++b) dst[b * 32 + r32] = f2bf(x[b]);
    }
  } };

struct EpiKV { const float *rowst, *gk, *kper; u16 *Kd, *Vd;
  DI void operator()(f32x16 (&acc)[1][4], int m0, int n0, int lane) const {
    const int r32 = lane & 31, hi = lane >> 5, head = n0 >> 8, isv = (n0 >> 7) & 1;
    if (isv) {
#pragma unroll
      for (int r = 0; r < 16; ++r) {
        const int row = m0 + crow(r, hi); const int seq = row / TP, rr = row % TP; const float rk = rowst[row * 4 + 1];
        u16* vd = Vd + ((long)(seq * 16 + head) * TP + rr) * 128;
#pragma unroll
        for (int b = 0; b < 4; ++b) vd[b * 32 + r32] = f2bf(acc[0][b][r] * rk);
      }
      return;
    }
    float ss[16];
#pragma unroll
    for (int r = 0; r < 16; ++r) {
      const int row = m0 + crow(r, hi); const float rk = rowst[row * 4 + 1]; float s = 0.f;
#pragma unroll
      for (int b = 0; b < 4; ++b) { acc[0][b][r] *= rk; s += acc[0][b][r] * acc[0][b][r]; }
      ss[r] = s;
    }
#pragma unroll
    for (int r = 0; r < 16; ++r) {
#pragma unroll
      for (int m = 16; m >= 1; m >>= 1) ss[r] += __shfl_xor(ss[r], m, 64);
    }
    float gc[4];
#pragma unroll
    for (int b = 0; b < 4; ++b) gc[b] = gk[b * 32 + r32];
#pragma unroll
    for (int r = 0; r < 16; ++r) {
      const int row = m0 + crow(r, hi); const int seq = row / TP, rr = row % TP;
      const float rs = rsqrtf((ss[r] + rowst[row * 4 + 2]) * (1.f / 192.f) + EPS);
      u16* kd = Kd + ((long)(seq * 16 + head) * TP + rr) * 192;
#pragma unroll
      for (int b = 0; b < 4; ++b) kd[b * 32 + r32] = f2bf(acc[0][b][r] * rs * gc[b]);
      kd[128 + r32] = f2bf(kper[(long)row * 64 + r32] * rs);
      kd[160 + r32] = f2bf(kper[(long)row * 64 + 32 + r32] * rs);
    }
  } };

struct EpiMout { float* out; int g;
  DI void operator()(f32x16 (&acc)[2][2], int m0, int n0, int lane) const {
    const int r32 = lane & 31, hi = lane >> 5;
#pragma unroll
    for (int a = 0; a < 2; ++a)
#pragma unroll
      for (int r = 0; r < 16; ++r) {
        const int row = m0 + a * 32 + crow(r, hi);
        const int seq = row / TP, rr = row % TP, pos = rr - PADR, sg = g * GS + seq;
        if (pos < 16) continue;
        float* dst = out + ((long)sg * SEQ + pos - 16) * D;
#pragma unroll
        for (int b = 0; b < 2; ++b) { const int col = n0 + b * 32 + r32; dst[col] += acc[a][b][r]; }
      }
  } };

template <int WM, int WN, int MT, int NT, class Epi>
DI void gemm_phase(const u16* A, int lda, const u16* Bt, int ldb, int K, int Npad, char* lds, const Epi& epi) {
  constexpr int BM = WM * MT * 32, BN = WN * NT * 32;
  const int nM = GR / BM, nN = Npad / BN;
  for (int t = blockIdx.x; t < nM * nN; t += gridDim.x) {
    const int tm = t % nM, tn = t / nM;
    gemm_tile<WM, WN, MT, NT, Epi>(A, lda, Bt, ldb, K, tm * BM, tn * BN, lds, epi);
  }
}

DI void phase_chunk(const Params& p, char* lds) {
  u16* P = (u16*)(p.ws + OFF_P); const u16* HALO = (const u16*)(p.ws + OFF_HALO);
  const float* BA = (const float*)(p.ws + OFF_BA); float* SCg = (float*)(p.ws + OFF_SC);
  u16* TQg = (u16*)(p.ws + OFF_TQ); u16* KTg = (u16*)(p.ws + OFF_KT);
  char* Qs = lds; char* Ks = lds + 16384; float* M0 = (float*)(lds + 32768);
  float* sbeta = (float*)(lds + 65536); float* sg = sbeta + 128; float* sgc = sg + 128;
  const int tid0 = otid();
  for (int item = blockIdx.x; item < GS * 8 * NCHUNK; item += gridDim.x) {
    int tid = tid0; asm volatile("" : "+v"(tid));
    const int lane = tid & 63, wid = tid >> 6, cp = tid & 255, rh = tid >> 8, part = (tid >> 6) & 3;
    const int ch = cp * 2;
    const int chunk = item % NCHUNK, h = (item / NCHUNK) % 8, seq = item / (NCHUNK * 8);
    const int col = ch < 128 ? h * 128 + ch : (ch < 256 ? 1024 + h * 128 + (ch - 128) : 2048 + h * 256 + (ch - 256));
    const int R0 = seq * TP + chunk * 64, cg_ = seq * NCHUNK + chunk;
    unsigned outv[32];
    {
      float w0[5], w1[5];
#pragma unroll
      for (int j = 0; j < 5; ++j) { w0[j] = p.g_conv[j * 4096 + col]; w1[j] = p.g_conv[j * 4096 + col + 1]; }
      unsigned x[36];
#pragma unroll
      for (int i = 0; i < 36; ++i) {
        const int rr = rh * 32 + i - 2;
        unsigned v = 0u;
        if (rr >= 0 && rr < 64) v = *(const unsigned*)(P + (long)(R0 + rr) * 4096 + col);
        else if (rr < 0) { if (cg_ > 0) v = *(const unsigned*)(HALO + ((long)(cg_ - 1) * 4 + 2 + (rr + 2)) * 4096 + col); }
        else { if (cg_ + 1 < GS * NCHUNK) v = *(const unsigned*)(HALO + ((long)(cg_ + 1) * 4 + (rr - 64)) * 4096 + col); }
        x[i] = v;
      }
#pragma unroll
      for (int o = 0; o < 32; ++o) {
        float a0 = 0.f, a1 = 0.f;
#pragma unroll
        for (int j = 0; j < 5; ++j) { a0 += w0[j] * bflo(x[o + j]); a1 += w1[j] * bfhi(x[o + j]); }
        a0 = silu(a0); a1 = silu(a1);
        if (part < 2) {
          float ss = wave_sum(a0 * a0 + a1 * a1);
          float sc = rsqrtf(ss + EPS) * (part == 0 ? 0.08838834764831845f : 1.f);
          a0 *= sc; a1 *= sc;
        }
        const int row = rh * 32 + o;
        if (chunk == 0 && row < PADR) { a0 = 0.f; a1 = 0.f; }
        outv[o] = pk2(a0, a1);
        if ((o & 3) == 3) SBAR();
      }
    }
    __syncthreads();
#pragma unroll
    for (int o = 0; o < 32; ++o) *(unsigned*)(P + (long)(R0 + rh * 32 + o) * 4096 + col) = outv[o];
    if (part < 2) {
      char* dstT = part == 0 ? Qs : Ks; const int chl = ch - part * 128;
#pragma unroll
      for (int o = 0; o < 32; ++o) { const int row = rh * 32 + o;
        *(unsigned*)(dstT + row * 256 + ((((chl >> 3) ^ (row & 7))) << 4) + (chl & 7) * 2) = outv[o]; }
      if (part == 1) {
        u16* kt = KTg + ((long)(seq * 8 + h) * NCHUNK + chunk) * 8192 + (long)chl * 64 + rh * 32;
#pragma unroll
        for (int q4 = 0; q4 < 4; ++q4) {
          u32x4 lo, hi4;
#pragma unroll
          for (int e = 0; e < 4; ++e) { const unsigned a = outv[q4 * 8 + 2 * e], b = outv[q4 * 8 + 2 * e + 1];
            lo[e] = (a & 0xffffu) | (b << 16); hi4[e] = (a >> 16) | (b & 0xffff0000u); }
          *(u32x4*)(kt + q4 * 8) = lo; *(u32x4*)(kt + 64 + q4 * 8) = hi4;
          SBAR();
        }
      }
    }
    if (tid < 128) {
      const int r = tid & 63, dir = tid >> 6; const long row = R0 + r;
      const float b = BA[row * 32 + dir * 8 + h], a = BA[row * 32 + 16 + dir * 8 + h];
      float beta = 1.f / (1.f + __expf(-b));
      float xx = a + p.g_dtb[dir * 8 + h];
      float sp = xx > 20.f ? xx : __logf(1.f + __expf(xx));
      float gg = -__expf(p.g_alog[dir * 8 + h]) * sp;
      if (chunk == 0 && r < PADR) { beta = 0.f; gg = 0.f; }
      float gc = gg;
#pragma unroll
      for (int off = 1; off < 64; off <<= 1) {
        const float up = __shfl_up(gc, off, 64), dn = __shfl_down(gc, off, 64);
        if (dir == 0) { if (r >= off) gc += up; } else { if (r + off < 64) gc += dn; }
      }
      const float gl = __shfl(gc, dir == 0 ? 63 : 0, 64);
      sbeta[dir * 64 + r] = beta; sgc[dir * 64 + r] = gc;
      f32x4 st = {beta, __expf(gc), __expf(gl - gc), __expf(gl)};
      *(f32x4*)(SCg + ((long)((seq * 8 + h) * 2 + dir) * TP + chunk * 64 + r) * 4) = st;
    }
    __syncthreads();
    {
      const int kind = wid >> 2, qi = (wid >> 1) & 1, qj = wid & 1;
      int r32 = lane & 31, hi = lane >> 5;
      asm volatile("" : "+v"(r32), "+v"(hi));
      const char* At = kind ? Qs : Ks;
      f32x16 acc;
#pragma unroll
      for (int r = 0; r < 16; ++r) acc[r] = 0.f;
#pragma unroll
      for (int ks = 0; ks < 8; ++ks) {
        const int c = ks * 2 + hi; const int ra = qi * 32 + r32, rb = qj * 32 + r32;
        bf16x8 af = *(const bf16x8*)(At + ra * 256 + ((c ^ (ra & 7)) << 4));
        bf16x8 bfr = *(const bf16x8*)(Ks + rb * 256 + ((c ^ (rb & 7)) << 4));
        acc = __builtin_amdgcn_mfma_f32_32x32x16_bf16(af, bfr, acc, 0, 0, 0);
        if (ks & 1) SBAR();
      }
      const int j = qj * 32 + r32;
      u16* Ag0 = TQg + ((long)((seq * 8 + h) * 2 + 0) * NCHUNK + chunk) * 8192 + 4096;
      u16* Ag1 = TQg + ((long)((seq * 8 + h) * 2 + 1) * NCHUNK + chunk) * 8192 + 4096;
      const float gj0 = sgc[j], gj1 = sgc[64 + j];
#pragma unroll
      for (int r = 0; r < 16; ++r) {
        const int i = qi * 32 + crow(r, hi);
        const float e0 = __expf(fminf(sgc[i] - gj0, 0.f)), e1 = __expf(fminf(sgc[64 + i] - gj1, 0.f));
        if (kind == 0) {
          M0[i * 64 + j] = j < i ? sbeta[i] * acc[r] * e0 : 0.f;
          M0[4096 + (63 - i) * 64 + (63 - j)] = j > i ? sbeta[64 + i] * acc[r] * e1 : 0.f;
        } else {
          Ag0[i * 64 + j] = f2bf(j <= i ? acc[r] * e0 : 0.f);
          Ag1[i * 64 + j] = f2bf(j >= i ? acc[r] * e1 : 0.f);
        }
        SBAR();
      }
    }
    __syncthreads();
    if (wid < 2) {
      const int d = wid; const float* M = M0 + d * 4096; float* Tl = M0 + 8192 + d * 4096;
#pragma unroll 4
      for (int a = 0; a < 64; ++a) Tl[a * 64 + lane] = 0.f;
#pragma unroll 1
      for (int a = 0; a < 64; ++a) {
        float acc = (a == lane) ? 1.f : 0.f;
        const int nb4 = (a + 3) >> 2;
#pragma unroll 2
        for (int b4 = 0; b4 < nb4; ++b4) {
          const f32x4 m = *(const f32x4*)(M + a * 64 + b4 * 4);
          acc -= m[0] * Tl[(b4 * 4 + 0) * 64 + lane]; acc -= m[1] * Tl[(b4 * 4 + 1) * 64 + lane];
          acc -= m[2] * Tl[(b4 * 4 + 2) * 64 + lane]; acc -= m[3] * Tl[(b4 * 4 + 3) * 64 + lane];
        }
        Tl[a * 64 + lane] = acc;
      }
      u16* Tg = TQg + ((long)((seq * 8 + h) * 2 + d) * NCHUNK + chunk) * 8192;
#pragma unroll 4
      for (int a = 0; a < 64; ++a) {
        const float tv = Tl[a * 64 + lane];
        if (d == 0) Tg[a * 64 + lane] = f2bf(tv); else Tg[(63 - a) * 64 + (63 - lane)] = f2bf(tv);
      }
    }
  }
}

DI bf16x8 pack8(f32x4 a, f32x4 b) { u32x4 w = {pk2(a[0], a[1]), pk2(a[2], a[3]), pk2(b[0], b[1]), pk2(b[2], b[3])}; return __builtin_bit_cast(bf16x8, w); }
DI bf16x8 ld_frag(const char* ptr) { u32x2 lo = *(const u32x2*)ptr; u32x2 hi = *(const u32x2*)(ptr + 32); u32x4 w = {lo[0], lo[1], hi[0], hi[1]}; return __builtin_bit_cast(bf16x8, w); }
#define MFMA16(a, b, c) __builtin_amdgcn_mfma_f32_16x16x32_bf16((a), (b), (c), 0, 0, 0)
constexpr int SB_Q = 0, SB_K = 17408, SB_KT = 34816, SB_T = 53248, SB_A = 62464, SB_V = 71680, SB_SC = 79872, SB_SIZE = 80896;

DI void scan_load(const Params& p, int seq, int h, int dir, int dvq, int cc, char* B, int lt) {
  const u16* P = (const u16*)(p.ws + OFF_P);
  const long R0 = (long)seq * TP + cc * 64;
  const u16* Pq = P + R0 * 4096 + h * 128; const u16* Pk = Pq + 1024; const u16* Pv = P + R0 * 4096 + 2048 + h * 256 + dvq * 64;
  const u16* KTg = (const u16*)(p.ws + OFF_KT) + ((long)(seq * 8 + h) * NCHUNK + cc) * 8192;
  const u16* Tg = (const u16*)(p.ws + OFF_TQ) + ((long)((seq * 8 + h) * 2 + dir) * NCHUNK + cc) * 8192;
  const float* SCg = (const float*)(p.ws + OFF_SC) + ((long)((seq * 8 + h) * 2 + dir) * TP + cc * 64) * 4;
  u32x4 rq[4], rk[4], rkt[4], rt[2], ra[2], rv[2]; f32x4 rs = {0.f, 0.f, 0.f, 0.f};
#pragma unroll
  for (int i = 0; i < 4; ++i) { const int e = lt + 256 * i, row = e >> 4, c = e & 15;
    rq[i] = *(const u32x4*)(Pq + (long)row * 4096 + c * 8); rk[i] = *(const u32x4*)(Pk + (long)row * 4096 + c * 8); }
#pragma unroll
  for (int i = 0; i < 4; ++i) { const int e = lt + 256 * i, row = e >> 3, c = e & 7; rkt[i] = *(const u32x4*)(KTg + row * 64 + c * 8); }
#pragma unroll
  for (int i = 0; i < 2; ++i) { const int e = lt + 256 * i, row = e >> 3, c = e & 7;
    rt[i] = *(const u32x4*)(Tg + row * 64 + c * 8); ra[i] = *(const u32x4*)(Tg + 4096 + row * 64 + c * 8);
    rv[i] = *(const u32x4*)(Pv + (long)row * 4096 + c * 8); }
  if (lt < 64) rs = *(const f32x4*)(SCg + lt * 4);
#pragma unroll
  for (int i = 0; i < 4; ++i) { const int e = lt + 256 * i, row = e >> 4, c = e & 15;
    *(u32x4*)(B + SB_Q + row * 272 + c * 16) = rq[i]; *(u32x4*)(B + SB_K + row * 272 + c * 16) = rk[i]; }
#pragma unroll
  for (int i = 0; i < 4; ++i) { const int e = lt + 256 * i, row = e >> 3, c = e & 7; *(u32x4*)(B + SB_KT + row * 144 + c * 16) = rkt[i]; }
#pragma unroll
  for (int i = 0; i < 2; ++i) { const int e = lt + 256 * i, row = e >> 3, c = e & 7;
    *(u32x4*)(B + SB_T + row * 144 + c * 16) = rt[i]; *(u32x4*)(B + SB_A + row * 144 + c * 16) = ra[i];
    *(u32x4*)(B + SB_V + row * 128 + c * 16) = rv[i]; }
  if (lt < 64) *(f32x4*)(B + SB_SC + lt * 16) = rs;
}

DI void phase_scan(const Params& p, char* lds) {
  for (int item = blockIdx.x; item < GS * 8 * 2 * 4; item += gridDim.x) {
    const int tid = otid(), wid = tid >> 6, lane = tid & 63, n = lane & 15, quad = lane >> 4;
    const int dvq = item & 3, dir = (item >> 2) & 1, h = (item >> 3) & 7, seq = item >> 6;
    u16* O = (u16*)(p.ws + (dir ? OFF_OB : OFF_OF));
    f32x4 S[8];
#pragma unroll
    for (int t = 0; t < 8; ++t) S[t] = (f32x4){0.f, 0.f, 0.f, 0.f};
    __syncthreads();
    if (wid >= 4) scan_load(p, seq, h, dir, dvq, dir ? NCHUNK - 1 : 0, lds, tid - 256);
    __syncthreads();
#pragma unroll 1
    for (int c = 0; c < NCHUNK; ++c) {
      const int cc = dir ? NCHUNK - 1 - c : c;
      if (wid >= 4) {
        if (c + 1 < NCHUNK) scan_load(p, seq, h, dir, dvq, dir ? NCHUNK - 2 - c : c + 1, lds + ((c + 1) & 1) * SB_SIZE, tid - 256);
      } else {
        const char* B = lds + (c & 1) * SB_SIZE;
        const long R0 = (long)seq * TP + cc * 64;
        bf16x8 Sb[4];
#pragma unroll
        for (int ks = 0; ks < 4; ++ks) Sb[ks] = pack8(S[2 * ks], S[2 * ks + 1]);
        f32x4 KS[4], QS[4];
#pragma unroll
        for (int mt = 0; mt < 4; ++mt) {
          KS[mt] = (f32x4){0.f, 0.f, 0.f, 0.f}; QS[mt] = (f32x4){0.f, 0.f, 0.f, 0.f};
#pragma unroll
          for (int ks = 0; ks < 4; ++ks) {
            const int off = (16 * mt + n) * 272 + 64 * ks + 8 * quad;
            KS[mt] = MFMA16(ld_frag(B + SB_K + off), Sb[ks], KS[mt]);
            QS[mt] = MFMA16(ld_frag(B + SB_Q + off), Sb[ks], QS[mt]);
          }
        }
        f32x4 rhs[4], egc[4], ekd[4]; float egl = 1.f;
#pragma unroll
        for (int mt = 0; mt < 4; ++mt)
#pragma unroll
          for (int i = 0; i < 4; ++i) {
            const int row = 16 * mt + 4 * quad + i;
            const f32x4 sc = *(const f32x4*)(B + SB_SC + row * 16);
            const float v = bf2f(*(const u16*)(B + SB_V + row * 128 + (wid * 16 + n) * 2));
            egc[mt][i] = sc[1]; ekd[mt][i] = sc[2]; egl = sc[3];
            rhs[mt][i] = sc[0] * (v - sc[1] * KS[mt][i]);
          }
        bf16x8 Rb[2];
#pragma unroll
        for (int k2 = 0; k2 < 2; ++k2) Rb[k2] = pack8(rhs[2 * k2], rhs[2 * k2 + 1]);
        f32x4 VN[4];
#pragma unroll
        for (int mt = 0; mt < 4; ++mt) {
          VN[mt] = (f32x4){0.f, 0.f, 0.f, 0.f};
#pragma unroll
          for (int k2 = 0; k2 < 2; ++k2) VN[mt] = MFMA16(ld_frag(B + SB_T + (16 * mt + n) * 144 + 64 * k2 + 8 * quad), Rb[k2], VN[mt]);
        }
        bf16x8 Vb[2], Vd[2];
#pragma unroll
        for (int k2 = 0; k2 < 2; ++k2) {
          Vb[k2] = pack8(VN[2 * k2], VN[2 * k2 + 1]);
          Vd[k2] = pack8(VN[2 * k2] * ekd[2 * k2], VN[2 * k2 + 1] * ekd[2 * k2 + 1]);
        }
#pragma unroll
        for (int mt = 0; mt < 4; ++mt) {
          f32x4 o = QS[mt] * egc[mt];
#pragma unroll
          for (int k2 = 0; k2 < 2; ++k2) o = MFMA16(ld_frag(B + SB_A + (16 * mt + n) * 144 + 64 * k2 + 8 * quad), Vb[k2], o);
#pragma unroll
          for (int i = 0; i < 4; ++i) O[(R0 + 16 * mt + 4 * quad + i) * 2048 + h * 256 + dvq * 64 + wid * 16 + n] = f2bf(o[i]);
        }
#pragma unroll
        for (int t = 0; t < 8; ++t) {
          S[t] = S[t] * egl;
#pragma unroll
          for (int k2 = 0; k2 < 2; ++k2) S[t] = MFMA16(ld_frag(B + SB_KT + (16 * t + n) * 144 + 64 * k2 + 8 * quad), Vd[k2], S[t]);
        }
      }
      __syncthreads();
    }
  }
}

DI void phase_gate(const Params& p) {
  u16* OFp = (u16*)(p.ws + OFF_OF); const u16* OBp = (const u16*)(p.ws + OFF_OB); const u16* Z = (const u16*)(p.ws + OFF_Z);
  const int lane = otid() & 63, wv = otid() >> 6;
  for (int it = blockIdx.x * 8 + wv; it < GR * 8; it += gridDim.x * 8) {
    const long off = (long)it * 256 + lane * 4;
    u32x2 a = *(const u32x2*)(OFp + off), b = *(const u32x2*)(OBp + off), z = *(const u32x2*)(Z + off);
    float o0 = bflo(a[0]) + bflo(b[0]), o1 = bfhi(a[0]) + bfhi(b[0]), o2 = bflo(a[1]) + bflo(b[1]), o3 = bfhi(a[1]) + bfhi(b[1]);
    float ss = wave_sum(o0 * o0 + o1 * o1 + o2 * o2 + o3 * o3);
    float rs = rsqrtf(ss * (1.f / 256.f) + EPS);
    u32x2 w = {pk2(o0 * rs * silu(bflo(z[0])), o1 * rs * silu(bfhi(z[0]))), pk2(o2 * rs * silu(bflo(z[1])), o3 * rs * silu(bfhi(z[1])))};
    *(u32x2*)(OFp + off) = w;
  }
}

DI void phase_rowstats(const Params& p) {
  const u16* CQ = (const u16*)(p.ws + OFF_CQ); const u16* CKV = (const u16*)(p.ws + OFF_CKV); const float* KPE = (const float*)(p.ws + OFF_KPE);
  float* rowst = (float*)(p.ws + OFF_ROWST); float* kper = (float*)(p.ws + OFF_KPER); const float* rope = (const float*)(p.ws + OFF_ROPE);
  const int lane = otid() & 63, wv = otid() >> 6;
  for (int row = blockIdx.x * 8 + wv; row < GR; row += gridDim.x * 8) {
    u32x4 q = *(const u32x4*)(CQ + (long)row * 512 + lane * 8);
    float sq = 0.f;
#pragma unroll
    for (int j = 0; j < 4; ++j) { float a = bflo(q[j]), b = bfhi(q[j]); sq += a * a + b * b; }
    u32x2 kv = *(const u32x2*)(CKV + (long)row * 256 + lane * 4);
    float sk = 0.f;
#pragma unroll
    for (int j = 0; j < 2; ++j) { float a = bflo(kv[j]), b = bfhi(kv[j]); sk += a * a + b * b; }
    const float kp = KPE[(long)row * 64 + lane];
    sq = wave_sum(sq); sk = wave_sum(sk); const float sp = wave_sum(kp * kp);
    const float val = kp * p.m_kg[128 + lane];
    const float oth = __shfl_xor(val, 32, 64);
    int pos = row % TP - PADR; pos = pos < 0 ? 0 : pos;
    const int i = lane & 31; const float c = rope[pos * 64 + i], s = rope[pos * 64 + 32 + i];
    kper[(long)row * 64 + lane] = lane < 32 ? val * c - oth * s : val * c + oth * s;
    if (lane == 0) { f32x4 st = {rsqrtf(sq * (1.f / 512.f) + EPS), rsqrtf(sk * (1.f / 256.f) + EPS), sp, 0.f}; *(f32x4*)(rowst + (long)row * 4) = st; }
  }
}

constexpr float ATT_SCALE = 0.07216878364870322f;
constexpr float ATT_THR = 8.f;
constexpr int SHM_V = 64 * 128 * 2, SHM_K = 64 * 192 * 2;
DI int v_st(int k, int c) { const int kk = (k & ~0xC) | ((k & 4) << 1) | ((k & 8) >> 1); return ((kk >> 3) * 4 + (c >> 5)) * 512 + ((kk & 7) * 32 + (c & 31)) * 2; }
DI int v_rd_base(int lane) { return ((lane & 3) << 3) | (((lane >> 2) & 3) << 6) | (((lane >> 4) & 1) << 5) | (((lane >> 5) & 1) << 8); }
constexpr int v_rd_off(int d0, int ks, int half) { return d0 * 512 + ks * 4096 + half * 2048; }
template <int OFF> DI s16x4 tr_read(int vb) {
  s16x4 r; asm volatile("ds_read_b64_tr_b16 %0, %1 offset:%2" : "=&v"(r) : "v"(vb), "i"(OFF) : "memory"); return r;
}
template <int D0> DI void pv_one(f32x16& od, int vb, bf16x8 pa0, bf16x8 pa1, bf16x8 pa2, bf16x8 pa3) {
  const s16x4 l0 = tr_read<v_rd_off(D0, 0, 0)>(vb), h0 = tr_read<v_rd_off(D0, 0, 1)>(vb), l1 = tr_read<v_rd_off(D0, 1, 0)>(vb), h1 = tr_read<v_rd_off(D0, 1, 1)>(vb);
  const s16x4 l2 = tr_read<v_rd_off(D0, 2, 0)>(vb), h2 = tr_read<v_rd_off(D0, 2, 1)>(vb), l3 = tr_read<v_rd_off(D0, 3, 0)>(vb), h3 = tr_read<v_rd_off(D0, 3, 1)>(vb);
  asm volatile("s_waitcnt lgkmcnt(0)" ::: "memory"); SBAR();
#define PKV(L, H) (bf16x8){L[0], L[1], L[2], L[3], H[0], H[1], H[2], H[3]}
  od = __builtin_amdgcn_mfma_f32_32x32x16_bf16(pa0, PKV(l0, h0), od, 0, 0, 0);
  od = __builtin_amdgcn_mfma_f32_32x32x16_bf16(pa1, PKV(l1, h1), od, 0, 0, 0);
  od = __builtin_amdgcn_mfma_f32_32x32x16_bf16(pa2, PKV(l2, h2), od, 0, 0, 0);
  od = __builtin_amdgcn_mfma_f32_32x32x16_bf16(pa3, PKV(l3, h3), od, 0, 0, 0);
#undef PKV
}

DI void attn_item(const u16* __restrict__ Qb, const u16* __restrict__ Kh, const u16* __restrict__ Vh, int q0,
                  u16* __restrict__ Yb, const u16* __restrict__ Zb, char* lds) {
  const int tid = otid(), wid = tid >> 6, lane = tid & 63, r32 = lane & 31, hi = lane >> 5;
  char* V_lds = lds; char* K_lds = lds + 2 * SHM_V;
  float* wsf = (float*)(lds + 2 * SHM_V + 2 * SHM_K) + wid * 64; float* li_l = wsf; float* al_l = wsf + 32;
  constexpr float C = ATT_SCALE * 1.4426950408889634f;
  float m_reg = -1e30f, l_reg = 0.f;
  f32x16 o[4];
#pragma unroll
  for (int d = 0; d < 4; ++d)
#pragma unroll
    for (int r = 0; r < 16; ++r) o[d][r] = 0.f;
  bf16x8 qr[12];
  const int qrow = q0 + wid * 32 + r32;
#pragma unroll
  for (int d0 = 0; d0 < 12; ++d0) {
    bf16x8 z = {0, 0, 0, 0, 0, 0, 0, 0};
    qr[d0] = qrow < TP ? *(const bf16x8*)(Qb + (long)qrow * 192 + d0 * 16 + hi * 8) : z;
  }
  const int sr = tid >> 4, sc = (tid & 15) * 8, vst0 = v_st(sr, sc), vst1 = v_st(32 + sr, sc);
  const int vb0 = (int)(uintptr_t)V_lds + v_rd_base(lane);
  u32x4 kst[3], vst[2];
#define KLOAD(k0) do { _Pragma("unroll") for (int i = 0; i < 3; ++i) { int q = tid + 512 * i; int row = q / 24, c = q % 24; \
      kst[i] = *(const u32x4*)(Kh + (long)((k0) + row) * 192 + c * 8); } } while (0)
#define VLOAD(k0) do { vst[0] = *(const u32x4*)(Vh + (long)((k0) + sr) * 128 + sc); vst[1] = *(const u32x4*)(Vh + (long)((k0) + 32 + sr) * 128 + sc); } while (0)
#define KWRITE(b) do { _Pragma("unroll") for (int i = 0; i < 3; ++i) { int q = tid + 512 * i; int row = q / 24, c = q % 24; \
      *(u32x4*)(K_lds + (b) * SHM_K + row * 384 + ((c * 16) ^ ((row & 7) << 4))) = kst[i]; } } while (0)
#define VWRITE(b) do { *(u32x4*)(V_lds + (b) * SHM_V + vst0) = vst[0]; *(u32x4*)(V_lds + (b) * SHM_V + vst1) = vst[1]; } while (0)
  constexpr int NT = TP / 64;
  __syncthreads();
  KLOAD(0); VLOAD(0); KWRITE(0); VWRITE(0); VLOAD(64);
  __syncthreads();
#pragma unroll 1
  for (int j = 0; j < NT; ++j) {
    const int cur = j & 1;
    f32x16 p0, p1;
#pragma unroll
    for (int r = 0; r < 16; ++r) { p0[r] = 0.f; p1[r] = 0.f; }
    const char* Kc = K_lds + cur * SHM_K;
#pragma unroll
    for (int d0 = 0; d0 < 12; ++d0) {
      const int cb = (d0 * 16 + hi * 8) * 2;
      bf16x8 b0 = *(const bf16x8*)(Kc + r32 * 384 + (cb ^ ((r32 & 7) << 4)));
      bf16x8 b1 = *(const bf16x8*)(Kc + (32 + r32) * 384 + (cb ^ ((r32 & 7) << 4)));
      p0 = __builtin_amdgcn_mfma_f32_32x32x16_bf16(b0, qr[d0], p0, 0, 0, 0);
      p1 = __builtin_amdgcn_mfma_f32_32x32x16_bf16(b1, qr[d0], p1, 0, 0, 0);
      if ((d0 & 1) == 1) SBAR();
    }
    if (j + 1 < NT) { VWRITE(cur ^ 1); KLOAD((j + 1) * 64); }
    if (j == 0) {
#pragma unroll
      for (int r = 0; r < 16; ++r) p0[r] = -1e30f;
#pragma unroll
      for (int r = 0; r < 8; ++r) p1[r] = -1e30f;
    }
    float pmax = p0[0];
#pragma unroll
    for (int r = 1; r < 16; ++r) pmax = fmaxf(pmax, p0[r]);
#pragma unroll
    for (int r = 0; r < 16; ++r) pmax = fmaxf(pmax, p1[r]);
    { auto rr = __builtin_amdgcn_permlane32_swap(__float_as_uint(pmax), __float_as_uint(pmax), false, false);
      pmax = fmaxf(__uint_as_float(rr[0]), __uint_as_float(rr[1])); }
    float mn, alpha;
    if (__all(pmax - m_reg <= ATT_THR / ATT_SCALE)) { mn = m_reg; alpha = 1.f; }
    else { mn = fmaxf(m_reg, pmax); alpha = __builtin_amdgcn_exp2f((m_reg - mn) * C); m_reg = mn; }
    if (__any(alpha < 1.f)) {
      if (hi == 0) al_l[r32] = alpha;
      asm volatile("s_waitcnt lgkmcnt(0)" ::: "memory");
#pragma unroll
      for (int r = 0; r < 16; ++r) { const float a = al_l[crow(r, hi)];
#pragma unroll
        for (int d = 0; d < 4; ++d) o[d][r] *= a; }
    }
    const float mnC = -mn * C;
    float ps = 0.f;
#pragma unroll
    for (int r = 0; r < 16; ++r) { p0[r] = __builtin_amdgcn_exp2f(fmaf(p0[r], C, mnC)); p1[r] = __builtin_amdgcn_exp2f(fmaf(p1[r], C, mnC)); ps += p0[r] + p1[r]; }
    { auto rr = __builtin_amdgcn_permlane32_swap(__float_as_uint(ps), __float_as_uint(ps), false, false);
      ps = __uint_as_float(rr[0]) + __uint_as_float(rr[1]); }
    l_reg = l_reg * alpha + ps;
    bf16x8 pa0, pa1, pa2, pa3;
#define PK4(PP, BASE, OUT) do { unsigned a0 = pk2(PP[BASE + 0], PP[BASE + 1]), a1 = pk2(PP[BASE + 2], PP[BASE + 3]); \
    unsigned b0 = pk2(PP[BASE + 4], PP[BASE + 5]), b1 = pk2(PP[BASE + 6], PP[BASE + 7]); \
    auto r0 = __builtin_amdgcn_permlane32_swap(a0, b0, false, false); auto r1 = __builtin_amdgcn_permlane32_swap(a1, b1, false, false); \
    u32x4 w = {r0[0], r1[0], r0[1], r1[1]}; OUT = __builtin_bit_cast(bf16x8, w); } while (0)
    PK4(p0, 0, pa0); PK4(p0, 8, pa1); PK4(p1, 0, pa2); PK4(p1, 8, pa3);
#undef PK4
    const int vb = vb0 + cur * SHM_V;
    pv_one<0>(o[0], vb, pa0, pa1, pa2, pa3); pv_one<1>(o[1], vb, pa0, pa1, pa2, pa3);
    pv_one<2>(o[2], vb, pa0, pa1, pa2, pa3); pv_one<3>(o[3], vb, pa0, pa1, pa2, pa3);
    if (j + 1 < NT) { KWRITE(cur ^ 1); if (j + 2 < NT) VLOAD((j + 2) * 64); }
    __syncthreads();
  }
#undef KLOAD
#undef VLOAD
#undef KWRITE
#undef VWRITE
  if (hi == 0) li_l[r32] = l_reg;
  asm volatile("s_waitcnt lgkmcnt(0)" ::: "memory");
#pragma unroll
  for (int r = 0; r < 16; ++r) {
    const int orow = q0 + wid * 32 + crow(r, hi);
    const float rl = 1.f / li_l[crow(r, hi)];
    if (orow < TP) {
#pragma unroll
      for (int d0 = 0; d0 < 4; ++d0) {
        const long off = (long)orow * 2048 + d0 * 32 + r32;
        Yb[off] = f2bf(o[d0][r] * rl * silu(bf2f(Zb[off])));
      }
    }
  }
}

DI void phase_attn(const Params& p, char* lds) {
  const u16* QM = (const u16*)(p.ws + OFF_QM); const u16* KM = (const u16*)(p.ws + OFF_KM); const u16* VM = (const u16*)(p.ws + OFF_VM);
  u16* Y = (u16*)(p.ws + OFF_Y); const u16* Z = (const u16*)(p.ws + OFF_Z);
  const int b = blockIdx.x, x = b & 7, lb = b >> 3;
  if (gridDim.x == 256) {
    for (int it = 0; it < 5; ++it) {
      int pair, qb;
      if (it < 4) { pair = x + 8 * (2 * it + (lb >> 4)); qb = lb & 15; }
      else { if (b >= 64) break; pair = b; qb = 16; }
      const int seq = pair >> 4, head = pair & 15;
      attn_item(QM + (long)pair * TP * 192, KM + (long)pair * TP * 192, VM + (long)pair * TP * 128, qb * 256,
                Y + (long)seq * TP * 2048 + head * 128, Z + (long)seq * TP * 2048 + head * 128, lds);
    }
  } else {
    for (int item = b; item < 64 * 17; item += gridDim.x) {
      const int pair = item / 17, qb = item % 17; const int seq = pair >> 4, head = pair & 15;
      attn_item(QM + (long)pair * TP * 192, KM + (long)pair * TP * 192, VM + (long)pair * TP * 128, qb * 256,
                Y + (long)seq * TP * 2048 + head * 128, Z + (long)seq * TP * 2048 + head * 128, lds);
    }
  }
}

__global__ void __launch_bounds__(512) fwd_mega(Params p) {
  extern __shared__ __attribute__((aligned(16))) char lds[];
  cg::grid_group grid = cg::this_grid();
  char* ws = p.ws;
  phase_prep(p, lds);
  for (int g = 0; g < NGRP; ++g) {
    phase_hn(p, g, 0);
    grid.sync();
    { EpiGin e{(u16*)(ws + OFF_P), (u16*)(ws + OFF_HALO), (u16*)(ws + OFF_Z), (float*)(ws + OFF_BA)};
      gemm_phase<4, 2, 2, 2>((const u16*)(ws + OFF_HN), 1024, (const u16*)(ws + OFF_WGIN), 1024, 1024, GINP, lds, e); }
    grid.sync();
    phase_chunk(p, lds);
    grid.sync();
    phase_scan(p, lds);
    grid.sync();
    phase_gate(p);
    grid.sync();
    { EpiGout e{p, g, (float*)(ws + OFF_H1M)};
      gemm_phase<4, 2, 2, 2>((const u16*)(ws + OFF_OF), 2048, (const u16*)(ws + OFF_WGOUT), 2048, 2048, 1024, lds, e); }
    grid.sync();
    phase_hn(p, g, 1);
    grid.sync();
    { EpiMin e{(u16*)(ws + OFF_CQ), (u16*)(ws + OFF_CKV), (u16*)(ws + OFF_Z), (float*)(ws + OFF_KPE)};
      gemm_phase<4, 2, 2, 2>((const u16*)(ws + OFF_HN), 1024, (const u16*)(ws + OFF_WMIN), 1024, 1024, MINP, lds, e); }
    grid.sync();
    phase_rowstats(p);
    grid.sync();
    { EpiQ e{(const float*)(ws + OFF_ROWST), p.m_qg, (const float*)(ws + OFF_ROPE), (u16*)(ws + OFF_QM)};
      gemm_phase<8, 1, 1, 6>((const u16*)(ws + OFF_CQ), 512, (const u16*)(ws + OFF_WUQ), 512, 512, 3072, lds, e); }
    { EpiKV e{(const float*)(ws + OFF_ROWST), p.m_kg, (const float*)(ws + OFF_KPER), (u16*)(ws + OFF_KM), (u16*)(ws + OFF_VM)};
      gemm_phase<8, 1, 1, 4>((const u16*)(ws + OFF_CKV), 256, (const u16*)(ws + OFF_WUKV), 256, 256, 4096, lds, e); }
    grid.sync();
    phase_attn(p, lds);
    grid.sync();
    { EpiMout e{p.out, g};
      gemm_phase<4, 2, 2, 2>((const u16*)(ws + OFF_Y), 2048, (const u16*)(ws + OFF_WMOUT), 2048, 2048, 1024, lds, e); }
    grid.sync();
  }
}

extern "C" void kernel_launch(void* const* d_in, const int* in_sizes, int n_in,
                              void* d_out, int out_size, void* d_ws, size_t ws_size,
                              hipStream_t stream) {
  static int grid_blocks = 0;
  if (!grid_blocks) {
    int dev = 0, cus = 0, per_cu = 0;
    (void)hipGetDevice(&dev);
    (void)hipDeviceGetAttribute(&cus, hipDeviceAttributeMultiprocessorCount, dev);
    (void)hipFuncSetAttribute((const void*)fwd_mega, hipFuncAttributeMaxDynamicSharedMemorySize, LDS_BYTES);
    (void)hipOccupancyMaxActiveBlocksPerMultiprocessor(&per_cu, fwd_mega, 512, LDS_BYTES);
    if (per_cu < 1) { fprintf(stderr, "occupancy query returned %d\n", per_cu); per_cu = 1; }
    if (per_cu > 1) per_cu = 1;
    grid_blocks = cus * per_cu;
  }
  if (ws_size < WS_NEED) { fprintf(stderr, "workspace too small: %zu < %zu\n", ws_size, (size_t)WS_NEED); return; }
  Params p{};
  p.xp = (const float*)d_in[0]; p.xs = (const float*)d_in[1]; p.meta = (const float*)d_in[2]; p.ln_g = (const float*)d_in[3];
  p.g_win = (const float*)d_in[4]; p.g_conv = (const float*)d_in[5]; p.g_alog = (const float*)d_in[6]; p.g_dtb = (const float*)d_in[7];
  p.g_onorm = (const float*)d_in[8]; p.g_wout = (const float*)d_in[9]; p.m_win = (const float*)d_in[10]; p.m_qn = (const float*)d_in[11];
  p.m_kvn = (const float*)d_in[12]; p.m_wuq = (const float*)d_in[13]; p.m_wukv = (const float*)d_in[14]; p.m_qg = (const float*)d_in[15];
  p.m_kg = (const float*)d_in[16]; p.m_wout = (const float*)d_in[17]; p.out = (float*)d_out; p.ws = (char*)d_ws;
  void* args[] = {&p};
  hipError_t e = hipLaunchCooperativeKernel((void*)fwd_mega, dim3(grid_blocks), dim3(512), args, LDS_BYTES, stream);
  if (e != hipSuccess) fprintf(stderr, "cooperative launch failed: %s (grid %d)\n", hipGetErrorString(e), grid_blocks);
}
```

```cpp
#include <hip/hip_runtime.h>
#include <hip/hip_cooperative_groups.h>
#include <cstdio>
#include <cstdint>
namespace cg = cooperative_groups;

typedef unsigned short u16;
typedef __bf16 bf2_t __attribute__((ext_vector_type(2)));
typedef float f2_t __attribute__((ext_vector_type(2)));
using bf16x8 = __attribute__((ext_vector_type(8))) short;
using s16x4  = __attribute__((ext_vector_type(4))) short;
using f32x16 = __attribute__((ext_vector_type(16))) float;
using f32x4  = __attribute__((ext_vector_type(4))) float;
using u32x4  = __attribute__((ext_vector_type(4))) unsigned;
using u32x2  = __attribute__((ext_vector_type(2))) unsigned;
#define DI __device__ __forceinline__
#define SBAR() __builtin_amdgcn_sched_barrier(0)

DI unsigned pk2(float a, float b) { f2_t v = {a, b}; bf2_t r = __builtin_convertvector(v, bf2_t); return __builtin_bit_cast(unsigned, r); }
DI u16 f2bf(float a) { return (u16)(pk2(a, 0.f) & 0xffffu); }
DI float bf2f(u16 v) { return __uint_as_float(((unsigned)v) << 16); }
DI float bflo(unsigned v) { return __uint_as_float(v << 16); }
DI float bfhi(unsigned v) { return __uint_as_float(v & 0xffff0000u); }
DI int otid() { int t = __builtin_amdgcn_workitem_id_x(); asm volatile("" : "+v"(t)); return t; }
DI int crow(int r, int hi) { return (r & 3) + 8 * (r >> 2) + 4 * hi; }
DI float wave_sum(float v) {
#pragma unroll
  for (int m = 32; m >= 1; m >>= 1) v += __shfl_xor(v, m, 64);
  return v;
}
DI float silu(float x) { return x / (1.f + __expf(-x)); }

constexpr int D = 1024, TP = 4160, GS = 4, GR = GS * TP, NGRP = 3, PADR = 48, SEQ = 4096;
constexpr int GIN = 6176, GINP = 6400, MIN_ = 2880, MINP = 2944;
constexpr float EPS = 1e-6f;
constexpr int NCHUNK = 65;

constexpr size_t al256(size_t x) { return (x + 255) / 256 * 256; }
constexpr size_t OFF_WGIN  = 0;
constexpr size_t OFF_WGOUT = OFF_WGIN  + al256((size_t)GINP * 1024 * 2);
constexpr size_t OFF_WMIN  = OFF_WGOUT + al256((size_t)1024 * 2048 * 2);
constexpr size_t OFF_WUQ   = OFF_WMIN  + al256((size_t)MINP * 1024 * 2);
constexpr size_t OFF_WUKV  = OFF_WUQ   + al256((size_t)3072 * 512 * 2);
constexpr size_t OFF_WMOUT = OFF_WUKV  + al256((size_t)4096 * 256 * 2);
constexpr size_t OFF_ROPE  = OFF_WMOUT + al256((size_t)1024 * 2048 * 2);
constexpr size_t OFF_H1M   = OFF_ROPE  + al256((size_t)4112 * 64 * 4);
constexpr size_t OFF_HN    = OFF_H1M   + al256((size_t)12 * 16 * 1024 * 4);
constexpr size_t OFF_Z     = OFF_HN    + al256((size_t)GR * 1024 * 2);
constexpr size_t OFF_R     = OFF_Z     + al256((size_t)GR * 2048 * 2);
constexpr size_t OFF_P     = OFF_R;
constexpr size_t OFF_HALO  = OFF_P     + al256((size_t)GR * 4096 * 2);
constexpr size_t OFF_BA    = OFF_HALO  + al256((size_t)(GR / 64) * 4 * 4096 * 2);
constexpr size_t OFF_SC    = OFF_BA    + al256((size_t)GR * 32 * 4);
constexpr size_t OFF_TQ    = OFF_SC    + al256((size_t)GS * 8 * 2 * TP * 16);
constexpr size_t OFF_KT    = OFF_TQ    + al256((size_t)GS * 8 * 2 * NCHUNK * 16384);
constexpr size_t OFF_OF    = OFF_KT    + al256((size_t)GS * 8 * NCHUNK * 16384);
constexpr size_t OFF_OB    = OFF_OF    + al256((size_t)GR * 2048 * 2);
constexpr size_t END_GDN   = OFF_OB    + al256((size_t)GR * 2048 * 2);
constexpr size_t OFF_CQ    = OFF_R;
constexpr size_t OFF_CKV   = OFF_CQ    + al256((size_t)GR * 512 * 2);
constexpr size_t OFF_KPE   = OFF_CKV   + al256((size_t)GR * 256 * 2);
constexpr size_t OFF_ROWST = OFF_KPE   + al256((size_t)GR * 64 * 4);
constexpr size_t OFF_KPER  = OFF_ROWST + al256((size_t)GR * 4 * 4);
constexpr size_t OFF_QM    = OFF_KPER  + al256((size_t)GR * 64 * 4);
constexpr size_t OFF_KM    = OFF_QM    + al256((size_t)GR * 16 * 192 * 2);
constexpr size_t OFF_VM    = OFF_KM    + al256((size_t)GR * 16 * 192 * 2);
constexpr size_t OFF_Y     = OFF_VM    + al256((size_t)GR * 16 * 128 * 2);
constexpr size_t END_MLA   = OFF_Y     + al256((size_t)GR * 2048 * 2);
constexpr size_t OFF_BAR   = END_MLA > END_GDN ? END_MLA : END_GDN;
constexpr size_t WS_NEED   = OFF_BAR + 16384;

constexpr int LDS_BYTES = 160 * 1024;
#ifndef REP_ATTN
#define REP_ATTN 1
#endif
#ifndef REP_SCAN
#define REP_SCAN 1
#endif
#ifndef REP_GEMM
#define REP_GEMM 1
#endif

struct Params {
  const float *xp, *xs, *meta, *ln_g, *g_win, *g_conv, *g_alog, *g_dtb, *g_onorm, *g_wout;
  const float *m_win, *m_qn, *m_kvn, *m_wuq, *m_wukv, *m_qg, *m_kg, *m_wout;
  float* out; char* ws;
};

DI const float* h0_row(const Params& p, int sg, int pos) {
  return pos < 16 ? p.meta + (long)pos * D
                  : (sg < 4 ? p.xp + ((long)sg * SEQ + pos - 16) * D : p.xs + ((long)(sg - 4) * SEQ + pos - 16) * D);
}

DI void transpose_cvt(const float* __restrict__ src, u16* __restrict__ dst, int K, int N, int Npad,
                      const float* __restrict__ gain, int gmod, float* lds) {
  const int tid = otid();
  const int tK = K / 64, tN = Npad / 64;
  for (int tile = blockIdx.x; tile < tK * tN; tile += gridDim.x) {
    const int tk = tile % tK, tn = tile / tK;
#pragma unroll
    for (int i = 0; i < 2; ++i) {
      int kk = (tid >> 4) + 32 * i, nn = (tid & 15) * 4;
      int k = tk * 64 + kk, n = tn * 64 + nn;
      float4 v = make_float4(0.f, 0.f, 0.f, 0.f);
      if (n < N) v = *(const float4*)(src + (long)k * N + n);
      float gsc = gain ? gain[k % gmod] : 1.f;
      lds[kk * 65 + nn + 0] = v.x * gsc; lds[kk * 65 + nn + 1] = v.y * gsc;
      lds[kk * 65 + nn + 2] = v.z * gsc; lds[kk * 65 + nn + 3] = v.w * gsc;
    }
    __syncthreads();
    {
      int n = tid >> 3, k8 = (tid & 7) * 8;
      float f[8];
#pragma unroll
      for (int j = 0; j < 8; ++j) f[j] = lds[(k8 + j) * 65 + n];
      u32x4 w = {pk2(f[0], f[1]), pk2(f[2], f[3]), pk2(f[4], f[5]), pk2(f[6], f[7])};
      *(u32x4*)(dst + (long)(tn * 64 + n) * K + tk * 64 + k8) = w;
    }
    __syncthreads();
  }
}

DI void phase_prep(const Params& p, char* lds) {
  float* l = (float*)lds;
  transpose_cvt(p.g_win, (u16*)(p.ws + OFF_WGIN), 1024, GIN, GINP, p.ln_g, 1024, l);
  transpose_cvt(p.g_wout, (u16*)(p.ws + OFF_WGOUT), 2048, 1024, 1024, p.g_onorm, 256, l);
  transpose_cvt(p.m_win, (u16*)(p.ws + OFF_WMIN), 1024, MIN_, MINP, p.ln_g + 1024, 1024, l);
  transpose_cvt(p.m_wuq, (u16*)(p.ws + OFF_WUQ), 512, 3072, 3072, p.m_qn, 512, l);
  transpose_cvt(p.m_wukv, (u16*)(p.ws + OFF_WUKV), 256, 4096, 4096, p.m_kvn, 256, l);
  transpose_cvt(p.m_wout, (u16*)(p.ws + OFF_WMOUT), 2048, 1024, 1024, nullptr, 1, l);
  float* rope = (float*)(p.ws + OFF_ROPE);
  for (int i = blockIdx.x * 512 + otid(); i < 4112 * 32; i += gridDim.x * 512) {
    int pos = i >> 5, j = i & 31;
    float inv = __builtin_amdgcn_exp2f(-(float)j * (13.287712379549449f / 32.f));
    float ang = (float)pos * inv;
    float n = rintf(ang * 0.15915494309189535f);
    float rr = fmaf(-n, 6.28318548202514648f, ang); rr = fmaf(-n, -1.7484555e-7f, rr);
    float s = __sinf(rr), c = __cosf(rr);
    rope[pos * 64 + j] = c; rope[pos * 64 + 32 + j] = s;
  }
}

DI void phase_hn(const Params& p, int g, int layer) {
  const int lane = otid() & 63, wv = otid() >> 6;
  u16* HN = (u16*)(p.ws + OFF_HN);
  const float* h1m = (const float*)(p.ws + OFF_H1M);
  for (int row = blockIdx.x * 8 + wv; row < GR; row += gridDim.x * 8) {
    int seq = row / TP, r = row % TP, pos = r - PADR, sg = g * GS + seq;
    u16* dst = HN + (long)row * D;
    if (pos < 0) {
      u32x2 z = {0u, 0u};
#pragma unroll
      for (int i = 0; i < 4; ++i) *(u32x2*)(dst + i * 256 + lane * 4) = z;
      continue;
    }
    const float* src;
    if (layer == 0) src = h0_row(p, sg, pos);
    else src = pos < 16 ? h1m + ((long)sg * 16 + pos) * D : p.out + ((long)sg * SEQ + pos - 16) * D;
    float4 v[4]; float ss = 0.f;
#pragma unroll
    for (int i = 0; i < 4; ++i) { v[i] = *(const float4*)(src + i * 256 + lane * 4); ss += v[i].x * v[i].x + v[i].y * v[i].y + v[i].z * v[i].z + v[i].w * v[i].w; }
    ss = wave_sum(ss);
    float rs = rsqrtf(ss * (1.f / 1024.f) + EPS);
#pragma unroll
    for (int i = 0; i < 4; ++i) { u32x2 w = {pk2(v[i].x * rs, v[i].y * rs), pk2(v[i].z * rs, v[i].w * rs)}; *(u32x2*)(dst + i * 256 + lane * 4) = w; }
  }
}

template <int WM, int WN, int MT, int NT, class Epi>
DI void gemm_tile(const u16* __restrict__ A, int lda, const u16* __restrict__ Bt, int ldb, int K, int m0, int n0, char* lds, const Epi& epi) {
  constexpr int BM = WM * MT * 32, BN = WN * NT * 32, NA = BM * 8 / 512, NB = BN * 8 / 512;
  static_assert(WM * WN == 8, "8 waves");
  const int tid = otid(), lane = tid & 63, wid = tid >> 6, r32 = lane & 31, hi = lane >> 5;
  const int wm = wid / WN, wn = wid % WN;
  char* As = lds; char* Bs = lds + 2 * BM * 128;
  f32x16 acc[MT][NT];
#pragma unroll
  for (int a = 0; a < MT; ++a)
#pragma unroll
    for (int b = 0; b < NT; ++b)
#pragma unroll
      for (int r = 0; r < 16; ++r) acc[a][b][r] = 0.f;
  u32x4 ra[NA], rb[NB];
  const int nk = K / 64;
#define GLOAD(kt) do { _Pragma("unroll") for (int i = 0; i < NA; ++i) { int q = tid + 512 * i; int row = q >> 3, c = q & 7; \
      ra[i] = *(const u32x4*)(A + (long)(m0 + row) * lda + (kt) * 64 + c * 8); } \
    _Pragma("unroll") for (int i = 0; i < NB; ++i) { int q = tid + 512 * i; int row = q >> 3, c = q & 7; \
      rb[i] = *(const u32x4*)(Bt + (long)(n0 + row) * ldb + (kt) * 64 + c * 8); } } while (0)
#define SWRITE(buf) do { _Pragma("unroll") for (int i = 0; i < NA; ++i) { int q = tid + 512 * i; int row = q >> 3, c = q & 7; \
      *(u32x4*)(As + (buf) * BM * 128 + row * 128 + ((c ^ (row & 7)) << 4)) = ra[i]; } \
    _Pragma("unroll") for (int i = 0; i < NB; ++i) { int q = tid + 512 * i; int row = q >> 3, c = q & 7; \
      *(u32x4*)(Bs + (buf) * BN * 128 + row * 128 + ((c ^ (row & 7)) << 4)) = rb[i]; } } while (0)
  GLOAD(0); SWRITE(0); if (nk > 1) GLOAD(1);
  __syncthreads();
  for (int kt = 0; kt < nk; ++kt) {
    const int cur = kt & 1;
#pragma unroll
    for (int ks = 0; ks < 4; ++ks) {
      bf16x8 af[MT], bfr[NT];
      const int c = ks * 2 + hi;
#pragma unroll
      for (int a = 0; a < MT; ++a) { int row = (wm * MT + a) * 32 + r32; af[a] = *(const bf16x8*)(As + cur * BM * 128 + row * 128 + ((c ^ (row & 7)) << 4)); }
#pragma unroll
      for (int b = 0; b < NT; ++b) { int row = (wn * NT + b) * 32 + r32; bfr[b] = *(const bf16x8*)(Bs + cur * BN * 128 + row * 128 + ((c ^ (row & 7)) << 4)); }
#pragma unroll
      for (int a = 0; a < MT; ++a)
#pragma unroll
        for (int b = 0; b < NT; ++b) acc[a][b] = __builtin_amdgcn_mfma_f32_32x32x16_bf16(af[a], bfr[b], acc[a][b], 0, 0, 0);
    }
    if (kt + 1 < nk) { SWRITE(cur ^ 1); if (kt + 2 < nk) GLOAD(kt + 2); }
    __syncthreads();
  }
#undef GLOAD
#undef SWRITE
  epi(acc, m0 + wm * MT * 32, n0 + wn * NT * 32, lane);
}

struct EpiGin { u16 *P, *HALO, *Z; float* BA;
  DI void operator()(f32x16 (&acc)[2][2], int m0, int n0, int lane) const {
    const int r32 = lane & 31, hi = lane >> 5;
#pragma unroll
    for (int a = 0; a < 2; ++a)
#pragma unroll
      for (int b = 0; b < 2; ++b) {
        const int col = n0 + b * 32 + r32;
#pragma unroll
        for (int r = 0; r < 16; ++r) {
          const int row = m0 + a * 32 + crow(r, hi); const float v = acc[a][b][r];
          if (col < 4096) { u16 bv = f2bf(v); P[(long)row * 4096 + col] = bv; int rm = row & 63;
            if (rm < 2 || rm >= 62) HALO[((long)(row >> 6) * 4 + (rm < 2 ? rm : rm - 60)) * 4096 + col] = bv; }
          else if (col < 6144) Z[(long)row * 2048 + col - 4096] = f2bf(v);
          else if (col < GIN) BA[(long)row * 32 + col - 6144] = v;
        }
      }
  } };

struct EpiGout { Params p; int g; float* h1m;
  DI void operator()(f32x16 (&acc)[2][2], int m0, int n0, int lane) const {
    const int r32 = lane & 31, hi = lane >> 5;
#pragma unroll
    for (int a = 0; a < 2; ++a)
#pragma unroll
      for (int r = 0; r < 16; ++r) {
        const int row = m0 + a * 32 + crow(r, hi);
        const int seq = row / TP, rr = row % TP, pos = rr - PADR, sg = g * GS + seq;
        if (pos < 0) continue;
        const float* h0 = h0_row(p, sg, pos);
        float* dst = pos < 16 ? h1m + ((long)sg * 16 + pos) * D : p.out + ((long)sg * SEQ + pos - 16) * D;
#pragma unroll
        for (int b = 0; b < 2; ++b) { const int col = n0 + b * 32 + r32; dst[col] = h0[col] + acc[a][b][r]; }
      }
  } };

struct EpiMin { u16 *CQ, *CKV, *Z; float* KPE;
  DI void operator()(f32x16 (&acc)[2][2], int m0, int n0, int lane) const {
    const int r32 = lane & 31, hi = lane >> 5;
#pragma unroll
    for (int a = 0; a < 2; ++a)
#pragma unroll
      for (int b = 0; b < 2; ++b) {
        const int col = n0 + b * 32 + r32;
#pragma unroll
        for (int r = 0; r < 16; ++r) {
          const int row = m0 + a * 32 + crow(r, hi); const float v = acc[a][b][r];
          if (col < 512) CQ[(long)row * 512 + col] = f2bf(v);
          else if (col < 768) CKV[(long)row * 256 + col - 512] = f2bf(v);
          else if (col < 832) KPE[(long)row * 64 + col - 768] = v;
          else if (col < MIN_) Z[(long)row * 2048 + col - 832] = f2bf(v);
        }
      }
  } };

struct EpiQ { const float *rowst, *gq, *rope; u16* Q;
  DI void operator()(f32x16 (&acc)[1][6], int m0, int n0, int lane) const {
    const int r32 = lane & 31, hi = lane >> 5, head = n0 / 192;
    float ss[16];
#pragma unroll
    for (int r = 0; r < 16; ++r) {
      const int row = m0 + crow(r, hi); const float rq = rowst[row * 4 + 0]; float s = 0.f;
#pragma unroll
      for (int b = 0; b < 6; ++b) { acc[0][b][r] *= rq; s += acc[0][b][r] * acc[0][b][r]; }
      ss[r] = s;
    }
#pragma unroll
    for (int r = 0; r < 16; ++r) {
#pragma unroll
      for (int m = 16; m >= 1; m >>= 1) ss[r] += __shfl_xor(ss[r], m, 64);
    }
    float gc[6];
#pragma unroll
    for (int b = 0; b < 6; ++b) gc[b] = gq[b * 32 + r32];
#pragma unroll
    for (int r = 0; r < 16; ++r) {
      const int row = m0 + crow(r, hi); const int seq = row / TP, rr = row % TP; int pos = rr - PADR; pos = pos < 0 ? 0 : pos;
      const float rs = rsqrtf(ss[r] * (1.f / 192.f) + EPS);
      const float c = rope[pos * 64 + r32], s = rope[pos * 64 + 32 + r32];
      float x[6];
#pragma unroll
      for (int b = 0; b < 6; ++b) x[b] = acc[0][b][r] * rs * gc[b];
      const float x1 = x[4] * c - x[5] * s, x2 = x[5] * c + x[4] * s; x[4] = x1; x[5] = x2;
      u16* dst = Q + ((long)(seq * 16 + head) * TP + rr) * 192;
#pragma unroll
      for (int b = 0; b < 6; ++b) dst[b * 32 + r32] = f2bf(x[b]);
    }
  } };

struct EpiKV { const float *rowst, *gk, *kper; u16 *Kd, *Vd;
  DI void operator()(f32x16 (&acc)[1][4], int m0, int n0, int lane) const {
    const int r32 = lane & 31, hi = lane >> 5, head = n0 >> 8, isv = (n0 >> 7) & 1;
    if (isv) {
#pragma unroll
      for (int r = 0; r < 16; ++r) {
        const int row = m0 + crow(r, hi); const int seq = row / TP, rr = row % TP; const float rk = rowst[row * 4 + 1];
        u16* vd = Vd + ((long)(seq * 16 + head) * TP + rr) * 128;
#pragma unroll
        for (int b = 0; b < 4; ++b) vd[b * 32 + r32] = f2bf(acc[0][b][r] * rk);
      }
      return;
    }
    float ss[16];
#pragma unroll
    for (int r = 0; r < 16; ++r) {
      const int row = m0 + crow(r, hi); const float rk = rowst[row * 4 + 1]; float s = 0.f;
#pragma unroll
      for (int b = 0; b < 4; ++b) { acc[0][b][r] *= rk; s += acc[0][b][r] * acc[0][b][r]; }
      ss[r] = s;
    }
#pragma unroll
    for (int r = 0; r < 16; ++r) {
#pragma unroll
      for (int m = 16; m >= 1; m >>= 1) ss[r] += __shfl_xor(ss[r], m, 64);
    }
    float gc[4];
#pragma unroll
    for (int b = 0; b < 4; ++b) gc[b] = gk[b * 32 + r32];
#pragma unroll
    for (int r = 0; r < 16; ++r) {
      const int row = m0 + crow(r, hi); const int seq = row / TP, rr = row % TP;
      const float rs = rsqrtf((ss[r] + rowst[row * 4 + 2]) * (1.f / 192.f) + EPS);
      u16* kd = Kd + ((long)(seq * 16 + head) * TP + rr) * 192;
#pragma unroll
      for (int b = 0; b < 4; ++b) kd[b * 32 + r32] = f2bf(acc[0][b][r] * rs * gc[b]);
      kd[128 + r32] = f2bf(kper[(long)row * 64 + r32] * rs);
      kd[160 + r32] = f2bf(kper[(long)row * 64 + 32 + r32] * rs);
    }
  } };

struct EpiMout { float* out; int g;
  DI void operator()(f32x16 (&acc)[2][2], int m0, int n0, int lane) const {
    const int r32 = lane & 31, hi = lane >> 5;
#pragma unroll
    for (int a = 0; a < 2; ++a)
#pragma unroll
      for (int r = 0; r < 16; ++r) {
        const int row = m0 + a * 32 + crow(r, hi);
        const int seq = row / TP, rr = row % TP, pos = rr - PADR, sg = g * GS + seq;
        if (pos < 16) continue;
        float* dst = out + ((long)sg * SEQ + pos - 16) * D;
#pragma unroll
        for (int b = 0; b < 2; ++b) { const int col = n0 + b * 32 + r32; dst[col] += acc[a][b][r]; }
      }
  } };

template <int WM, int WN, int MT, int NT, class Epi>
DI void gemm_phase(const u16* A, int lda, const u16* Bt, int ldb, int K, int Npad, char* lds, const Epi& epi) {
  constexpr int BM = WM * MT * 32, BN = WN * NT * 32;
  const int nM = GR / BM, nN = Npad / BN;
  for (int t = blockIdx.x; t < nM * nN; t += gridDim.x) {
    const int tm = t % nM, tn = t / nM;
    gemm_tile<WM, WN, MT, NT, Epi>(A, lda, Bt, ldb, K, tm * BM, tn * BN, lds, epi);
  }
}

DI void phase_chunk(const Params& p, char* lds) {
  u16* P = (u16*)(p.ws + OFF_P); const u16* HALO = (const u16*)(p.ws + OFF_HALO);
  const float* BA = (const float*)(p.ws + OFF_BA); float* SCg = (float*)(p.ws + OFF_SC);
  u16* TQg = (u16*)(p.ws + OFF_TQ); u16* KTg = (u16*)(p.ws + OFF_KT);
  char* Qs = lds; char* Ks = lds + 16384; float* M0 = (float*)(lds + 32768);
  float* sbeta = (float*)(lds + 98304); float* sg = sbeta + 128; float* sgc = sg + 128;
  const int tid0 = otid();
  for (int item = blockIdx.x; item < GS * 8 * NCHUNK; item += gridDim.x) {
    int tid = tid0; asm volatile("" : "+v"(tid));
    const int lane = tid & 63, wid = tid >> 6, cp = tid & 255, rh = tid >> 8, part = (tid >> 6) & 3;
    const int ch = cp * 2;
    const int chunk = item % NCHUNK, h = (item / NCHUNK) % 8, seq = item / (NCHUNK * 8);
    const int col = ch < 128 ? h * 128 + ch : (ch < 256 ? 1024 + h * 128 + (ch - 128) : 2048 + h * 256 + (ch - 256));
    const int R0 = seq * TP + chunk * 64, cg_ = seq * NCHUNK + chunk;
    unsigned outv[32];
    {
      float w0[5], w1[5];
#pragma unroll
      for (int j = 0; j < 5; ++j) { w0[j] = p.g_conv[j * 4096 + col]; w1[j] = p.g_conv[j * 4096 + col + 1]; }
      unsigned x[36];
#pragma unroll
      for (int i = 0; i < 36; ++i) {
        const int rr = rh * 32 + i - 2;
        unsigned v = 0u;
        if (rr >= 0 && rr < 64) v = *(const unsigned*)(P + (long)(R0 + rr) * 4096 + col);
        else if (rr < 0) { if (cg_ > 0) v = *(const unsigned*)(HALO + ((long)(cg_ - 1) * 4 + 2 + (rr + 2)) * 4096 + col); }
        else { if (cg_ + 1 < GS * NCHUNK) v = *(const unsigned*)(HALO + ((long)(cg_ + 1) * 4 + (rr - 64)) * 4096 + col); }
        x[i] = v;
      }
#pragma unroll
      for (int o = 0; o < 32; ++o) {
        float a0 = 0.f, a1 = 0.f;
#pragma unroll
        for (int j = 0; j < 5; ++j) { a0 += w0[j] * bflo(x[o + j]); a1 += w1[j] * bfhi(x[o + j]); }
        a0 = silu(a0); a1 = silu(a1);
        if (part < 2) {
          float ss = wave_sum(a0 * a0 + a1 * a1);
          float sc = rsqrtf(ss + EPS) * (part == 0 ? 0.08838834764831845f : 1.f);
          a0 *= sc; a1 *= sc;
        }
        const int row = rh * 32 + o;
        if (chunk == 0 && row < PADR) { a0 = 0.f; a1 = 0.f; }
        outv[o] = pk2(a0, a1);
        if ((o & 3) == 3) SBAR();
      }
    }
    __syncthreads();
#pragma unroll
    for (int o = 0; o < 32; ++o) *(unsigned*)(P + (long)(R0 + rh * 32 + o) * 4096 + col) = outv[o];
    if (part < 2) {
      char* dstT = part == 0 ? Qs : Ks; const int chl = ch - part * 128;
#pragma unroll
      for (int o = 0; o < 32; ++o) { const int row = rh * 32 + o;
        *(unsigned*)(dstT + row * 256 + ((((chl >> 3) ^ (row & 7))) << 4) + (chl & 7) * 2) = outv[o]; }
      if (part == 1) {
        u16* kt = KTg + ((long)(seq * 8 + h) * NCHUNK + chunk) * 8192 + (long)chl * 64 + rh * 32;
#pragma unroll
        for (int q4 = 0; q4 < 4; ++q4) {
          u32x4 lo, hi4;
#pragma unroll
          for (int e = 0; e < 4; ++e) { const unsigned a = outv[q4 * 8 + 2 * e], b = outv[q4 * 8 + 2 * e + 1];
            lo[e] = (a & 0xffffu) | (b << 16); hi4[e] = (a >> 16) | (b & 0xffff0000u); }
          *(u32x4*)(kt + q4 * 8) = lo; *(u32x4*)(kt + 64 + q4 * 8) = hi4;
          SBAR();
        }
      }
    }
    if (tid < 128) {
      const int r = tid & 63, dir = tid >> 6; const long row = R0 + r;
      const float b = BA[row * 32 + dir * 8 + h], a = BA[row * 32 + 16 + dir * 8 + h];
      float beta = 1.f / (1.f + __expf(-b));
      float xx = a + p.g_dtb[dir * 8 + h];
      float sp = xx > 20.f ? xx : __logf(1.f + __expf(xx));
      float gg = -__expf(p.g_alog[dir * 8 + h]) * sp;
      if (chunk == 0 && r < PADR) { beta = 0.f; gg = 0.f; }
      float gc = gg;
#pragma unroll
      for (int off = 1; off < 64; off <<= 1) {
        const float up = __shfl_up(gc, off, 64), dn = __shfl_down(gc, off, 64);
        if (dir == 0) { if (r >= off) gc += up; } else { if (r + off < 64) gc += dn; }
      }
      const float gl = __shfl(gc, dir == 0 ? 63 : 0, 64);
      sbeta[dir * 64 + r] = beta; sgc[dir * 64 + r] = gc;
      f32x4 st = {beta, __expf(gc), __expf(gl - gc), __expf(gl)};
      *(f32x4*)(SCg + ((long)((seq * 8 + h) * 2 + dir) * TP + chunk * 64 + r) * 4) = st;
    }
    __syncthreads();
    {
      const int kind = wid >> 2, qi = (wid >> 1) & 1, qj = wid & 1;
      int r32 = lane & 31, hi = lane >> 5;
      asm volatile("" : "+v"(r32), "+v"(hi));
      const char* At = kind ? Qs : Ks;
      f32x16 acc;
#pragma unroll
      for (int r = 0; r < 16; ++r) acc[r] = 0.f;
#pragma unroll
      for (int ks = 0; ks < 8; ++ks) {
        const int c = ks * 2 + hi; const int ra = qi * 32 + r32, rb = qj * 32 + r32;
        bf16x8 af = *(const bf16x8*)(At + ra * 256 + ((c ^ (ra & 7)) << 4));
        bf16x8 bfr = *(const bf16x8*)(Ks + rb * 256 + ((c ^ (rb & 7)) << 4));
        acc = __builtin_amdgcn_mfma_f32_32x32x16_bf16(af, bfr, acc, 0, 0, 0);
        if (ks & 1) SBAR();
      }
      const int j = qj * 32 + r32;
      u16* Ag0 = TQg + ((long)((seq * 8 + h) * 2 + 0) * NCHUNK + chunk) * 8192 + 4096;
      u16* Ag1 = TQg + ((long)((seq * 8 + h) * 2 + 1) * NCHUNK + chunk) * 8192 + 4096;
      const float gj0 = sgc[j], gj1 = sgc[64 + j];
#pragma unroll
      for (int r = 0; r < 16; ++r) {
        const int i = qi * 32 + crow(r, hi);
        const float e0 = __expf(fminf(sgc[i] - gj0, 0.f)), e1 = __expf(fminf(sgc[64 + i] - gj1, 0.f));
        if (kind == 0) {
          M0[i * 64 + j] = j < i ? sbeta[i] * acc[r] * e0 : 0.f;
          M0[4096 + (63 - i) * 64 + (63 - j)] = j > i ? sbeta[64 + i] * acc[r] * e1 : 0.f;
        } else {
          Ag0[i * 64 + j] = f2bf(j <= i ? acc[r] * e0 : 0.f);
          Ag1[i * 64 + j] = f2bf(j >= i ? acc[r] * e1 : 0.f);
        }
        SBAR();
      }
    }
    __syncthreads();
    if (wid < 2) {
      const int d = wid; const float* M = M0 + d * 4096; float* Tl = M0 + 8192 + d * 4096;
#pragma unroll 4
      for (int a = 0; a < 64; ++a) Tl[a * 64 + lane] = 0.f;
#pragma unroll 1
      for (int a = 0; a < 64; ++a) {
        float acc = (a == lane) ? 1.f : 0.f;
        const int nb4 = (a + 3) >> 2;
#pragma unroll 2
        for (int b4 = 0; b4 < nb4; ++b4) {
          const f32x4 m = *(const f32x4*)(M + a * 64 + b4 * 4);
          acc -= m[0] * Tl[(b4 * 4 + 0) * 64 + lane]; acc -= m[1] * Tl[(b4 * 4 + 1) * 64 + lane];
          acc -= m[2] * Tl[(b4 * 4 + 2) * 64 + lane]; acc -= m[3] * Tl[(b4 * 4 + 3) * 64 + lane];
        }
        Tl[a * 64 + lane] = acc;
      }
      u16* Tg = TQg + ((long)((seq * 8 + h) * 2 + d) * NCHUNK + chunk) * 8192;
#pragma unroll 4
      for (int a = 0; a < 64; ++a) {
        const float tv = Tl[a * 64 + lane];
        if (d == 0) Tg[a * 64 + lane] = f2bf(tv); else Tg[(63 - a) * 64 + (63 - lane)] = f2bf(tv);
      }
    }
  }
}

DI bf16x8 pack8(f32x4 a, f32x4 b) { u32x4 w = {pk2(a[0], a[1]), pk2(a[2], a[3]), pk2(b[0], b[1]), pk2(b[2], b[3])}; return __builtin_bit_cast(bf16x8, w); }
DI bf16x8 ld_frag(const char* ptr) { u32x2 lo = *(const u32x2*)ptr; u32x2 hi = *(const u32x2*)(ptr + 32); u32x4 w = {lo[0], lo[1], hi[0], hi[1]}; return __builtin_bit_cast(bf16x8, w); }
#define MFMA16(a, b, c) __builtin_amdgcn_mfma_f32_16x16x32_bf16((a), (b), (c), 0, 0, 0)
constexpr int SB_Q = 0, SB_K = 17408, SB_KT = 34816, SB_T = 53248, SB_A = 62464, SB_V = 71680, SB_SC = 79872, SB_SIZE = 80896;

DI void scan_load(const Params& p, int seq, int h, int dir, int dvq, int cc, char* B, int lt) {
  const u16* P = (const u16*)(p.ws + OFF_P);
  const long R0 = (long)seq * TP + cc * 64;
  const u16* Pq = P + R0 * 4096 + h * 128; const u16* Pk = Pq + 1024; const u16* Pv = P + R0 * 4096 + 2048 + h * 256 + dvq * 64;
  const u16* KTg = (const u16*)(p.ws + OFF_KT) + ((long)(seq * 8 + h) * NCHUNK + cc) * 8192;
  const u16* Tg = (const u16*)(p.ws + OFF_TQ) + ((long)((seq * 8 + h) * 2 + dir) * NCHUNK + cc) * 8192;
  const float* SCg = (const float*)(p.ws + OFF_SC) + ((long)((seq * 8 + h) * 2 + dir) * TP + cc * 64) * 4;
  u32x4 rq[4], rk[4], rkt[4], rt[2], ra[2], rv[2]; f32x4 rs = {0.f, 0.f, 0.f, 0.f};
#pragma unroll
  for (int i = 0; i < 4; ++i) { const int e = lt + 256 * i, row = e >> 4, c = e & 15;
    rq[i] = *(const u32x4*)(Pq + (long)row * 4096 + c * 8); rk[i] = *(const u32x4*)(Pk + (long)row * 4096 + c * 8); }
#pragma unroll
  for (int i = 0; i < 4; ++i) { const int e = lt + 256 * i, row = e >> 3, c = e & 7; rkt[i] = *(const u32x4*)(KTg + row * 64 + c * 8); }
#pragma unroll
  for (int i = 0; i < 2; ++i) { const int e = lt + 256 * i, row = e >> 3, c = e & 7;
    rt[i] = *(const u32x4*)(Tg + row * 64 + c * 8); ra[i] = *(const u32x4*)(Tg + 4096 + row * 64 + c * 8);
    rv[i] = *(const u32x4*)(Pv + (long)row * 4096 + c * 8); }
  if (lt < 64) rs = *(const f32x4*)(SCg + lt * 4);
#pragma unroll
  for (int i = 0; i < 4; ++i) { const int e = lt + 256 * i, row = e >> 4, c = e & 15;
    *(u32x4*)(B + SB_Q + row * 272 + c * 16) = rq[i]; *(u32x4*)(B + SB_K + row * 272 + c * 16) = rk[i]; }
#pragma unroll
  for (int i = 0; i < 4; ++i) { const int e = lt + 256 * i, row = e >> 3, c = e & 7; *(u32x4*)(B + SB_KT + row * 144 + c * 16) = rkt[i]; }
#pragma unroll
  for (int i = 0; i < 2; ++i) { const int e = lt + 256 * i, row = e >> 3, c = e & 7;
    *(u32x4*)(B + SB_T + row * 144 + c * 16) = rt[i]; *(u32x4*)(B + SB_A + row * 144 + c * 16) = ra[i];
    *(u32x4*)(B + SB_V + row * 128 + c * 16) = rv[i]; }
  if (lt < 64) *(f32x4*)(B + SB_SC + lt * 16) = rs;
}

DI void phase_scan(const Params& p, char* lds) {
  for (int item = blockIdx.x; item < GS * 8 * 2 * 4; item += gridDim.x) {
    const int tid = otid(), wid = tid >> 6, lane = tid & 63, n = lane & 15, quad = lane >> 4;
    const int dvq = item & 3, dir = (item >> 2) & 1, h = (item >> 3) & 7, seq = item >> 6;
    u16* O = (u16*)(p.ws + (dir ? OFF_OB : OFF_OF));
    f32x4 S[8];
#pragma unroll
    for (int t = 0; t < 8; ++t) S[t] = (f32x4){0.f, 0.f, 0.f, 0.f};
    __syncthreads();
    if (wid >= 4) scan_load(p, seq, h, dir, dvq, dir ? NCHUNK - 1 : 0, lds, tid - 256);
    __syncthreads();
#pragma unroll 1
    for (int c = 0; c < NCHUNK; ++c) {
      const int cc = dir ? NCHUNK - 1 - c : c;
      if (wid >= 4) {
        if (c + 1 < NCHUNK) scan_load(p, seq, h, dir, dvq, dir ? NCHUNK - 2 - c : c + 1, lds + ((c + 1) & 1) * SB_SIZE, tid - 256);
      } else {
        const char* B = lds + (c & 1) * SB_SIZE;
        const long R0 = (long)seq * TP + cc * 64;
        bf16x8 Sb[4];
#pragma unroll
        for (int ks = 0; ks < 4; ++ks) Sb[ks] = pack8(S[2 * ks], S[2 * ks + 1]);
        f32x4 KS[4], QS[4];
#pragma unroll
        for (int mt = 0; mt < 4; ++mt) {
          KS[mt] = (f32x4){0.f, 0.f, 0.f, 0.f}; QS[mt] = (f32x4){0.f, 0.f, 0.f, 0.f};
#pragma unroll
          for (int ks = 0; ks < 4; ++ks) {
            const int off = (16 * mt + n) * 272 + 64 * ks + 8 * quad;
            KS[mt] = MFMA16(ld_frag(B + SB_K + off), Sb[ks], KS[mt]);
            QS[mt] = MFMA16(ld_frag(B + SB_Q + off), Sb[ks], QS[mt]);
          }
        }
        f32x4 rhs[4], egc[4], ekd[4]; float egl = 1.f;
#pragma unroll
        for (int mt = 0; mt < 4; ++mt)
#pragma unroll
          for (int i = 0; i < 4; ++i) {
            const int row = 16 * mt + 4 * quad + i;
            const f32x4 sc = *(const f32x4*)(B + SB_SC + row * 16);
            const float v = bf2f(*(const u16*)(B + SB_V + row * 128 + (wid * 16 + n) * 2));
            egc[mt][i] = sc[1]; ekd[mt][i] = sc[2]; egl = sc[3];
            rhs[mt][i] = sc[0] * (v - sc[1] * KS[mt][i]);
          }
        bf16x8 Rb[2];
#pragma unroll
        for (int k2 = 0; k2 < 2; ++k2) Rb[k2] = pack8(rhs[2 * k2], rhs[2 * k2 + 1]);
        f32x4 VN[4];
#pragma unroll
        for (int mt = 0; mt < 4; ++mt) {
          VN[mt] = (f32x4){0.f, 0.f, 0.f, 0.f};
#pragma unroll
          for (int k2 = 0; k2 < 2; ++k2) VN[mt] = MFMA16(ld_frag(B + SB_T + (16 * mt + n) * 144 + 64 * k2 + 8 * quad), Rb[k2], VN[mt]);
        }
        bf16x8 Vb[2], Vd[2];
#pragma unroll
        for (int k2 = 0; k2 < 2; ++k2) {
          Vb[k2] = pack8(VN[2 * k2], VN[2 * k2 + 1]);
          Vd[k2] = pack8(VN[2 * k2] * ekd[2 * k2], VN[2 * k2 + 1] * ekd[2 * k2 + 1]);
        }
#pragma unroll
        for (int mt = 0; mt < 4; ++mt) {
          f32x4 o = QS[mt] * egc[mt];
#pragma unroll
          for (int k2 = 0; k2 < 2; ++k2) o = MFMA16(ld_frag(B + SB_A + (16 * mt + n) * 144 + 64 * k2 + 8 * quad), Vb[k2], o);
#pragma unroll
          for (int i = 0; i < 4; ++i) O[(R0 + 16 * mt + 4 * quad + i) * 2048 + h * 256 + dvq * 64 + wid * 16 + n] = f2bf(o[i]);
        }
#pragma unroll
        for (int t = 0; t < 8; ++t) {
          S[t] = S[t] * egl;
#pragma unroll
          for (int k2 = 0; k2 < 2; ++k2) S[t] = MFMA16(ld_frag(B + SB_KT + (16 * t + n) * 144 + 64 * k2 + 8 * quad), Vd[k2], S[t]);
        }
      }
      __syncthreads();
    }
  }
}

DI void phase_gate(const Params& p) {
  u16* OFp = (u16*)(p.ws + OFF_OF); const u16* OBp = (const u16*)(p.ws + OFF_OB); const u16* Z = (const u16*)(p.ws + OFF_Z);
  const int lane = otid() & 63, wv = otid() >> 6;
  for (int it = blockIdx.x * 8 + wv; it < GR * 8; it += gridDim.x * 8) {
    const long off = (long)it * 256 + lane * 4;
    u32x2 a = *(const u32x2*)(OFp + off), b = *(const u32x2*)(OBp + off), z = *(const u32x2*)(Z + off);
    float o0 = bflo(a[0]) + bflo(b[0]), o1 = bfhi(a[0]) + bfhi(b[0]), o2 = bflo(a[1]) + bflo(b[1]), o3 = bfhi(a[1]) + bfhi(b[1]);
    float ss = wave_sum(o0 * o0 + o1 * o1 + o2 * o2 + o3 * o3);
    float rs = rsqrtf(ss * (1.f / 256.f) + EPS);
    u32x2 w = {pk2(o0 * rs * silu(bflo(z[0])), o1 * rs * silu(bfhi(z[0]))), pk2(o2 * rs * silu(bflo(z[1])), o3 * rs * silu(bfhi(z[1])))};
    *(u32x2*)(OFp + off) = w;
  }
}

DI void phase_rowstats(const Params& p) {
  const u16* CQ = (const u16*)(p.ws + OFF_CQ); const u16* CKV = (const u16*)(p.ws + OFF_CKV); const float* KPE = (const float*)(p.ws + OFF_KPE);
  float* rowst = (float*)(p.ws + OFF_ROWST); float* kper = (float*)(p.ws + OFF_KPER); const float* rope = (const float*)(p.ws + OFF_ROPE);
  const int lane = otid() & 63, wv = otid() >> 6;
  for (int row = blockIdx.x * 8 + wv; row < GR; row += gridDim.x * 8) {
    u32x4 q = *(const u32x4*)(CQ + (long)row * 512 + lane * 8);
    float sq = 0.f;
#pragma unroll
    for (int j = 0; j < 4; ++j) { float a = bflo(q[j]), b = bfhi(q[j]); sq += a * a + b * b; }
    u32x2 kv = *(const u32x2*)(CKV + (long)row * 256 + lane * 4);
    float sk = 0.f;
#pragma unroll
    for (int j = 0; j < 2; ++j) { float a = bflo(kv[j]), b = bfhi(kv[j]); sk += a * a + b * b; }
    const float kp = KPE[(long)row * 64 + lane];
    sq = wave_sum(sq); sk = wave_sum(sk); const float sp = wave_sum(kp * kp);
    const float val = kp * p.m_kg[128 + lane];
    const float oth = __shfl_xor(val, 32, 64);
    int pos = row % TP - PADR; pos = pos < 0 ? 0 : pos;
    const int i = lane & 31; const float c = rope[pos * 64 + i], s = rope[pos * 64 + 32 + i];
    kper[(long)row * 64 + lane] = lane < 32 ? val * c - oth * s : val * c + oth * s;
    if (lane == 0) { f32x4 st = {rsqrtf(sq * (1.f / 512.f) + EPS), rsqrtf(sk * (1.f / 256.f) + EPS), sp, 0.f}; *(f32x4*)(rowst + (long)row * 4) = st; }
  }
}

constexpr float ATT_SCALE = 0.07216878364870322f;
constexpr float ATT_THR = 8.f;
constexpr int SHM_V = 64 * 128 * 2, SHM_K = 64 * 192 * 2;
DI int v_st(int k, int c) { const int kk = (k & ~0xC) | ((k & 4) << 1) | ((k & 8) >> 1); return ((kk >> 3) * 4 + (c >> 5)) * 512 + ((kk & 7) * 32 + (c & 31)) * 2; }
DI int v_rd_base(int lane) { return ((lane & 3) << 3) | (((lane >> 2) & 3) << 6) | (((lane >> 4) & 1) << 5) | (((lane >> 5) & 1) << 8); }
constexpr int v_rd_off(int d0, int ks, int half) { return d0 * 512 + ks * 4096 + half * 2048; }
template <int OFF> DI s16x4 tr_read(int vb) {
  s16x4 r; asm volatile("ds_read_b64_tr_b16 %0, %1 offset:%2" : "=&v"(r) : "v"(vb), "i"(OFF) : "memory"); return r;
}
template <int D0> DI void pv_one(f32x16& od, int vb, bf16x8 pa0, bf16x8 pa1, bf16x8 pa2, bf16x8 pa3) {
  const s16x4 l0 = tr_read<v_rd_off(D0, 0, 0)>(vb), h0 = tr_read<v_rd_off(D0, 0, 1)>(vb), l1 = tr_read<v_rd_off(D0, 1, 0)>(vb), h1 = tr_read<v_rd_off(D0, 1, 1)>(vb);
  const s16x4 l2 = tr_read<v_rd_off(D0, 2, 0)>(vb), h2 = tr_read<v_rd_off(D0, 2, 1)>(vb), l3 = tr_read<v_rd_off(D0, 3, 0)>(vb), h3 = tr_read<v_rd_off(D0, 3, 1)>(vb);
  asm volatile("s_waitcnt lgkmcnt(0)" ::: "memory"); SBAR();
#define PKV(L, H) (bf16x8){L[0], L[1], L[2], L[3], H[0], H[1], H[2], H[3]}
  od = __builtin_amdgcn_mfma_f32_32x32x16_bf16(pa0, PKV(l0, h0), od, 0, 0, 0);
  od = __builtin_amdgcn_mfma_f32_32x32x16_bf16(pa1, PKV(l1, h1), od, 0, 0, 0);
  od = __builtin_amdgcn_mfma_f32_32x32x16_bf16(pa2, PKV(l2, h2), od, 0, 0, 0);
  od = __builtin_amdgcn_mfma_f32_32x32x16_bf16(pa3, PKV(l3, h3), od, 0, 0, 0);
#undef PKV
}

DI void attn_item(const u16* __restrict__ Qb, const u16* __restrict__ Kh, const u16* __restrict__ Vh, int q0,
                  u16* __restrict__ Yb, const u16* __restrict__ Zb, char* lds) {
  const int tid = otid(), wid = tid >> 6, lane = tid & 63, r32 = lane & 31, hi = lane >> 5;
  char* V_lds = lds; char* K_lds = lds + 2 * SHM_V;
  float* wsf = (float*)(lds + 2 * SHM_V + 2 * SHM_K) + wid * 64; float* li_l = wsf; float* al_l = wsf + 32;
  constexpr float C = ATT_SCALE * 1.4426950408889634f;
  float m_reg = -1e30f, l_reg = 0.f;
  f32x16 o[4];
#pragma unroll
  for (int d = 0; d < 4; ++d)
#pragma unroll
    for (int r = 0; r < 16; ++r) o[d][r] = 0.f;
  bf16x8 qr[12];
  const int qrow = q0 + wid * 32 + r32;
#pragma unroll
  for (int d0 = 0; d0 < 12; ++d0) {
    bf16x8 z = {0, 0, 0, 0, 0, 0, 0, 0};
    qr[d0] = qrow < TP ? *(const bf16x8*)(Qb + (long)qrow * 192 + d0 * 16 + hi * 8) : z;
  }
  const int sr = tid >> 4, sc = (tid & 15) * 8, vst0 = v_st(sr, sc), vst1 = v_st(32 + sr, sc);
  const int vb0 = (int)(uintptr_t)V_lds + v_rd_base(lane);
  u32x4 kst[3], vst[2];
#define KLOAD(k0) do { _Pragma("unroll") for (int i = 0; i < 3; ++i) { int q = tid + 512 * i; int row = q / 24, c = q % 24; \
      kst[i] = *(const u32x4*)(Kh + (long)((k0) + row) * 192 + c * 8); } } while (0)
#define VLOAD(k0) do { vst[0] = *(const u32x4*)(Vh + (long)((k0) + sr) * 128 + sc); vst[1] = *(const u32x4*)(Vh + (long)((k0) + 32 + sr) * 128 + sc); } while (0)
#define KWRITE(b) do { _Pragma("unroll") for (int i = 0; i < 3; ++i) { int q = tid + 512 * i; int row = q / 24, c = q % 24; \
      *(u32x4*)(K_lds + (b) * SHM_K + row * 384 + ((c * 16) ^ ((row & 7) << 4))) = kst[i]; } } while (0)
#define VWRITE(b) do { *(u32x4*)(V_lds + (b) * SHM_V + vst0) = vst[0]; *(u32x4*)(V_lds + (b) * SHM_V + vst1) = vst[1]; } while (0)
  constexpr int NT = TP / 64;
  __syncthreads();
  KLOAD(0); VLOAD(0); KWRITE(0); VWRITE(0); VLOAD(64);
  __syncthreads();
#pragma unroll 1
  for (int j = 0; j < NT; ++j) {
    const int cur = j & 1;
    f32x16 p0, p1;
#pragma unroll
    for (int r = 0; r < 16; ++r) { p0[r] = 0.f; p1[r] = 0.f; }
    const char* Kc = K_lds + cur * SHM_K;
#pragma unroll
    for (int d0 = 0; d0 < 12; ++d0) {
      const int cb = (d0 * 16 + hi * 8) * 2;
      bf16x8 b0 = *(const bf16x8*)(Kc + r32 * 384 + (cb ^ ((r32 & 7) << 4)));
      bf16x8 b1 = *(const bf16x8*)(Kc + (32 + r32) * 384 + (cb ^ ((r32 & 7) << 4)));
      p0 = __builtin_amdgcn_mfma_f32_32x32x16_bf16(b0, qr[d0], p0, 0, 0, 0);
      p1 = __builtin_amdgcn_mfma_f32_32x32x16_bf16(b1, qr[d0], p1, 0, 0, 0);
      if ((d0 & 1) == 1) SBAR();
    }
    if (j + 1 < NT) { VWRITE(cur ^ 1); KLOAD((j + 1) * 64); }
    if (j == 0) {
#pragma unroll
      for (int r = 0; r < 16; ++r) p0[r] = -1e30f;
#pragma unroll
      for (int r = 0; r < 8; ++r) p1[r] = -1e30f;
    }
    float pmax = p0[0];
#pragma unroll
    for (int r = 1; r < 16; ++r) pmax = fmaxf(pmax, p0[r]);
#pragma unroll
    for (int r = 0; r < 16; ++r) pmax = fmaxf(pmax, p1[r]);
    { auto rr = __builtin_amdgcn_permlane32_swap(__float_as_uint(pmax), __float_as_uint(pmax), false, false);
      pmax = fmaxf(__uint_as_float(rr[0]), __uint_as_float(rr[1])); }
    float mn, alpha;
    if (__all(pmax - m_reg <= ATT_THR / ATT_SCALE)) { mn = m_reg; alpha = 1.f; }
    else { mn = fmaxf(m_reg, pmax); alpha = __builtin_amdgcn_exp2f((m_reg - mn) * C); m_reg = mn; }
    if (__any(alpha < 1.f)) {
      if (hi == 0) al_l[r32] = alpha;
      asm volatile("s_waitcnt lgkmcnt(0)" ::: "memory");
#pragma unroll
      for (int r = 0; r < 16; ++r) { const float a = al_l[crow(r, hi)];
#pragma unroll
        for (int d = 0; d < 4; ++d) o[d][r] *= a; }
    }
    const float mnC = -mn * C;
    float ps = 0.f;
#pragma unroll
    for (int r = 0; r < 16; ++r) { p0[r] = __builtin_amdgcn_exp2f(fmaf(p0[r], C, mnC)); p1[r] = __builtin_amdgcn_exp2f(fmaf(p1[r], C, mnC)); ps += p0[r] + p1[r]; }
    { auto rr = __builtin_amdgcn_permlane32_swap(__float_as_uint(ps), __float_as_uint(ps), false, false);
      ps = __uint_as_float(rr[0]) + __uint_as_float(rr[1]); }
    l_reg = l_reg * alpha + ps;
    bf16x8 pa0, pa1, pa2, pa3;
#define PK4(PP, BASE, OUT) do { unsigned a0 = pk2(PP[BASE + 0], PP[BASE + 1]), a1 = pk2(PP[BASE + 2], PP[BASE + 3]); \
    unsigned b0 = pk2(PP[BASE + 4], PP[BASE + 5]), b1 = pk2(PP[BASE + 6], PP[BASE + 7]); \
    auto r0 = __builtin_amdgcn_permlane32_swap(a0, b0, false, false); auto r1 = __builtin_amdgcn_permlane32_swap(a1, b1, false, false); \
    u32x4 w = {r0[0], r1[0], r0[1], r1[1]}; OUT = __builtin_bit_cast(bf16x8, w); } while (0)
    PK4(p0, 0, pa0); PK4(p0, 8, pa1); PK4(p1, 0, pa2); PK4(p1, 8, pa3);
#undef PK4
    const int vb = vb0 + cur * SHM_V;
    pv_one<0>(o[0], vb, pa0, pa1, pa2, pa3); pv_one<1>(o[1], vb, pa0, pa1, pa2, pa3);
    pv_one<2>(o[2], vb, pa0, pa1, pa2, pa3); pv_one<3>(o[3], vb, pa0, pa1, pa2, pa3);
    if (j + 1 < NT) { KWRITE(cur ^ 1); if (j + 2 < NT) VLOAD((j + 2) * 64); }
    __syncthreads();
  }
#undef KLOAD
#undef VLOAD
#undef KWRITE
#undef VWRITE
  if (hi == 0) li_l[r32] = l_reg;
  asm volatile("s_waitcnt lgkmcnt(0)" ::: "memory");
#pragma unroll
  for (int r = 0; r < 16; ++r) {
    const int orow = q0 + wid * 32 + crow(r, hi);
    const float rl = 1.f / li_l[crow(r, hi)];
    if (orow < TP) {
#pragma unroll
      for (int d0 = 0; d0 < 4; ++d0) {
        const long off = (long)orow * 2048 + d0 * 32 + r32;
        Yb[off] = f2bf(o[d0][r] * rl * silu(bf2f(Zb[off])));
      }
    }
  }
}

DI void phase_attn(const Params& p, char* lds) {
  const u16* QM = (const u16*)(p.ws + OFF_QM); const u16* KM = (const u16*)(p.ws + OFF_KM); const u16* VM = (const u16*)(p.ws + OFF_VM);
  u16* Y = (u16*)(p.ws + OFF_Y); const u16* Z = (const u16*)(p.ws + OFF_Z);
  const int b = blockIdx.x, x = b & 7, lb = b >> 3;
  if (gridDim.x == 256) {
    for (int it = 0; it < 5; ++it) {
      int pair, qb;
      if (it < 4) { pair = x + 8 * (2 * it + (lb >> 4)); qb = lb & 15; }
      else { if (b >= 64) break; pair = b; qb = 16; }
      const int seq = pair >> 4, head = pair & 15;
      attn_item(QM + (long)pair * TP * 192, KM + (long)pair * TP * 192, VM + (long)pair * TP * 128, qb * 256,
                Y + (long)seq * TP * 2048 + head * 128, Z + (long)seq * TP * 2048 + head * 128, lds);
    }
  } else {
    for (int item = b; item < 64 * 17; item += gridDim.x) {
      const int pair = item / 17, qb = item % 17; const int seq = pair >> 4, head = pair & 15;
      attn_item(QM + (long)pair * TP * 192, KM + (long)pair * TP * 192, VM + (long)pair * TP * 128, qb * 256,
                Y + (long)seq * TP * 2048 + head * 128, Z + (long)seq * TP * 2048 + head * 128, lds);
    }
  }
}


#define XB_TMO      128
#define XB_XCNT(j)  (256  + 64 * (j))
#define XB_XSUB(j)  (1280 + 64 * (j))
#define XB_XGEN(j)  (2304 + 64 * (j))
#define XB_TOP      3328
#define XB_TOPGEN   3392
#define XCD_BAR_WORDS 3456
#define XB_SPIN_CAP (1u << 18)
#define LAS __attribute__((address_space(3)))
DI unsigned xb_ld(unsigned* p)              { return __hip_atomic_load(p, __ATOMIC_RELAXED, __HIP_MEMORY_SCOPE_AGENT); }
DI unsigned xb_add(unsigned* p, unsigned v) { return __hip_atomic_fetch_add(p, v, __ATOMIC_RELAXED, __HIP_MEMORY_SCOPE_AGENT); }
DI unsigned xb_xcc_id() { return (unsigned)__builtin_amdgcn_s_getreg((3 << 11) | 20) & 0xFu; }
#define XB_SPIN(cond, bar) do { unsigned _sp = 0; while (cond) { __builtin_amdgcn_s_sleep(1); \
    if ((++_sp & 255u) == 0u) { if (xb_ld(&(bar)[XB_TMO])) break; if (_sp > XB_SPIN_CAP) { atomicAdd(&(bar)[XB_TMO], 1u); break; } } } } while (0)
struct XcdBarrier { unsigned* bar; unsigned x; volatile LAS unsigned* st; };
DI XcdBarrier xcd_barrier_post(unsigned* bar, volatile LAS unsigned* st) {
  XcdBarrier b; b.bar = bar; b.x = xb_xcc_id(); b.st = st;
  if (__builtin_amdgcn_workitem_id_x() == 0) (void)xb_add(&bar[XB_XCNT(b.x)], 1u);
  return b;
}
DI void xcd_barrier_complete(unsigned* bar, unsigned x, unsigned& nloc, unsigned& nx) {
  const unsigned G = gridDim.x * gridDim.y * gridDim.z;
  unsigned sum, cnt, mine, sp = 0u;
  for (;;) {
    sum = 0u; cnt = 0u; mine = 0u;
#pragma unroll
    for (unsigned j = 0; j < 16; ++j) { const unsigned c = xb_ld(&bar[XB_XCNT(j)]); sum += c; cnt += (c > 0u) ? 1u : 0u; mine = (j == x) ? c : mine; }
    if (sum == G) break;
    __builtin_amdgcn_s_sleep(1);
    if ((++sp & 255u) == 0u) { if (xb_ld(&bar[XB_TMO])) break; if (sp > XB_SPIN_CAP) { atomicAdd(&bar[XB_TMO], 1u); break; } }
  }
  nloc = mine > 0u ? mine : 1u; nx = cnt > 0u ? cnt : 1u;
}
DI void xcd_barrier(const XcdBarrier& b) {
  asm volatile("s_waitcnt vmcnt(0)" ::: "memory");
  __syncthreads();
  if (__builtin_amdgcn_workitem_id_x() == 0) {
    unsigned* bar = b.bar;
    __builtin_amdgcn_s_waitcnt(0);
    unsigned nloc = b.st[0], nx = b.st[1];
    if (nloc == 0u) { xcd_barrier_complete(bar, b.x, nloc, nx); b.st[0] = nloc; b.st[1] = nx; }
    const unsigned old = xb_add(&bar[XB_XSUB(b.x)], 1u);
    const unsigned gen = old / nloc;
    if (old + 1u == (gen + 1u) * nloc) {
      __builtin_amdgcn_fence(__ATOMIC_RELEASE, "agent");
      asm volatile("s_waitcnt vmcnt(0)" ::: "memory");
      const unsigned og = xb_add(&bar[XB_TOP], 1u);
      const unsigned tg = og / nx;
      if (og + 1u == (tg + 1u) * nx) xb_add(&bar[XB_TOPGEN], 1u);
      else XB_SPIN(xb_ld(&bar[XB_TOPGEN]) == tg, bar);
      __builtin_amdgcn_fence(__ATOMIC_ACQUIRE, "agent");
      xb_add(&bar[XB_XGEN(b.x)], 1u);
      asm volatile("s_waitcnt vmcnt(0)" ::: "memory");
    } else {
      XB_SPIN(xb_ld(&bar[XB_XGEN(b.x)]) == gen, bar);
      __builtin_amdgcn_fence(__ATOMIC_ACQUIRE, "agent");
      asm volatile("s_waitcnt vmcnt(0)" ::: "memory");
    }
  }
  __syncthreads();
}

__global__ void __launch_bounds__(512) fwd_mega(Params p) {
  extern __shared__ __attribute__((aligned(16))) char lds[];
  cg::grid_group grid = cg::this_grid();
  char* ws = p.ws;
  unsigned* barw = (unsigned*)(ws + OFF_BAR);
  if (blockIdx.x == 0) for (int i = otid(); i < XCD_BAR_WORDS; i += 512) barw[i] = 0u;
  volatile LAS unsigned* xst = (volatile LAS unsigned*)(lds + LDS_BYTES - 16);
  if (otid() == 0) { xst[0] = 0u; xst[1] = 0u; }
  grid.sync();
  const XcdBarrier xb = xcd_barrier_post(barw, xst);
  phase_prep(p, lds);
  for (int g = 0; g < NGRP; ++g) {
    phase_hn(p, g, 0);
    xcd_barrier(xb);
    { EpiGin e{(u16*)(ws + OFF_P), (u16*)(ws + OFF_HALO), (u16*)(ws + OFF_Z), (float*)(ws + OFF_BA)};
      for (int rep = 0; rep < REP_GEMM; ++rep) gemm_phase<4, 2, 2, 2>((const u16*)(ws + OFF_HN), 1024, (const u16*)(ws + OFF_WGIN), 1024, 1024, GINP, lds, e); }
    xcd_barrier(xb);
    phase_chunk(p, lds);
    xcd_barrier(xb);
    for (int rep = 0; rep < REP_SCAN; ++rep) phase_scan(p, lds);
    xcd_barrier(xb);
    phase_gate(p);
    xcd_barrier(xb);
    { EpiGout e{p, g, (float*)(ws + OFF_H1M)};
      for (int rep = 0; rep < REP_GEMM; ++rep) gemm_phase<4, 2, 2, 2>((const u16*)(ws + OFF_OF), 2048, (const u16*)(ws + OFF_WGOUT), 2048, 2048, 1024, lds, e); }
    xcd_barrier(xb);
    phase_hn(p, g, 1);
    xcd_barrier(xb);
    { EpiMin e{(u16*)(ws + OFF_CQ), (u16*)(ws + OFF_CKV), (u16*)(ws + OFF_Z), (float*)(ws + OFF_KPE)};
      for (int rep = 0; rep < REP_GEMM; ++rep) gemm_phase<4, 2, 2, 2>((const u16*)(ws + OFF_HN), 1024, (const u16*)(ws + OFF_WMIN), 1024, 1024, MINP, lds, e); }
    xcd_barrier(xb);
    phase_rowstats(p);
    xcd_barrier(xb);
    { EpiQ e{(const float*)(ws + OFF_ROWST), p.m_qg, (const float*)(ws + OFF_ROPE), (u16*)(ws + OFF_QM)};
      for (int rep = 0; rep < REP_GEMM; ++rep) gemm_phase<8, 1, 1, 6>((const u16*)(ws + OFF_CQ), 512, (const u16*)(ws + OFF_WUQ), 512, 512, 3072, lds, e); }
    { EpiKV e{(const float*)(ws + OFF_ROWST), p.m_kg, (const float*)(ws + OFF_KPER), (u16*)(ws + OFF_KM), (u16*)(ws + OFF_VM)};
      for (int rep = 0; rep < REP_GEMM; ++rep) gemm_phase<8, 1, 1, 4>((const u16*)(ws + OFF_CKV), 256, (const u16*)(ws + OFF_WUKV), 256, 256, 4096, lds, e); }
    xcd_barrier(xb);
    for (int rep = 0; rep < REP_ATTN; ++rep) phase_attn(p, lds);
    xcd_barrier(xb);
    { EpiMout e{p.out, g};
      gemm_phase<4, 2, 2, 2>((const u16*)(ws + OFF_Y), 2048, (const u16*)(ws + OFF_WMOUT), 2048, 2048, 1024, lds, e); }
    xcd_barrier(xb);
  }
}

extern "C" void kernel_launch(void* const* d_in, const int* in_sizes, int n_in,
                              void* d_out, int out_size, void* d_ws, size_t ws_size,
                              hipStream_t stream) {
  static int grid_blocks = 0;
  if (!grid_blocks) {
    int dev = 0, cus = 0, per_cu = 0;
    (void)hipGetDevice(&dev);
    (void)hipDeviceGetAttribute(&cus, hipDeviceAttributeMultiprocessorCount, dev);
    (void)hipFuncSetAttribute((const void*)fwd_mega, hipFuncAttributeMaxDynamicSharedMemorySize, LDS_BYTES);
    (void)hipOccupancyMaxActiveBlocksPerMultiprocessor(&per_cu, fwd_mega, 512, LDS_BYTES);
    if (per_cu < 1) { fprintf(stderr, "occupancy query returned %d\n", per_cu); per_cu = 1; }
    if (per_cu > 1) per_cu = 1;
    grid_blocks = cus * per_cu;
  }
  if (ws_size < WS_NEED) { fprintf(stderr, "workspace too small: %zu < %zu\n", ws_size, (size_t)WS_NEED); return; }
  Params p{};
  p.xp = (const float*)d_in[0]; p.xs = (const float*)d_in[1]; p.meta = (const float*)d_in[2]; p.ln_g = (const float*)d_in[3];
  p.g_win = (const float*)d_in[4]; p.g_conv = (const float*)d_in[5]; p.g_alog = (const float*)d_in[6]; p.g_dtb = (const float*)d_in[7];
  p.g_onorm = (const float*)d_in[8]; p.g_wout = (const float*)d_in[9]; p.m_win = (const float*)d_in[10]; p.m_qn = (const float*)d_in[11];
  p.m_kvn = (const float*)d_in[12]; p.m_wuq = (const float*)d_in[13]; p.m_wukv = (const float*)d_in[14]; p.m_qg = (const float*)d_in[15];
  p.m_kg = (const float*)d_in[16]; p.m_wout = (const float*)d_in[17]; p.out = (float*)d_out; p.ws = (char*)d_ws;
  void* args[] = {&p};
  hipError_t e = hipLaunchCooperativeKernel((void*)fwd_mega, dim3(grid_blocks), dim3(512), args, LDS_BYTES, stream);
  if (e != hipSuccess) fprintf(stderr, "cooperative launch failed: %s (grid %d)\n", hipGetErrorString(e), grid_blocks);
}
```

```cpp
#include <hip/hip_runtime.h>
#include <hip/hip_cooperative_groups.h>
#include <cstdio>
#include <cstdint>
namespace cg = cooperative_groups;

typedef unsigned short u16;
typedef __bf16 bf2_t __attribute__((ext_vector_type(2)));
typedef float f2_t __attribute__((ext_vector_type(2)));
using bf16x8 = __attribute__((ext_vector_type(8))) short;
using s16x4  = __attribute__((ext_vector_type(4))) short;
using f32x16 = __attribute__((ext_vector_type(16))) float;
using f32x4  = __attribute__((ext_vector_type(4))) float;
using u32x4  = __attribute__((ext_vector_type(4))) unsigned;
using u32x2  = __attribute__((ext_vector_type(2))) unsigned;
#define DI __device__ __forceinline__
#define SBAR() __builtin_amdgcn_sched_barrier(0)

DI unsigned pk2(float a, float b) { f2_t v = {a, b}; bf2_t r = __builtin_convertvector(v, bf2_t); return __builtin_bit_cast(unsigned, r); }
DI u16 f2bf(float a) { return (u16)(pk2(a, 0.f) & 0xffffu); }
DI float bf2f(u16 v) { return __uint_as_float(((unsigned)v) << 16); }
DI float bflo(unsigned v) { return __uint_as_float(v << 16); }
DI float bfhi(unsigned v) { return __uint_as_float(v & 0xffff0000u); }
DI int otid() { int t = __builtin_amdgcn_workitem_id_x(); asm volatile("" : "+v"(t)); return t; }
DI int crow(int r, int hi) { return (r & 3) + 8 * (r >> 2) + 4 * hi; }
DI float wave_sum(float v) {
#pragma unroll
  for (int m = 32; m >= 1; m >>= 1) v += __shfl_xor(v, m, 64);
  return v;
}
DI float silu(float x) { return x / (1.f + __expf(-x)); }

constexpr int D = 1024, TP = 4160, GS = 4, GR = GS * TP, NGRP = 3, PADR = 48, SEQ = 4096;
constexpr int GIN = 6176, GINP = 6400, MIN_ = 2880, MINP = 2944;
constexpr float EPS = 1e-6f;
constexpr int NCHUNK = 65;

constexpr size_t al256(size_t x) { return (x + 255) / 256 * 256; }
constexpr size_t OFF_WGIN  = 0;
constexpr size_t OFF_WGOUT = OFF_WGIN  + al256((size_t)GINP * 1024 * 2);
constexpr size_t OFF_WMIN  = OFF_WGOUT + al256((size_t)1024 * 2048 * 2);
constexpr size_t OFF_WUQ   = OFF_WMIN  + al256((size_t)MINP * 1024 * 2);
constexpr size_t OFF_WUKV  = OFF_WUQ   + al256((size_t)3072 * 512 * 2);
constexpr size_t OFF_WMOUT = OFF_WUKV  + al256((size_t)4096 * 256 * 2);
constexpr size_t OFF_ROPE  = OFF_WMOUT + al256((size_t)1024 * 2048 * 2);
constexpr size_t OFF_H1M   = OFF_ROPE  + al256((size_t)4112 * 64 * 4);
constexpr size_t OFF_HN    = OFF_H1M   + al256((size_t)12 * 16 * 1024 * 4);
constexpr size_t OFF_Z     = OFF_HN    + al256((size_t)GR * 1024 * 2);
constexpr size_t OFF_R     = OFF_Z     + al256((size_t)GR * 2048 * 2);
constexpr size_t OFF_P     = OFF_R;
constexpr size_t OFF_HALO  = OFF_P     + al256((size_t)GR * 4096 * 2);
constexpr size_t OFF_BA    = OFF_HALO  + al256((size_t)(GR / 64) * 4 * 4096 * 2);
constexpr size_t OFF_SC    = OFF_BA    + al256((size_t)GR * 32 * 4);
constexpr size_t OFF_TQ    = OFF_SC    + al256((size_t)GS * 8 * 2 * TP * 16);
constexpr size_t OFF_KT    = OFF_TQ    + al256((size_t)GS * 8 * 2 * NCHUNK * 16384);
constexpr size_t OFF_OF    = OFF_KT    + al256((size_t)GS * 8 * NCHUNK * 16384);
constexpr size_t OFF_OB    = OFF_OF    + al256((size_t)GR * 2048 * 2);
constexpr size_t END_GDN   = OFF_OB    + al256((size_t)GR * 2048 * 2);
constexpr size_t OFF_CQ    = OFF_R;
constexpr size_t OFF_CKV   = OFF_CQ    + al256((size_t)GR * 512 * 2);
constexpr size_t OFF_KPE   = OFF_CKV   + al256((size_t)GR * 256 * 2);
constexpr size_t OFF_ROWST = OFF_KPE   + al256((size_t)GR * 64 * 4);
constexpr size_t OFF_KPER  = OFF_ROWST + al256((size_t)GR * 4 * 4);
constexpr size_t OFF_QM    = OFF_KPER  + al256((size_t)GR * 64 * 4);
constexpr size_t OFF_KM    = OFF_QM    + al256((size_t)GR * 16 * 192 * 2);
constexpr size_t OFF_VM    = OFF_KM    + al256((size_t)GR * 16 * 192 * 2);
constexpr size_t OFF_Y     = OFF_VM    + al256((size_t)GR * 16 * 128 * 2);
constexpr size_t END_MLA   = OFF_Y     + al256((size_t)GR * 2048 * 2);
constexpr size_t OFF_BAR   = END_MLA > END_GDN ? END_MLA : END_GDN;
constexpr size_t WS_NEED   = OFF_BAR + 16384;

constexpr int LDS_BYTES = 160 * 1024;
#ifndef REP_ATTN
#define REP_ATTN 1
#endif
#ifndef REP_SCAN
#define REP_SCAN 1
#endif
#ifndef REP_GEMM
#define REP_GEMM 1
#endif

struct Params {
  const float *xp, *xs, *meta, *ln_g, *g_win, *g_conv, *g_alog, *g_dtb, *g_onorm, *g_wout;
  const float *m_win, *m_qn, *m_kvn, *m_wuq, *m_wukv, *m_qg, *m_kg, *m_wout;
  float* out; char* ws;
};

DI const float* h0_row(const Params& p, int sg, int pos) {
  return pos < 16 ? p.meta + (long)pos * D
                  : (sg < 4 ? p.xp + ((long)sg * SEQ + pos - 16) * D : p.xs + ((long)(sg - 4) * SEQ + pos - 16) * D);
}

DI void transpose_cvt(const float* __restrict__ src, u16* __restrict__ dst, int K, int N, int Npad,
                      const float* __restrict__ gain, int gmod, float* lds) {
  const int tid = otid();
  const int tK = K / 64, tN = Npad / 64;
  for (int tile = blockIdx.x; tile < tK * tN; tile += gridDim.x) {
    const int tk = tile % tK, tn = tile / tK;
#pragma unroll
    for (int i = 0; i < 2; ++i) {
      int kk = (tid >> 4) + 32 * i, nn = (tid & 15) * 4;
      int k = tk * 64 + kk, n = tn * 64 + nn;
      float4 v = make_float4(0.f, 0.f, 0.f, 0.f);
      if (n < N) v = *(const float4*)(src + (long)k * N + n);
      float gsc = gain ? gain[k % gmod] : 1.f;
      lds[kk * 65 + nn + 0] = v.x * gsc; lds[kk * 65 + nn + 1] = v.y * gsc;
      lds[kk * 65 + nn + 2] = v.z * gsc; lds[kk * 65 + nn + 3] = v.w * gsc;
    }
    __syncthreads();
    {
      int n = tid >> 3, k8 = (tid & 7) * 8;
      float f[8];
#pragma unroll
      for (int j = 0; j < 8; ++j) f[j] = lds[(k8 + j) * 65 + n];
      u32x4 w = {pk2(f[0], f[1]), pk2(f[2], f[3]), pk2(f[4], f[5]), pk2(f[6], f[7])};
      *(u32x4*)(dst + (long)(tn * 64 + n) * K + tk * 64 + k8) = w;
    }
    __syncthreads();
  }
}

DI void phase_prep(const Params& p, char* lds) {
  float* l = (float*)lds;
  transpose_cvt(p.g_win, (u16*)(p.ws + OFF_WGIN), 1024, GIN, GINP, p.ln_g, 1024, l);
  transpose_cvt(p.g_wout, (u16*)(p.ws + OFF_WGOUT), 2048, 1024, 1024, p.g_onorm, 256, l);
  transpose_cvt(p.m_win, (u16*)(p.ws + OFF_WMIN), 1024, MIN_, MINP, p.ln_g + 1024, 1024, l);
  transpose_cvt(p.m_wuq, (u16*)(p.ws + OFF_WUQ), 512, 3072, 3072, p.m_qn, 512, l);
  transpose_cvt(p.m_wukv, (u16*)(p.ws + OFF_WUKV), 256, 4096, 4096, p.m_kvn, 256, l);
  transpose_cvt(p.m_wout, (u16*)(p.ws + OFF_WMOUT), 2048, 1024, 1024, nullptr, 1, l);
  float* rope = (float*)(p.ws + OFF_ROPE);
  for (int i = blockIdx.x * 512 + otid(); i < 4112 * 32; i += gridDim.x * 512) {
    int pos = i >> 5, j = i & 31;
    float inv = __builtin_amdgcn_exp2f(-(float)j * (13.287712379549449f / 32.f));
    float ang = (float)pos * inv;
    float n = rintf(ang * 0.15915494309189535f);
    float rr = fmaf(-n, 6.28318548202514648f, ang); rr = fmaf(-n, -1.7484555e-7f, rr);
    float s = __sinf(rr), c = __cosf(rr);
    rope[pos * 64 + j] = c; rope[pos * 64 + 32 + j] = s;
  }
}

DI void phase_hn(const Params& p, int g, int layer) {
  const int lane = otid() & 63, wv = otid() >> 6;
  u16* HN = (u16*)(p.ws + OFF_HN);
  const float* h1m = (const float*)(p.ws + OFF_H1M);
  for (int row = blockIdx.x * 8 + wv; row < GR; row += gridDim.x * 8) {
    int seq = row / TP, r = row % TP, pos = r - PADR, sg = g * GS + seq;
    u16* dst = HN + (long)row * D;
    if (pos < 0) {
      u32x2 z = {0u, 0u};
#pragma unroll
      for (int i = 0; i < 4; ++i) *(u32x2*)(dst + i * 256 + lane * 4) = z;
      continue;
    }
    const float* src;
    if (layer == 0) src = h0_row(p, sg, pos);
    else src = pos < 16 ? h1m + ((long)sg * 16 + pos) * D : p.out + ((long)sg * SEQ + pos - 16) * D;
    float4 v[4]; float ss = 0.f;
#pragma unroll
    for (int i = 0; i < 4; ++i) { v[i] = *(const float4*)(src + i * 256 + lane * 4); ss += v[i].x * v[i].x + v[i].y * v[i].y + v[i].z * v[i].z + v[i].w * v[i].w; }
    ss = wave_sum(ss);
    float rs = rsqrtf(ss * (1.f / 1024.f) + EPS);
#pragma unroll
    for (int i = 0; i < 4; ++i) { u32x2 w = {pk2(v[i].x * rs, v[i].y * rs), pk2(v[i].z * rs, v[i].w * rs)}; *(u32x2*)(dst + i * 256 + lane * 4) = w; }
  }
}

template <int WM, int WN, int MT, int NT, class Epi>
DI void gemm_tile(const u16* __restrict__ A, int lda, const u16* __restrict__ Bt, int ldb, int K, int m0, int n0, char* lds, const Epi& epi) {
  constexpr int BM = WM * MT * 32, BN = WN * NT * 32, NA = BM * 8 / 512, NB = BN * 8 / 512;
  static_assert(WM * WN == 8, "8 waves");
  const int tid = otid(), lane = tid & 63, wid = tid >> 6, r32 = lane & 31, hi = lane >> 5;
  const int wm = wid / WN, wn = wid % WN;
  char* As = lds; char* Bs = lds + 2 * BM * 128;
  f32x16 acc[MT][NT];
#pragma unroll
  for (int a = 0; a < MT; ++a)
#pragma unroll
    for (int b = 0; b < NT; ++b)
#pragma unroll
      for (int r = 0; r < 16; ++r) acc[a][b][r] = 0.f;
  u32x4 ra[NA], rb[NB];
  const int nk = K / 64;
#define GLOAD(kt) do { _Pragma("unroll") for (int i = 0; i < NA; ++i) { int q = tid + 512 * i; int row = q >> 3, c = q & 7; \
      ra[i] = *(const u32x4*)(A + (long)(m0 + row) * lda + (kt) * 64 + c * 8); } \
    _Pragma("unroll") for (int i = 0; i < NB; ++i) { int q = tid + 512 * i; int row = q >> 3, c = q & 7; \
      rb[i] = *(const u32x4*)(Bt + (long)(n0 + row) * ldb + (kt) * 64 + c * 8); } } while (0)
#define SWRITE(buf) do { _Pragma("unroll") for (int i = 0; i < NA; ++i) { int q = tid + 512 * i; int row = q >> 3, c = q & 7; \
      *(u32x4*)(As + (buf) * BM * 128 + row * 128 + ((c ^ (row & 7)) << 4)) = ra[i]; } \
    _Pragma("unroll") for (int i = 0; i < NB; ++i) { int q = tid + 512 * i; int row = q >> 3, c = q & 7; \
      *(u32x4*)(Bs + (buf) * BN * 128 + row * 128 + ((c ^ (row & 7)) << 4)) = rb[i]; } } while (0)
  GLOAD(0); SWRITE(0); if (nk > 1) GLOAD(1);
  __syncthreads();
  for (int kt = 0; kt < nk; ++kt) {
    const int cur = kt & 1;
#pragma unroll
    for (int ks = 0; ks < 4; ++ks) {
      bf16x8 af[MT], bfr[NT];
      const int c = ks * 2 + hi;
#pragma unroll
      for (int a = 0; a < MT; ++a) { int row = (wm * MT + a) * 32 + r32; af[a] = *(const bf16x8*)(As + cur * BM * 128 + row * 128 + ((c ^ (row & 7)) << 4)); }
#pragma unroll
      for (int b = 0; b < NT; ++b) { int row = (wn * NT + b) * 32 + r32; bfr[b] = *(const bf16x8*)(Bs + cur * BN * 128 + row * 128 + ((c ^ (row & 7)) << 4)); }
#pragma unroll
      for (int a = 0; a < MT; ++a)
#pragma unroll
        for (int b = 0; b < NT; ++b) acc[a][b] = __builtin_amdgcn_mfma_f32_32x32x16_bf16(af[a], bfr[b], acc[a][b], 0, 0, 0);
    }
    if (kt + 1 < nk) { SWRITE(cur ^ 1); if (kt + 2 < nk) GLOAD(kt + 2); }
    __syncthreads();
  }
#undef GLOAD
#undef SWRITE
  epi(acc, m0 + wm * MT * 32, n0 + wn * NT * 32, lane);
}

struct EpiGin { u16 *P, *HALO, *Z; float* BA;
  DI void operator()(f32x16 (&acc)[2][2], int m0, int n0, int lane) const {
    const int r32 = lane & 31, hi = lane >> 5;
#pragma unroll
    for (int a = 0; a < 2; ++a)
#pragma unroll
      for (int b = 0; b < 2; ++b) {
        const int col = n0 + b * 32 + r32;
#pragma unroll
        for (int r = 0; r < 16; ++r) {
          const int row = m0 + a * 32 + crow(r, hi); const float v = acc[a][b][r];
          if (col < 4096) { u16 bv = f2bf(v); P[(long)row * 4096 + col] = bv; int rm = row & 63;
            if (rm < 2 || rm >= 62) HALO[((long)(row >> 6) * 4 + (rm < 2 ? rm : rm - 60)) * 4096 + col] = bv; }
          else if (col < 6144) Z[(long)row * 2048 + col - 4096] = f2bf(v);
          else if (col < GIN) BA[(long)row * 32 + col - 6144] = v;
        }
      }
  } };

struct EpiGout { Params p; int g; float* h1m;
  DI void operator()(f32x16 (&acc)[2][2], int m0, int n0, int lane) const {
    const int r32 = lane & 31, hi = lane >> 5;
#pragma unroll
    for (int a = 0; a < 2; ++a)
#pragma unroll
      for (int r = 0; r < 16; ++r) {
        const int row = m0 + a * 32 + crow(r, hi);
        const int seq = row / TP, rr = row % TP, pos = rr - PADR, sg = g * GS + seq;
        if (pos < 0) continue;
        const float* h0 = h0_row(p, sg, pos);
        float* dst = pos < 16 ? h1m + ((long)sg * 16 + pos) * D : p.out + ((long)sg * SEQ + pos - 16) * D;
#pragma unroll
        for (int b = 0; b < 2; ++b) { const int col = n0 + b * 32 + r32; dst[col] = h0[col] + acc[a][b][r]; }
      }
  } };

struct EpiMin { u16 *CQ, *CKV, *Z; float* KPE;
  DI void operator()(f32x16 (&acc)[2][2], int m0, int n0, int lane) const {
    const int r32 = lane & 31, hi = lane >> 5;
#pragma unroll
    for (int a = 0; a < 2; ++a)
#pragma unroll
      for (int b = 0; b < 2; ++b) {
        const int col = n0 + b * 32 + r32;
#pragma unroll
        for (int r = 0; r < 16; ++r) {
          const int row = m0 + a * 32 + crow(r, hi); const float v = acc[a][b][r];
          if (col < 512) CQ[(long)row * 512 + col] = f2bf(v);
          else if (col < 768) CKV[(long)row * 256 + col - 512] = f2bf(v);
          else if (col < 832) KPE[(long)row * 64 + col - 768] = v;
          else if (col < MIN_) Z[(long)row * 2048 + col - 832] = f2bf(v);
        }
      }
  } };

struct EpiQ { const float *rowst, *gq, *rope; u16* Q;
  DI void operator()(f32x16 (&acc)[1][6], int m0, int n0, int lane) const {
    const int r32 = lane & 31, hi = lane >> 5, head = n0 / 192;
    float ss[16];
#pragma unroll
    for (int r = 0; r < 16; ++r) {
      const int row = m0 + crow(r, hi); const float rq = rowst[row * 4 + 0]; float s = 0.f;
#pragma unroll
      for (int b = 0; b < 6; ++b) { acc[0][b][r] *= rq; s += acc[0][b][r] * acc[0][b][r]; }
      ss[r] = s;
    }
#pragma unroll
    for (int r = 0; r < 16; ++r) {
#pragma unroll
      for (int m = 16; m >= 1; m >>= 1) ss[r] += __shfl_xor(ss[r], m, 64);
    }
    float gc[6];
#pragma unroll
    for (int b = 0; b < 6; ++b) gc[b] = gq[b * 32 + r32];
#pragma unroll
    for (int r = 0; r < 16; ++r) {
      const int row = m0 + crow(r, hi); const int seq = row / TP, rr = row % TP; int pos = rr - PADR; pos = pos < 0 ? 0 : pos;
      const float rs = rsqrtf(ss[r] * (1.f / 192.f) + EPS);
      const float c = rope[pos * 64 + r32], s = rope[pos * 64 + 32 + r32];
      float x[6];
#pragma unroll
      for (int b = 0; b < 6; ++b) x[b] = acc[0][b][r] * rs * gc[b];
      const float x1 = x[4] * c - x[5] * s, x2 = x[5] * c + x[4] * s; x[4] = x1; x[5] = x2;
      u16* dst = Q + ((long)(seq * 16 + head) * TP + rr) * 192;
#pragma unroll
      for (int b = 0; b < 6; ++b) dst[b * 32 + r32] = f2bf(x[b]);
    }
  } };

struct EpiKV { const float *rowst, *gk, *kper; u16 *Kd, *Vd;
  DI void operator()(f32x16 (&acc)[1][4], int m0, int n0, int lane) const {
    const int r32 = lane & 31, hi = lane >> 5, head = n0 >> 8, isv = (n0 >> 7) & 1;
    if (isv) {
#pragma unroll
      for (int r = 0; r < 16; ++r) {
        const int row = m0 + crow(r, hi); const int seq = row / TP, rr = row % TP; const float rk = rowst[row * 4 + 1];
        u16* vd = Vd + ((long)(seq * 16 + head) * TP + rr) * 128;
#pragma unroll
        for (int b = 0; b < 4; ++b) vd[b * 32 + r32] = f2bf(acc[0][b][r] * rk);
      }
      return;
    }
    float ss[16];
#pragma unroll
    for (int r = 0; r < 16; ++r) {
      const int row = m0 + crow(r, hi); const float rk = rowst[row * 4 + 1]; float s = 0.f;
#pragma unroll
      for (int b = 0; b < 4; ++b) { acc[0][b][r] *= rk; s += acc[0][b][r] * acc[0][b][r]; }
      ss[r] = s;
    }
#pragma unroll
    for (int r = 0; r < 16; ++r) {
#pragma unroll
      for (int m = 16; m >= 1; m >>= 1) ss[r] += __shfl_xor(ss[r], m, 64);
    }
    float gc[4];
#pragma unroll
    for (int b = 0; b < 4; ++b) gc[b] = gk[b * 32 + r32];
#pragma unroll
    for (int r = 0; r < 16; ++r) {
      const int row = m0 + crow(r, hi); const int seq = row / TP, rr = row % TP;
      const float rs = rsqrtf((ss[r] + rowst[row * 4 + 2]) * (1.f / 192.f) + EPS);
      u16* kd = Kd + ((long)(seq * 16 + head) * TP + rr) * 192;
#pragma unroll
      for (int b = 0; b < 4; ++b) kd[b * 32 + r32] = f2bf(acc[0][b][r] * rs * gc[b]);
      kd[128 + r32] = f2bf(kper[(long)row * 64 + r32] * rs);
      kd[160 + r32] = f2bf(kper[(long)row * 64 + 32 + r32] * rs);
    }
  } };

struct EpiMout { float* out; int g;
  DI void operator()(f32x16 (&acc)[2][2], int m0, int n0, int lane) const {
    const int r32 = lane & 31, hi = lane >> 5;
#pragma unroll
    for (int a = 0; a < 2; ++a)
#pragma unroll
      for (int r = 0; r < 16; ++r) {
        const int row = m0 + a * 32 + crow(r, hi);
        const int seq = row / TP, rr = row % TP, pos = rr - PADR, sg = g * GS + seq;
        if (pos < 16) continue;
        float* dst = out + ((long)sg * SEQ + pos - 16) * D;
#pragma unroll
        for (int b = 0; b < 2; ++b) { const int col = n0 + b * 32 + r32; dst[col] += acc[a][b][r]; }
      }
  } };

template <int WM, int WN, int MT, int NT, class Epi>
DI void gemm_phase(const u16* A, int lda, const u16* Bt, int ldb, int K, int Npad, char* lds, const Epi& epi) {
  constexpr int BM = WM * MT * 32, BN = WN * NT * 32;
  constexpr int nM = GR / BM;
  const int nN = Npad / BN, total = nM * nN;
  if (gridDim.x == 256 && nM == 65) {
    const int x = blockIdx.x & 7, lb = blockIdx.x >> 3, full = 64 * nN;
    for (int i = 0;; ++i) {
      const int L = (i * 8 + x) * 32 + lb;
      if (L >= total) break;
      int tm, tn;
      if (L < full) { const int panel = L / (4 * nN), w = L % (4 * nN); tn = w >> 2; tm = panel * 4 + (w & 3); }
      else { tm = 64; tn = L - full; }
      gemm_tile<WM, WN, MT, NT, Epi>(A, lda, Bt, ldb, K, tm * BM, tn * BN, lds, epi);
    }
  } else {
    for (int t = blockIdx.x; t < total; t += gridDim.x) {
      const int tm = t % nM, tn = t / nM;
      gemm_tile<WM, WN, MT, NT, Epi>(A, lda, Bt, ldb, K, tm * BM, tn * BN, lds, epi);
    }
  }
}

DI void phase_chunk(const Params& p, char* lds) {
  u16* P = (u16*)(p.ws + OFF_P); const u16* HALO = (const u16*)(p.ws + OFF_HALO);
  const float* BA = (const float*)(p.ws + OFF_BA); float* SCg = (float*)(p.ws + OFF_SC);
  u16* TQg = (u16*)(p.ws + OFF_TQ); u16* KTg = (u16*)(p.ws + OFF_KT);
  char* Qs = lds; char* Ks = lds + 16384; float* M0 = (float*)(lds + 32768);
  float* sbeta = (float*)(lds + 98304); float* sg = sbeta + 128; float* sgc = sg + 128;
  const int tid0 = otid();
  for (int item = blockIdx.x; item < GS * 8 * NCHUNK; item += gridDim.x) {
    int tid = tid0; asm volatile("" : "+v"(tid));
    const int lane = tid & 63, wid = tid >> 6, cp = tid & 255, rh = tid >> 8, part = (tid >> 6) & 3;
    const int ch = cp * 2;
    const int chunk = item % NCHUNK, h = (item / NCHUNK) % 8, seq = item / (NCHUNK * 8);
    const int col = ch < 128 ? h * 128 + ch : (ch < 256 ? 1024 + h * 128 + (ch - 128) : 2048 + h * 256 + (ch - 256));
    const int R0 = seq * TP + chunk * 64, cg_ = seq * NCHUNK + chunk;
    unsigned outv[32];
    {
      float w0[5], w1[5];
#pragma unroll
      for (int j = 0; j < 5; ++j) { w0[j] = p.g_conv[j * 4096 + col]; w1[j] = p.g_conv[j * 4096 + col + 1]; }
      unsigned x[36];
#pragma unroll
      for (int i = 0; i < 36; ++i) {
        const int rr = rh * 32 + i - 2;
        unsigned v = 0u;
        if (rr >= 0 && rr < 64) v = *(const unsigned*)(P + (long)(R0 + rr) * 4096 + col);
        else if (rr < 0) { if (cg_ > 0) v = *(const unsigned*)(HALO + ((long)(cg_ - 1) * 4 + 2 + (rr + 2)) * 4096 + col); }
        else { if (cg_ + 1 < GS * NCHUNK) v = *(const unsigned*)(HALO + ((long)(cg_ + 1) * 4 + (rr - 64)) * 4096 + col); }
        x[i] = v;
      }
#pragma unroll
      for (int o = 0; o < 32; ++o) {
        float a0 = 0.f, a1 = 0.f;
#pragma unroll
        for (int j = 0; j < 5; ++j) { a0 += w0[j] * bflo(x[o + j]); a1 += w1[j] * bfhi(x[o + j]); }
        a0 = silu(a0); a1 = silu(a1);
        if (part < 2) {
          float ss = wave_sum(a0 * a0 + a1 * a1);
          float sc = rsqrtf(ss + EPS) * (part == 0 ? 0.08838834764831845f : 1.f);
          a0 *= sc; a1 *= sc;
        }
        const int row = rh * 32 + o;
        if (chunk == 0 && row < PADR) { a0 = 0.f; a1 = 0.f; }
        outv[o] = pk2(a0, a1);
        if ((o & 3) == 3) SBAR();
      }
    }
    __syncthreads();
#pragma unroll
    for (int o = 0; o < 32; ++o) *(unsigned*)(P + (long)(R0 + rh * 32 + o) * 4096 + col) = outv[o];
    if (part < 2) {
      char* dstT = part == 0 ? Qs : Ks; const int chl = ch - part * 128;
#pragma unroll
      for (int o = 0; o < 32; ++o) { const int row = rh * 32 + o;
        *(unsigned*)(dstT + row * 256 + ((((chl >> 3) ^ (row & 7))) << 4) + (chl & 7) * 2) = outv[o]; }
      if (part == 1) {
        u16* kt = KTg + ((long)(seq * 8 + h) * NCHUNK + chunk) * 8192 + (long)chl * 64 + rh * 32;
#pragma unroll
        for (int q4 = 0; q4 < 4; ++q4) {
          u32x4 lo, hi4;
#pragma unroll
          for (int e = 0; e < 4; ++e) { const unsigned a = outv[q4 * 8 + 2 * e], b = outv[q4 * 8 + 2 * e + 1];
            lo[e] = (a & 0xffffu) | (b << 16); hi4[e] = (a >> 16) | (b & 0xffff0000u); }
          *(u32x4*)(kt + q4 * 8) = lo; *(u32x4*)(kt + 64 + q4 * 8) = hi4;
          SBAR();
        }
      }
    }
    if (tid < 128) {
      const int r = tid & 63, dir = tid >> 6; const long row = R0 + r;
      const float b = BA[row * 32 + dir * 8 + h], a = BA[row * 32 + 16 + dir * 8 + h];
      float beta = 1.f / (1.f + __expf(-b));
      float xx = a + p.g_dtb[dir * 8 + h];
      float sp = xx > 20.f ? xx : __logf(1.f + __expf(xx));
      float gg = -__expf(p.g_alog[dir * 8 + h]) * sp;
      if (chunk == 0 && r < PADR) { beta = 0.f; gg = 0.f; }
      float gc = gg;
#pragma unroll
      for (int off = 1; off < 64; off <<= 1) {
        const float up = __shfl_up(gc, off, 64), dn = __shfl_down(gc, off, 64);
        if (dir == 0) { if (r >= off) gc += up; } else { if (r + off < 64) gc += dn; }
      }
      const float gl = __shfl(gc, dir == 0 ? 63 : 0, 64);
      sbeta[dir * 64 + r] = beta; sgc[dir * 64 + r] = gc;
      f32x4 st = {beta, __expf(gc), __expf(gl - gc), __expf(gl)};
      *(f32x4*)(SCg + ((long)((seq * 8 + h) * 2 + dir) * TP + chunk * 64 + r) * 4) = st;
    }
    __syncthreads();
    {
      const int kind = wid >> 2, qi = (wid >> 1) & 1, qj = wid & 1;
      int r32 = lane & 31, hi = lane >> 5;
      asm volatile("" : "+v"(r32), "+v"(hi));
      const char* At = kind ? Qs : Ks;
      f32x16 acc;
#pragma unroll
      for (int r = 0; r < 16; ++r) acc[r] = 0.f;
#pragma unroll
      for (int ks = 0; ks < 8; ++ks) {
        const int c = ks * 2 + hi; const int ra = qi * 32 + r32, rb = qj * 32 + r32;
        bf16x8 af = *(const bf16x8*)(At + ra * 256 + ((c ^ (ra & 7)) << 4));
        bf16x8 bfr = *(const bf16x8*)(Ks + rb * 256 + ((c ^ (rb & 7)) << 4));
        acc = __builtin_amdgcn_mfma_f32_32x32x16_bf16(af, bfr, acc, 0, 0, 0);
        if (ks & 1) SBAR();
      }
      const int j = qj * 32 + r32;
      u16* Ag0 = TQg + ((long)((seq * 8 + h) * 2 + 0) * NCHUNK + chunk) * 8192 + 4096;
      u16* Ag1 = TQg + ((long)((seq * 8 + h) * 2 + 1) * NCHUNK + chunk) * 8192 + 4096;
      const float gj0 = sgc[j], gj1 = sgc[64 + j];
#pragma unroll
      for (int r = 0; r < 16; ++r) {
        const int i = qi * 32 + crow(r, hi);
        const float e0 = __expf(fminf(sgc[i] - gj0, 0.f)), e1 = __expf(fminf(sgc[64 + i] - gj1, 0.f));
        if (kind == 0) {
          M0[i * 64 + j] = j < i ? sbeta[i] * acc[r] * e0 : 0.f;
          M0[4096 + (63 - i) * 64 + (63 - j)] = j > i ? sbeta[64 + i] * acc[r] * e1 : 0.f;
        } else {
          Ag0[i * 64 + j] = f2bf(j <= i ? acc[r] * e0 : 0.f);
          Ag1[i * 64 + j] = f2bf(j >= i ? acc[r] * e1 : 0.f);
        }
        SBAR();
      }
    }
    __syncthreads();
    if (wid < 2) {
      const int d = wid; const float* M = M0 + d * 4096; float* Tl = M0 + 8192 + d * 4096;
#pragma unroll 1
      for (int a0 = 0; a0 < 64; a0 += 4) {
        float c0 = (a0 + 0 == lane) ? 1.f : 0.f, c1 = (a0 + 1 == lane) ? 1.f : 0.f, c2 = (a0 + 2 == lane) ? 1.f : 0.f, c3 = (a0 + 3 == lane) ? 1.f : 0.f;
        const float* Mr = M + a0 * 64;
#pragma unroll 2
        for (int b = 0; b < a0; b += 4) {
          const f32x4 m0 = *(const f32x4*)(Mr + b), m1 = *(const f32x4*)(Mr + 64 + b), m2 = *(const f32x4*)(Mr + 128 + b), m3 = *(const f32x4*)(Mr + 192 + b);
          const float t0 = Tl[(b + 0) * 64 + lane], t1 = Tl[(b + 1) * 64 + lane], t2 = Tl[(b + 2) * 64 + lane], t3 = Tl[(b + 3) * 64 + lane];
          c0 -= m0[0] * t0 + m0[1] * t1 + m0[2] * t2 + m0[3] * t3;
          c1 -= m1[0] * t0 + m1[1] * t1 + m1[2] * t2 + m1[3] * t3;
          c2 -= m2[0] * t0 + m2[1] * t1 + m2[2] * t2 + m2[3] * t3;
          c3 -= m3[0] * t0 + m3[1] * t1 + m3[2] * t2 + m3[3] * t3;
        }
        const f32x4 d1 = *(const f32x4*)(Mr + 64 + a0), d2 = *(const f32x4*)(Mr + 128 + a0), d3 = *(const f32x4*)(Mr + 192 + a0);
        c1 -= d1[0] * c0;
        c2 -= d2[0] * c0 + d2[1] * c1;
        c3 -= d3[0] * c0 + d3[1] * c1 + d3[2] * c2;
        Tl[(a0 + 0) * 64 + lane] = c0; Tl[(a0 + 1) * 64 + lane] = c1; Tl[(a0 + 2) * 64 + lane] = c2; Tl[(a0 + 3) * 64 + lane] = c3;
      }
      u16* Tg = TQg + ((long)((seq * 8 + h) * 2 + d) * NCHUNK + chunk) * 8192;
#pragma unroll 4
      for (int a = 0; a < 64; ++a) {
        const float tv = Tl[a * 64 + lane];
        if (d == 0) Tg[a * 64 + lane] = f2bf(tv); else Tg[(63 - a) * 64 + (63 - lane)] = f2bf(tv);
      }
    }
  }
}

DI bf16x8 pack8(f32x4 a, f32x4 b) { u32x4 w = {pk2(a[0], a[1]), pk2(a[2], a[3]), pk2(b[0], b[1]), pk2(b[2], b[3])}; return __builtin_bit_cast(bf16x8, w); }
DI bf16x8 ld_frag(const char* ptr) { u32x2 lo = *(const u32x2*)ptr; u32x2 hi = *(const u32x2*)(ptr + 32); u32x4 w = {lo[0], lo[1], hi[0], hi[1]}; return __builtin_bit_cast(bf16x8, w); }
#define MFMA16(a, b, c) __builtin_amdgcn_mfma_f32_16x16x32_bf16((a), (b), (c), 0, 0, 0)
constexpr int SB_Q = 0, SB_K = 17408, SB_KT = 34816, SB_T = 53248, SB_A = 62464, SB_V = 71680, SB_SC = 79872, SB_SIZE = 80896;

DI void scan_load(const Params& p, int seq, int h, int dir, int dvq, int cc, char* B, int lt) {
  const u16* P = (const u16*)(p.ws + OFF_P);
  const long R0 = (long)seq * TP + cc * 64;
  const u16* Pq = P + R0 * 4096 + h * 128; const u16* Pk = Pq + 1024; const u16* Pv = P + R0 * 4096 + 2048 + h * 256 + dvq * 64;
  const u16* KTg = (const u16*)(p.ws + OFF_KT) + ((long)(seq * 8 + h) * NCHUNK + cc) * 8192;
  const u16* Tg = (const u16*)(p.ws + OFF_TQ) + ((long)((seq * 8 + h) * 2 + dir) * NCHUNK + cc) * 8192;
  const float* SCg = (const float*)(p.ws + OFF_SC) + ((long)((seq * 8 + h) * 2 + dir) * TP + cc * 64) * 4;
  u32x4 rq[4], rk[4], rkt[4], rt[2], ra[2], rv[2]; f32x4 rs = {0.f, 0.f, 0.f, 0.f};
#pragma unroll
  for (int i = 0; i < 4; ++i) { const int e = lt + 256 * i, row = e >> 4, c = e & 15;
    rq[i] = *(const u32x4*)(Pq + (long)row * 4096 + c * 8); rk[i] = *(const u32x4*)(Pk + (long)row * 4096 + c * 8); }
#pragma unroll
  for (int i = 0; i < 4; ++i) { const int e = lt + 256 * i, row = e >> 3, c = e & 7; rkt[i] = *(const u32x4*)(KTg + row * 64 + c * 8); }
#pragma unroll
  for (int i = 0; i < 2; ++i) { const int e = lt + 256 * i, row = e >> 3, c = e & 7;
    rt[i] = *(const u32x4*)(Tg + row * 64 + c * 8); ra[i] = *(const u32x4*)(Tg + 4096 + row * 64 + c * 8);
    rv[i] = *(const u32x4*)(Pv + (long)row * 4096 + c * 8); }
  if (lt < 64) rs = *(const f32x4*)(SCg + lt * 4);
#pragma unroll
  for (int i = 0; i < 4; ++i) { const int e = lt + 256 * i, row = e >> 4, c = e & 15;
    *(u32x4*)(B + SB_Q + row * 272 + c * 16) = rq[i]; *(u32x4*)(B + SB_K + row * 272 + c * 16) = rk[i]; }
#pragma unroll
  for (int i = 0; i < 4; ++i) { const int e = lt + 256 * i, row = e >> 3, c = e & 7; *(u32x4*)(B + SB_KT + row * 144 + c * 16) = rkt[i]; }
#pragma unroll
  for (int i = 0; i < 2; ++i) { const int e = lt + 256 * i, row = e >> 3, c = e & 7;
    *(u32x4*)(B + SB_T + row * 144 + c * 16) = rt[i]; *(u32x4*)(B + SB_A + row * 144 + c * 16) = ra[i];
    *(u32x4*)(B + SB_V + row * 128 + c * 16) = rv[i]; }
  if (lt < 64) *(f32x4*)(B + SB_SC + lt * 16) = rs;
}

DI void phase_scan(const Params& p, char* lds) {
  for (int item = blockIdx.x; item < GS * 8 * 2 * 4; item += gridDim.x) {
    const int tid = otid(), wid = tid >> 6, lane = tid & 63, n = lane & 15, quad = lane >> 4;
    int dvq = item & 3, tri = item >> 2;
    if (gridDim.x == 256) { const int x = item & 7, lb = item >> 3; dvq = lb & 3; tri = x + 8 * (lb >> 2); }
    const int dir = tri & 1, h = (tri >> 1) & 7, seq = tri >> 4;
    u16* O = (u16*)(p.ws + (dir ? OFF_OB : OFF_OF));
    f32x4 S[8];
#pragma unroll
    for (int t = 0; t < 8; ++t) S[t] = (f32x4){0.f, 0.f, 0.f, 0.f};
    __syncthreads();
    if (wid >= 4) scan_load(p, seq, h, dir, dvq, dir ? NCHUNK - 1 : 0, lds, tid - 256);
    __syncthreads();
#pragma unroll 1
    for (int c = 0; c < NCHUNK; ++c) {
      const int cc = dir ? NCHUNK - 1 - c : c;
      if (wid >= 4) {
        if (c + 1 < NCHUNK) scan_load(p, seq, h, dir, dvq, dir ? NCHUNK - 2 - c : c + 1, lds + ((c + 1) & 1) * SB_SIZE, tid - 256);
      } else {
        const char* B = lds + (c & 1) * SB_SIZE;
        const long R0 = (long)seq * TP + cc * 64;
        bf16x8 Sb[4];
#pragma unroll
        for (int ks = 0; ks < 4; ++ks) Sb[ks] = pack8(S[2 * ks], S[2 * ks + 1]);
        f32x4 KS[4], QS[4];
#pragma unroll
        for (int mt = 0; mt < 4; ++mt) {
          KS[mt] = (f32x4){0.f, 0.f, 0.f, 0.f}; QS[mt] = (f32x4){0.f, 0.f, 0.f, 0.f};
#pragma unroll
          for (int ks = 0; ks < 4; ++ks) {
            const int off = (16 * mt + n) * 272 + 64 * ks + 8 * quad;
            KS[mt] = MFMA16(ld_frag(B + SB_K + off), Sb[ks], KS[mt]);
            QS[mt] = MFMA16(ld_frag(B + SB_Q + off), Sb[ks], QS[mt]);
          }
        }
        f32x4 rhs[4], egc[4], ekd[4]; float egl = 1.f;
#pragma unroll
        for (int mt = 0; mt < 4; ++mt)
#pragma unroll
          for (int i = 0; i < 4; ++i) {
            const int row = 16 * mt + 4 * quad + i;
            const f32x4 sc = *(const f32x4*)(B + SB_SC + row * 16);
            const float v = bf2f(*(const u16*)(B + SB_V + row * 128 + (wid * 16 + n) * 2));
            egc[mt][i] = sc[1]; ekd[mt][i] = sc[2]; egl = sc[3];
            rhs[mt][i] = sc[0] * (v - sc[1] * KS[mt][i]);
          }
        bf16x8 Rb[2];
#pragma unroll
        for (int k2 = 0; k2 < 2; ++k2) Rb[k2] = pack8(rhs[2 * k2], rhs[2 * k2 + 1]);
        f32x4 VN[4];
#pragma unroll
        for (int mt = 0; mt < 4; ++mt) {
          VN[mt] = (f32x4){0.f, 0.f, 0.f, 0.f};
#pragma unroll
          for (int k2 = 0; k2 < 2; ++k2) VN[mt] = MFMA16(ld_frag(B + SB_T + (16 * mt + n) * 144 + 64 * k2 + 8 * quad), Rb[k2], VN[mt]);
        }
        bf16x8 Vb[2], Vd[2];
#pragma unroll
        for (int k2 = 0; k2 < 2; ++k2) {
          Vb[k2] = pack8(VN[2 * k2], VN[2 * k2 + 1]);
          Vd[k2] = pack8(VN[2 * k2] * ekd[2 * k2], VN[2 * k2 + 1] * ekd[2 * k2 + 1]);
        }
#pragma unroll
        for (int mt = 0; mt < 4; ++mt) {
          f32x4 o = QS[mt] * egc[mt];
#pragma unroll
          for (int k2 = 0; k2 < 2; ++k2) o = MFMA16(ld_frag(B + SB_A + (16 * mt + n) * 144 + 64 * k2 + 8 * quad), Vb[k2], o);
#pragma unroll
          for (int i = 0; i < 4; ++i) O[(R0 + 16 * mt + 4 * quad + i) * 2048 + h * 256 + dvq * 64 + wid * 16 + n] = f2bf(o[i]);
        }
#pragma unroll
        for (int t = 0; t < 8; ++t) {
          S[t] = S[t] * egl;
#pragma unroll
          for (int k2 = 0; k2 < 2; ++k2) S[t] = MFMA16(ld_frag(B + SB_KT + (16 * t + n) * 144 + 64 * k2 + 8 * quad), Vd[k2], S[t]);
        }
      }
      __syncthreads();
    }
  }
}

DI void phase_gate(const Params& p) {
  u16* OFp = (u16*)(p.ws + OFF_OF); const u16* OBp = (const u16*)(p.ws + OFF_OB); const u16* Z = (const u16*)(p.ws + OFF_Z);
  const int lane = otid() & 63, wv = otid() >> 6;
  for (int it = blockIdx.x * 8 + wv; it < GR * 8; it += gridDim.x * 8) {
    const long off = (long)it * 256 + lane * 4;
    u32x2 a = *(const u32x2*)(OFp + off), b = *(const u32x2*)(OBp + off), z = *(const u32x2*)(Z + off);
    float o0 = bflo(a[0]) + bflo(b[0]), o1 = bfhi(a[0]) + bfhi(b[0]), o2 = bflo(a[1]) + bflo(b[1]), o3 = bfhi(a[1]) + bfhi(b[1]);
    float ss = wave_sum(o0 * o0 + o1 * o1 + o2 * o2 + o3 * o3);
    float rs = rsqrtf(ss * (1.f / 256.f) + EPS);
    u32x2 w = {pk2(o0 * rs * silu(bflo(z[0])), o1 * rs * silu(bfhi(z[0]))), pk2(o2 * rs * silu(bflo(z[1])), o3 * rs * silu(bfhi(z[1])))};
    *(u32x2*)(OFp + off) = w;
  }
}

DI void phase_rowstats(const Params& p) {
  const u16* CQ = (const u16*)(p.ws + OFF_CQ); const u16* CKV = (const u16*)(p.ws + OFF_CKV); const float* KPE = (const float*)(p.ws + OFF_KPE);
  float* rowst = (float*)(p.ws + OFF_ROWST); float* kper = (float*)(p.ws + OFF_KPER); const float* rope = (const float*)(p.ws + OFF_ROPE);
  const int lane = otid() & 63, wv = otid() >> 6;
  for (int row = blockIdx.x * 8 + wv; row < GR; row += gridDim.x * 8) {
    u32x4 q = *(const u32x4*)(CQ + (long)row * 512 + lane * 8);
    float sq = 0.f;
#pragma unroll
    for (int j = 0; j < 4; ++j) { float a = bflo(q[j]), b = bfhi(q[j]); sq += a * a + b * b; }
    u32x2 kv = *(const u32x2*)(CKV + (long)row * 256 + lane * 4);
    float sk = 0.f;
#pragma unroll
    for (int j = 0; j < 2; ++j) { float a = bflo(kv[j]), b = bfhi(kv[j]); sk += a * a + b * b; }
    const float kp = KPE[(long)row * 64 + lane];
    sq = wave_sum(sq); sk = wave_sum(sk); const float sp = wave_sum(kp * kp);
    const float val = kp * p.m_kg[128 + lane];
    const float oth = __shfl_xor(val, 32, 64);
    int pos = row % TP - PADR; pos = pos < 0 ? 0 : pos;
    const int i = lane & 31; const float c = rope[pos * 64 + i], s = rope[pos * 64 + 32 + i];
    kper[(long)row * 64 + lane] = lane < 32 ? val * c - oth * s : val * c + oth * s;
    if (lane == 0) { f32x4 st = {rsqrtf(sq * (1.f / 512.f) + EPS), rsqrtf(sk * (1.f / 256.f) + EPS), sp, 0.f}; *(f32x4*)(rowst + (long)row * 4) = st; }
  }
}

constexpr float ATT_SCALE = 0.07216878364870322f;
constexpr float ATT_THR = 8.f;
constexpr int SHM_V = 64 * 128 * 2, SHM_K = 64 * 192 * 2;
DI int v_st(int k, int c) { const int kk = (k & ~0xC) | ((k & 4) << 1) | ((k & 8) >> 1); return ((kk >> 3) * 4 + (c >> 5)) * 512 + ((kk & 7) * 32 + (c & 31)) * 2; }
DI int v_rd_base(int lane) { return ((lane & 3) << 3) | (((lane >> 2) & 3) << 6) | (((lane >> 4) & 1) << 5) | (((lane >> 5) & 1) << 8); }
constexpr int v_rd_off(int d0, int ks, int half) { return d0 * 512 + ks * 4096 + half * 2048; }
template <int OFF> DI s16x4 tr_read(int vb) {
  s16x4 r; asm volatile("ds_read_b64_tr_b16 %0, %1 offset:%2" : "=&v"(r) : "v"(vb), "i"(OFF) : "memory"); return r;
}
#define RD8(D0, X) do { X##0 = tr_read<v_rd_off(D0, 0, 0)>(vb); X##1 = tr_read<v_rd_off(D0, 0, 1)>(vb); X##2 = tr_read<v_rd_off(D0, 1, 0)>(vb); X##3 = tr_read<v_rd_off(D0, 1, 1)>(vb); \
    X##4 = tr_read<v_rd_off(D0, 2, 0)>(vb); X##5 = tr_read<v_rd_off(D0, 2, 1)>(vb); X##6 = tr_read<v_rd_off(D0, 3, 0)>(vb); X##7 = tr_read<v_rd_off(D0, 3, 1)>(vb); } while (0)
#define PKV(L, H) (bf16x8){L[0], L[1], L[2], L[3], H[0], H[1], H[2], H[3]}
#define MM4(OD, X) do { OD = __builtin_amdgcn_mfma_f32_32x32x16_bf16(pa0, PKV(X##0, X##1), OD, 0, 0, 0); OD = __builtin_amdgcn_mfma_f32_32x32x16_bf16(pa1, PKV(X##2, X##3), OD, 0, 0, 0); \
    OD = __builtin_amdgcn_mfma_f32_32x32x16_bf16(pa2, PKV(X##4, X##5), OD, 0, 0, 0); OD = __builtin_amdgcn_mfma_f32_32x32x16_bf16(pa3, PKV(X##6, X##7), OD, 0, 0, 0); } while (0)
DI void pv_all(f32x16* o, int vb, bf16x8 pa0, bf16x8 pa1, bf16x8 pa2, bf16x8 pa3) {
  s16x4 a0, a1, a2, a3, a4, a5, a6, a7, b0, b1, b2, b3, b4, b5, b6, b7;
  RD8(0, a); RD8(1, b);
  asm volatile("s_waitcnt lgkmcnt(8)" ::: "memory"); SBAR(); MM4(o[0], a); SBAR();
  RD8(2, a);
  asm volatile("s_waitcnt lgkmcnt(8)" ::: "memory"); SBAR(); MM4(o[1], b); SBAR();
  RD8(3, b);
  asm volatile("s_waitcnt lgkmcnt(8)" ::: "memory"); SBAR(); MM4(o[2], a); SBAR();
  asm volatile("s_waitcnt lgkmcnt(0)" ::: "memory"); SBAR(); MM4(o[3], b); SBAR();
}
#undef RD8
#undef MM4
#undef PKV

DI void attn_item(const u16* __restrict__ Qb, const u16* __restrict__ Kh, const u16* __restrict__ Vh, int q0,
                  u16* __restrict__ Yb, const u16* __restrict__ Zb, char* lds) {
  const int tid = otid(), wid = tid >> 6, lane = tid & 63, r32 = lane & 31, hi = lane >> 5;
  char* V_lds = lds; char* K_lds = lds + 3 * SHM_V;
  float* wsf = (float*)(lds + 3 * SHM_V + 3 * SHM_K) + wid * 64; float* li_l = wsf; float* al_l = wsf + 32;
  constexpr float C = ATT_SCALE * 1.4426950408889634f;
  float m_reg = -1e30f, l_reg = 0.f;
  f32x16 o[4];
#pragma unroll
  for (int d = 0; d < 4; ++d)
#pragma unroll
    for (int r = 0; r < 16; ++r) o[d][r] = 0.f;
  bf16x8 qr[12];
  const int qrow = q0 + wid * 32 + r32;
#pragma unroll
  for (int d0 = 0; d0 < 12; ++d0) {
    bf16x8 z = {0, 0, 0, 0, 0, 0, 0, 0};
    qr[d0] = qrow < TP ? *(const bf16x8*)(Qb + (long)qrow * 192 + d0 * 16 + hi * 8) : z;
  }
  const int sr = tid >> 4, sc = (tid & 15) * 8, vst0 = v_st(sr, sc), vst1 = v_st(32 + sr, sc);
  const int vb0 = (int)(uintptr_t)V_lds + v_rd_base(lane);
  u32x4 kst[3], vst[2];
#define KLOAD(k0) do { _Pragma("unroll") for (int i = 0; i < 3; ++i) { int q = tid + 512 * i; int row = q / 24, c = q % 24; \
      kst[i] = *(const u32x4*)(Kh + (long)((k0) + row) * 192 + c * 8); } } while (0)
#define VLOAD(k0) do { vst[0] = *(const u32x4*)(Vh + (long)((k0) + sr) * 128 + sc); vst[1] = *(const u32x4*)(Vh + (long)((k0) + 32 + sr) * 128 + sc); } while (0)
#define KWRITE(b) do { _Pragma("unroll") for (int i = 0; i < 3; ++i) { int q = tid + 512 * i; int row = q / 24, c = q % 24; \
      *(u32x4*)(K_lds + (b) * SHM_K + row * 384 + ((c * 16) ^ ((row & 7) << 4))) = kst[i]; } } while (0)
#define VWRITE(b) do { *(u32x4*)(V_lds + (b) * SHM_V + vst0) = vst[0]; *(u32x4*)(V_lds + (b) * SHM_V + vst1) = vst[1]; } while (0)
  constexpr int NT = TP / 64;
  __syncthreads();
  KLOAD(0); VLOAD(0); KWRITE(0); VWRITE(0); KLOAD(64); VLOAD(64); KWRITE(1); VWRITE(1);
  __syncthreads();
  int bcur = 0, bnext2 = 2;
#pragma unroll 1
  for (int j = 0; j < NT; ++j) {
    if (j + 2 < NT) { KLOAD((j + 2) * 64); VLOAD((j + 2) * 64); }
    f32x16 p0, p1;
#pragma unroll
    for (int r = 0; r < 16; ++r) { p0[r] = 0.f; p1[r] = 0.f; }
    const char* Kc = K_lds + bcur * SHM_K;
    {
      const int swz = (r32 & 7) << 4;
      const char* Kr0 = Kc + r32 * 384; const char* Kr1 = Kc + (32 + r32) * 384;
      bf16x8 kf[2][4];
#define KFLOAD(G, S) do { const int cb0 = ((2 * (G)) * 16 + hi * 8) * 2, cb1 = ((2 * (G) + 1) * 16 + hi * 8) * 2; \
        kf[S][0] = *(const bf16x8*)(Kr0 + (cb0 ^ swz)); kf[S][1] = *(const bf16x8*)(Kr1 + (cb0 ^ swz)); \
        kf[S][2] = *(const bf16x8*)(Kr0 + (cb1 ^ swz)); kf[S][3] = *(const bf16x8*)(Kr1 + (cb1 ^ swz)); } while (0)
      KFLOAD(0, 0);
#pragma unroll
      for (int g = 0; g < 6; ++g) {
        if (g + 1 < 6) { if (g & 1) KFLOAD(g + 1, 0); else KFLOAD(g + 1, 1); }
        p0 = __builtin_amdgcn_mfma_f32_32x32x16_bf16(kf[g & 1][0], qr[2 * g], p0, 0, 0, 0);
        p1 = __builtin_amdgcn_mfma_f32_32x32x16_bf16(kf[g & 1][1], qr[2 * g], p1, 0, 0, 0);
        p0 = __builtin_amdgcn_mfma_f32_32x32x16_bf16(kf[g & 1][2], qr[2 * g + 1], p0, 0, 0, 0);
        p1 = __builtin_amdgcn_mfma_f32_32x32x16_bf16(kf[g & 1][3], qr[2 * g + 1], p1, 0, 0, 0);
        __builtin_amdgcn_sched_group_barrier(0x100, 4, 0);
        __builtin_amdgcn_sched_group_barrier(0x008, 4, 0);
        SBAR();
      }
#undef KFLOAD
    }
    if (j == 0) {
#pragma unroll
      for (int r = 0; r < 16; ++r) p0[r] = -1e30f;
#pragma unroll
      for (int r = 0; r < 8; ++r) p1[r] = -1e30f;
    }
    float pmax = p0[0];
#pragma unroll
    for (int r = 1; r < 16; ++r) pmax = fmaxf(pmax, p0[r]);
#pragma unroll
    for (int r = 0; r < 16; ++r) pmax = fmaxf(pmax, p1[r]);
    { auto rr = __builtin_amdgcn_permlane32_swap(__float_as_uint(pmax), __float_as_uint(pmax), false, false);
      pmax = fmaxf(__uint_as_float(rr[0]), __uint_as_float(rr[1])); }
    float mn, alpha;
    if (__all(pmax - m_reg <= ATT_THR / ATT_SCALE)) { mn = m_reg; alpha = 1.f; }
    else { mn = fmaxf(m_reg, pmax); alpha = __builtin_amdgcn_exp2f((m_reg - mn) * C); m_reg = mn; }
    if (__any(alpha < 1.f)) {
      if (hi == 0) al_l[r32] = alpha;
      asm volatile("s_waitcnt lgkmcnt(0)" ::: "memory");
#pragma unroll
      for (int r = 0; r < 16; ++r) { const float a = al_l[crow(r, hi)];
#pragma unroll
        for (int d = 0; d < 4; ++d) o[d][r] *= a; }
    }
    const float mnC = -mn * C;
    float ps = 0.f;
#pragma unroll
    for (int r = 0; r < 16; ++r) { p0[r] = __builtin_amdgcn_exp2f(fmaf(p0[r], C, mnC)); p1[r] = __builtin_amdgcn_exp2f(fmaf(p1[r], C, mnC)); ps += p0[r] + p1[r]; }
    { auto rr = __builtin_amdgcn_permlane32_swap(__float_as_uint(ps), __float_as_uint(ps), false, false);
      ps = __uint_as_float(rr[0]) + __uint_as_float(rr[1]); }
    l_reg = l_reg * alpha + ps;
    bf16x8 pa0, pa1, pa2, pa3;
#define PK4(PP, BASE, OUT) do { unsigned a0 = pk2(PP[BASE + 0], PP[BASE + 1]), a1 = pk2(PP[BASE + 2], PP[BASE + 3]); \
    unsigned b0 = pk2(PP[BASE + 4], PP[BASE + 5]), b1 = pk2(PP[BASE + 6], PP[BASE + 7]); \
    auto r0 = __builtin_amdgcn_permlane32_swap(a0, b0, false, false); auto r1 = __builtin_amdgcn_permlane32_swap(a1, b1, false, false); \
    u32x4 w = {r0[0], r1[0], r0[1], r1[1]}; OUT = __builtin_bit_cast(bf16x8, w); } while (0)
    PK4(p0, 0, pa0); PK4(p0, 8, pa1); PK4(p1, 0, pa2); PK4(p1, 8, pa3);
#undef PK4
    const int vb = vb0 + bcur * SHM_V;
    pv_all(o, vb, pa0, pa1, pa2, pa3);
    if (j + 2 < NT) { KWRITE(bnext2); VWRITE(bnext2); }
    bcur = (bcur == 2) ? 0 : bcur + 1; bnext2 = (bnext2 == 2) ? 0 : bnext2 + 1;
    __syncthreads();
  }
#undef KLOAD
#undef VLOAD
#undef KWRITE
#undef VWRITE
  if (hi == 0) li_l[r32] = l_reg;
  asm volatile("s_waitcnt lgkmcnt(0)" ::: "memory");
#pragma unroll
  for (int r = 0; r < 16; ++r) {
    const int orow = q0 + wid * 32 + crow(r, hi);
    const float rl = 1.f / li_l[crow(r, hi)];
    if (orow < TP) {
#pragma unroll
      for (int d0 = 0; d0 < 4; ++d0) {
        const long off = (long)orow * 2048 + d0 * 32 + r32;
        Yb[off] = f2bf(o[d0][r] * rl * silu(bf2f(Zb[off])));
      }
    }
  }
}

DI void phase_attn(const Params& p, char* lds) {
  const u16* QM = (const u16*)(p.ws + OFF_QM); const u16* KM = (const u16*)(p.ws + OFF_KM); const u16* VM = (const u16*)(p.ws + OFF_VM);
  u16* Y = (u16*)(p.ws + OFF_Y); const u16* Z = (const u16*)(p.ws + OFF_Z);
  const int b = blockIdx.x, x = b & 7, lb = b >> 3;
  if (gridDim.x == 256) {
    for (int it = 0; it < 5; ++it) {
      int pair, qb;
      if (it < 4) { pair = x + 8 * (2 * it + (lb >> 4)); qb = lb & 15; }
      else { if (b >= 64) break; pair = b; qb = 16; }
      const int seq = pair >> 4, head = pair & 15;
      attn_item(QM + (long)pair * TP * 192, KM + (long)pair * TP * 192, VM + (long)pair * TP * 128, qb * 256,
                Y + (long)seq * TP * 2048 + head * 128, Z + (long)seq * TP * 2048 + head * 128, lds);
    }
  } else {
    for (int item = b; item < 64 * 17; item += gridDim.x) {
      const int pair = item / 17, qb = item % 17; const int seq = pair >> 4, head = pair & 15;
      attn_item(QM + (long)pair * TP * 192, KM + (long)pair * TP * 192, VM + (long)pair * TP * 128, qb * 256,
                Y + (long)seq * TP * 2048 + head * 128, Z + (long)seq * TP * 2048 + head * 128, lds);
    }
  }
}


#define XB_TMO      128
#define XB_XCNT(j)  (256  + 64 * (j))
#define XB_XSUB(j)  (1280 + 64 * (j))
#define XB_XGEN(j)  (2304 + 64 * (j))
#define XB_TOP      3328
#define XB_TOPGEN   3392
#define XCD_BAR_WORDS 3456
#define XB_SPIN_CAP (1u << 18)
#define LAS __attribute__((address_space(3)))
DI unsigned xb_ld(unsigned* p)              { return __hip_atomic_load(p, __ATOMIC_RELAXED, __HIP_MEMORY_SCOPE_AGENT); }
DI unsigned xb_add(unsigned* p, unsigned v) { return __hip_atomic_fetch_add(p, v, __ATOMIC_RELAXED, __HIP_MEMORY_SCOPE_AGENT); }
DI unsigned xb_xcc_id() { return (unsigned)__builtin_amdgcn_s_getreg((3 << 11) | 20) & 0xFu; }
#define XB_SPIN(cond, bar) do { unsigned _sp = 0; while (cond) { __builtin_amdgcn_s_sleep(1); \
    if ((++_sp & 255u) == 0u) { if (xb_ld(&(bar)[XB_TMO])) break; if (_sp > XB_SPIN_CAP) { atomicAdd(&(bar)[XB_TMO], 1u); break; } } } } while (0)
struct XcdBarrier { unsigned* bar; unsigned x; volatile LAS unsigned* st; };
DI XcdBarrier xcd_barrier_post(unsigned* bar, volatile LAS unsigned* st) {
  XcdBarrier b; b.bar = bar; b.x = xb_xcc_id(); b.st = st;
  if (__builtin_amdgcn_workitem_id_x() == 0) (void)xb_add(&bar[XB_XCNT(b.x)], 1u);
  return b;
}
DI void xcd_barrier_complete(unsigned* bar, unsigned x, unsigned& nloc, unsigned& nx) {
  const unsigned G = gridDim.x * gridDim.y * gridDim.z;
  unsigned sum, cnt, mine, sp = 0u;
  for (;;) {
    sum = 0u; cnt = 0u; mine = 0u;
#pragma unroll
    for (unsigned j = 0; j < 16; ++j) { const unsigned c = xb_ld(&bar[XB_XCNT(j)]); sum += c; cnt += (c > 0u) ? 1u : 0u; mine = (j == x) ? c : mine; }
    if (sum == G) break;
    __builtin_amdgcn_s_sleep(1);
    if ((++sp & 255u) == 0u) { if (xb_ld(&bar[XB_TMO])) break; if (sp > XB_SPIN_CAP) { atomicAdd(&bar[XB_TMO], 1u); break; } }
  }
  nloc = mine > 0u ? mine : 1u; nx = cnt > 0u ? cnt : 1u;
}
DI void xcd_barrier(const XcdBarrier& b) {
  asm volatile("s_waitcnt vmcnt(0)" ::: "memory");
  __syncthreads();
  if (__builtin_amdgcn_workitem_id_x() == 0) {
    unsigned* bar = b.bar;
    __builtin_amdgcn_s_waitcnt(0);
    unsigned nloc = b.st[0], nx = b.st[1];
    if (nloc == 0u) { xcd_barrier_complete(bar, b.x, nloc, nx); b.st[0] = nloc; b.st[1] = nx; }
    const unsigned old = xb_add(&bar[XB_XSUB(b.x)], 1u);
    const unsigned gen = old / nloc;
    if (old + 1u == (gen + 1u) * nloc) {
      __builtin_amdgcn_fence(__ATOMIC_RELEASE, "agent");
      asm volatile("s_waitcnt vmcnt(0)" ::: "memory");
      const unsigned og = xb_add(&bar[XB_TOP], 1u);
      const unsigned tg = og / nx;
      if (og + 1u == (tg + 1u) * nx) xb_add(&bar[XB_TOPGEN], 1u);
      else XB_SPIN(xb_ld(&bar[XB_TOPGEN]) == tg, bar);
      __builtin_amdgcn_fence(__ATOMIC_ACQUIRE, "agent");
      xb_add(&bar[XB_XGEN(b.x)], 1u);
      asm volatile("s_waitcnt vmcnt(0)" ::: "memory");
    } else {
      XB_SPIN(xb_ld(&bar[XB_XGEN(b.x)]) == gen, bar);
      __builtin_amdgcn_fence(__ATOMIC_ACQUIRE, "agent");
      asm volatile("s_waitcnt vmcnt(0)" ::: "memory");
    }
  }
  __syncthreads();
}

__global__ void __launch_bounds__(512) fwd_mega(Params p) {
  extern __shared__ __attribute__((aligned(16))) char lds[];
  cg::grid_group grid = cg::this_grid();
  char* ws = p.ws;
  unsigned* barw = (unsigned*)(ws + OFF_BAR);
  if (blockIdx.x == 0) for (int i = otid(); i < XCD_BAR_WORDS; i += 512) barw[i] = 0u;
  volatile LAS unsigned* xst = (volatile LAS unsigned*)(lds + LDS_BYTES - 16);
  if (otid() == 0) { xst[0] = 0u; xst[1] = 0u; }
  grid.sync();
  const XcdBarrier xb = xcd_barrier_post(barw, xst);
  phase_prep(p, lds);
  for (int g = 0; g < NGRP; ++g) {
    phase_hn(p, g, 0);
    xcd_barrier(xb);
    { EpiGin e{(u16*)(ws + OFF_P), (u16*)(ws + OFF_HALO), (u16*)(ws + OFF_Z), (float*)(ws + OFF_BA)};
      for (int rep = 0; rep < REP_GEMM; ++rep) gemm_phase<4, 2, 2, 2>((const u16*)(ws + OFF_HN), 1024, (const u16*)(ws + OFF_WGIN), 1024, 1024, GINP, lds, e); }
    xcd_barrier(xb);
    phase_chunk(p, lds);
    xcd_barrier(xb);
    for (int rep = 0; rep < REP_SCAN; ++rep) phase_scan(p, lds);
    xcd_barrier(xb);
    phase_gate(p);
    xcd_barrier(xb);
    { EpiGout e{p, g, (float*)(ws + OFF_H1M)};
      for (int rep = 0; rep < REP_GEMM; ++rep) gemm_phase<4, 2, 2, 2>((const u16*)(ws + OFF_OF), 2048, (const u16*)(ws + OFF_WGOUT), 2048, 2048, 1024, lds, e); }
    xcd_barrier(xb);
    phase_hn(p, g, 1);
    xcd_barrier(xb);
    { EpiMin e{(u16*)(ws + OFF_CQ), (u16*)(ws + OFF_CKV), (u16*)(ws + OFF_Z), (float*)(ws + OFF_KPE)};
      for (int rep = 0; rep < REP_GEMM; ++rep) gemm_phase<4, 2, 2, 2>((const u16*)(ws + OFF_HN), 1024, (const u16*)(ws + OFF_WMIN), 1024, 1024, MINP, lds, e); }
    xcd_barrier(xb);
    phase_rowstats(p);
    xcd_barrier(xb);
    { EpiQ e{(const float*)(ws + OFF_ROWST), p.m_qg, (const float*)(ws + OFF_ROPE), (u16*)(ws + OFF_QM)};
      for (int rep = 0; rep < REP_GEMM; ++rep) gemm_phase<8, 1, 1, 6>((const u16*)(ws + OFF_CQ), 512, (const u16*)(ws + OFF_WUQ), 512, 512, 3072, lds, e); }
    { EpiKV e{(const float*)(ws + OFF_ROWST), p.m_kg, (const float*)(ws + OFF_KPER), (u16*)(ws + OFF_KM), (u16*)(ws + OFF_VM)};
      for (int rep = 0; rep < REP_GEMM; ++rep) gemm_phase<8, 1, 1, 4>((const u16*)(ws + OFF_CKV), 256, (const u16*)(ws + OFF_WUKV), 256, 256, 4096, lds, e); }
    xcd_barrier(xb);
    for (int rep = 0; rep < REP_ATTN; ++rep) phase_attn(p, lds);
    xcd_barrier(xb);
    { EpiMout e{p.out, g};
      gemm_phase<4, 2, 2, 2>((const u16*)(ws + OFF_Y), 2048, (const u16*)(ws + OFF_WMOUT), 2048, 2048, 1024, lds, e); }
    xcd_barrier(xb);
  }
}

extern "C" void kernel_launch(void* const* d_in, const int* in_sizes, int n_in,
                              void* d_out, int out_size, void* d_ws, size_t ws_size,
                              hipStream_t stream) {
  static int grid_blocks = 0;
  if (!grid_blocks) {
    int dev = 0, cus = 0, per_cu = 0;
    (void)hipGetDevice(&dev);
    (void)hipDeviceGetAttribute(&cus, hipDeviceAttributeMultiprocessorCount, dev);
    (void)hipFuncSetAttribute((const void*)fwd_mega, hipFuncAttributeMaxDynamicSharedMemorySize, LDS_BYTES);
    (void)hipOccupancyMaxActiveBlocksPerMultiprocessor(&per_cu, fwd_mega, 512, LDS_BYTES);
    if (per_cu < 1) { fprintf(stderr, "occupancy query returned %d\n", per_cu); per_cu = 1; }
    if (per_cu > 1) per_cu = 1;
    grid_blocks = cus * per_cu;
  }
  if (ws_size < WS_NEED) { fprintf(stderr, "workspace too small: %zu < %zu\n", ws_size, (size_t)WS_NEED); return; }
  Params p{};
  p.xp = (const float*)d_in[0]; p.xs = (const float*)d_in[1]; p.meta = (const float*)d_in[2]; p.ln_g = (const float*)d_in[3];
  p.g_win = (const float*)d_in[4]; p.g_conv = (const float*)d_in[5]; p.g_alog = (const float*)d_in[6]; p.g_dtb = (const float*)d_in[7];
  p.g_onorm = (const float*)d_in[8]; p.g_wout = (const float*)d_in[9]; p.m_win = (const float*)d_in[10]; p.m_qn = (const float*)d_in[11];
  p.m_kvn = (const float*)d_in[12]; p.m_wuq = (const float*)d_in[13]; p.m_wukv = (const float*)d_in[14]; p.m_qg = (const float*)d_in[15];
  p.m_kg = (const float*)d_in[16]; p.m_wout = (const float*)d_in[17]; p.out = (float*)d_out; p.ws = (char*)d_ws;
  void* args[] = {&p};
  hipError_t e = hipLaunchCooperativeKernel((void*)fwd_mega, dim3(grid_blocks), dim3(512), args, LDS_BYTES, stream);
  if (e != hipSuccess) fprintf(stderr, "cooperative launch failed: %s (grid %d)\n", hipGetErrorString(e), grid_blocks);
}
```

```cpp
#include <hip/hip_runtime.h>
#include <hip/hip_cooperative_groups.h>
#include <cstdio>
#include <cstdint>
namespace cg = cooperative_groups;

typedef unsigned short u16;
typedef __bf16 bf2_t __attribute__((ext_vector_type(2)));
typedef float f2_t __attribute__((ext_vector_type(2)));
using bf16x8 = __attribute__((ext_vector_type(8))) short;
using s16x4  = __attribute__((ext_vector_type(4))) short;
using f32x16 = __attribute__((ext_vector_type(16))) float;
using f32x4  = __attribute__((ext_vector_type(4))) float;
using u32x4  = __attribute__((ext_vector_type(4))) unsigned;
using u32x2  = __attribute__((ext_vector_type(2))) unsigned;
#define DI __device__ __forceinline__
#define SBAR() __builtin_amdgcn_sched_barrier(0)

DI unsigned pk2(float a, float b) { f2_t v = {a, b}; bf2_t r = __builtin_convertvector(v, bf2_t); return __builtin_bit_cast(unsigned, r); }
DI u16 f2bf(float a) { return (u16)(pk2(a, 0.f) & 0xffffu); }
DI float bf2f(u16 v) { return __uint_as_float(((unsigned)v) << 16); }
DI float bflo(unsigned v) { return __uint_as_float(v << 16); }
DI float bfhi(unsigned v) { return __uint_as_float(v & 0xffff0000u); }
DI int otid() { int t = __builtin_amdgcn_workitem_id_x(); asm volatile("" : "+v"(t)); return t; }
DI int crow(int r, int hi) { return (r & 3) + 8 * (r >> 2) + 4 * hi; }
#define DPP_ADD(v, ctrl, rm) ((v) + __builtin_bit_cast(float, __builtin_amdgcn_update_dpp(0, __builtin_bit_cast(int, (v)), (ctrl), (rm), 0xF, false)))
DI float wave_sum(float v) {
  v = DPP_ADD(v, 0xB1, 0xF);
  v = DPP_ADD(v, 0x4E, 0xF);
  v = DPP_ADD(v, 0x141, 0xF);
  v = DPP_ADD(v, 0x140, 0xF);
  v = DPP_ADD(v, 0x142, 0xA);
  v = DPP_ADD(v, 0x143, 0xC);
  return __builtin_bit_cast(float, __builtin_amdgcn_readlane(__builtin_bit_cast(int, v), 63));
}
DI float silu(float x) { return x * __builtin_amdgcn_rcpf(1.f + __expf(-x)); }

constexpr int D = 1024, TP = 4160, GS = 4, GR = GS * TP, NGRP = 3, PADR = 48, SEQ = 4096;
constexpr int GIN = 6176, GINP = 6400, MIN_ = 2880, MINP = 3072;
constexpr float EPS = 1e-6f;
constexpr int NCHUNK = 65;

constexpr size_t al256(size_t x) { return (x + 255) / 256 * 256; }
constexpr size_t OFF_WGIN  = 0;
constexpr size_t OFF_WGOUT = OFF_WGIN  + al256((size_t)GINP * 1024 * 2);
constexpr size_t OFF_WMIN  = OFF_WGOUT + al256((size_t)1024 * 2048 * 2);
constexpr size_t OFF_WUQ   = OFF_WMIN  + al256((size_t)MINP * 1024 * 2);
constexpr size_t OFF_WUKV  = OFF_WUQ   + al256((size_t)3072 * 512 * 2);
constexpr size_t OFF_WMOUT = OFF_WUKV  + al256((size_t)4096 * 256 * 2);
constexpr size_t OFF_ROPE  = OFF_WMOUT + al256((size_t)1024 * 2048 * 2);
constexpr size_t OFF_H1M   = OFF_ROPE  + al256((size_t)4112 * 64 * 4);
constexpr size_t OFF_HN    = OFF_H1M   + al256((size_t)12 * 16 * 1024 * 4);
constexpr size_t OFF_Z     = OFF_HN    + al256((size_t)GR * 1024 * 2);
constexpr size_t OFF_R     = OFF_Z     + al256((size_t)GR * 2048 * 2);
constexpr size_t OFF_P     = OFF_R;
constexpr size_t OFF_HALO  = OFF_P     + al256((size_t)GR * 4096 * 2);
constexpr size_t OFF_BA    = OFF_HALO  + al256((size_t)(GR / 64) * 4 * 4096 * 2);
constexpr size_t OFF_SC    = OFF_BA    + al256((size_t)GR * 32 * 4);
constexpr size_t OFF_TQ    = OFF_SC    + al256((size_t)GS * 8 * 2 * TP * 16);
constexpr size_t OFF_KT    = OFF_TQ    + al256((size_t)GS * 8 * 2 * NCHUNK * 16384);
constexpr size_t OFF_OF    = OFF_KT    + al256((size_t)GS * 8 * NCHUNK * 16384);
constexpr size_t OFF_OB    = OFF_OF    + al256((size_t)GR * 2048 * 2);
constexpr size_t END_GDN   = OFF_OB    + al256((size_t)GR * 2048 * 2);
constexpr size_t OFF_CQ    = OFF_R;
constexpr size_t OFF_CKV   = OFF_CQ    + al256((size_t)GR * 512 * 2);
constexpr size_t OFF_KPE   = OFF_CKV   + al256((size_t)GR * 256 * 2);
constexpr size_t OFF_ROWST = OFF_KPE   + al256((size_t)GR * 64 * 4);
constexpr size_t OFF_KPER  = OFF_ROWST + al256((size_t)GR * 4 * 4);
constexpr size_t OFF_QM    = OFF_KPER  + al256((size_t)GR * 64 * 4);
constexpr size_t OFF_KM    = OFF_QM    + al256((size_t)GR * 16 * 192 * 2);
constexpr size_t OFF_VM    = OFF_KM    + al256((size_t)GR * 16 * 192 * 2);
constexpr size_t OFF_Y     = OFF_VM    + al256((size_t)GR * 16 * 128 * 2);
constexpr size_t END_MLA   = OFF_Y     + al256((size_t)GR * 2048 * 2);
constexpr size_t OFF_BAR   = END_MLA > END_GDN ? END_MLA : END_GDN;
constexpr size_t WS_NEED   = OFF_BAR + 16384;

constexpr int LDS_BYTES = 160 * 1024;
#ifndef REP_ATTN
#define REP_ATTN 1
#endif
#ifndef REP_SCAN
#define REP_SCAN 1
#endif
#ifndef REP_GEMM
#define REP_GEMM 1
#endif

struct Params {
  const float *xp, *xs, *meta, *ln_g, *g_win, *g_conv, *g_alog, *g_dtb, *g_onorm, *g_wout;
  const float *m_win, *m_qn, *m_kvn, *m_wuq, *m_wukv, *m_qg, *m_kg, *m_wout;
  float* out; char* ws;
};

DI const float* h0_row(const Params& p, int sg, int pos) {
  return pos < 16 ? p.meta + (long)pos * D
                  : (sg < 4 ? p.xp + ((long)sg * SEQ + pos - 16) * D : p.xs + ((long)(sg - 4) * SEQ + pos - 16) * D);
}

#define LASP __attribute__((address_space(3)))
DI int vbid(const char* lds) { return __builtin_amdgcn_readfirstlane((int)*(const volatile LASP unsigned*)(lds + LDS_BYTES - 4)); }

DI void transpose_cvt(const float* __restrict__ src, u16* __restrict__ dst, int K, int N, int Npad,
                      const float* __restrict__ gain, int gmod, float* lds) {
  const int tid = otid();
  const int tK = K / 64, tN = Npad / 64;
  for (int tile = blockIdx.x; tile < tK * tN; tile += gridDim.x) {
    const int tk = tile % tK, tn = tile / tK;
#pragma unroll
    for (int i = 0; i < 2; ++i) {
      int kk = (tid >> 4) + 32 * i, nn = (tid & 15) * 4;
      int k = tk * 64 + kk, n = tn * 64 + nn;
      float4 v = make_float4(0.f, 0.f, 0.f, 0.f);
      if (n < N) v = *(const float4*)(src + (long)k * N + n);
      float gsc = gain ? gain[k % gmod] : 1.f;
      lds[kk * 65 + nn + 0] = v.x * gsc; lds[kk * 65 + nn + 1] = v.y * gsc;
      lds[kk * 65 + nn + 2] = v.z * gsc; lds[kk * 65 + nn + 3] = v.w * gsc;
    }
    __syncthreads();
    {
      int n = tid >> 3, k8 = (tid & 7) * 8;
      float f[8];
#pragma unroll
      for (int j = 0; j < 8; ++j) f[j] = lds[(k8 + j) * 65 + n];
      u32x4 w = {pk2(f[0], f[1]), pk2(f[2], f[3]), pk2(f[4], f[5]), pk2(f[6], f[7])};
      *(u32x4*)(dst + (long)(tn * 64 + n) * K + tk * 64 + k8) = w;
    }
    __syncthreads();
  }
}

DI void phase_prep(const Params& p, char* lds) {
  float* l = (float*)lds;
  transpose_cvt(p.g_win, (u16*)(p.ws + OFF_WGIN), 1024, GIN, GINP, p.ln_g, 1024, l);
  transpose_cvt(p.g_wout, (u16*)(p.ws + OFF_WGOUT), 2048, 1024, 1024, p.g_onorm, 256, l);
  transpose_cvt(p.m_win, (u16*)(p.ws + OFF_WMIN), 1024, MIN_, MINP, p.ln_g + 1024, 1024, l);
  transpose_cvt(p.m_wuq, (u16*)(p.ws + OFF_WUQ), 512, 3072, 3072, p.m_qn, 512, l);
  transpose_cvt(p.m_wukv, (u16*)(p.ws + OFF_WUKV), 256, 4096, 4096, p.m_kvn, 256, l);
  transpose_cvt(p.m_wout, (u16*)(p.ws + OFF_WMOUT), 2048, 1024, 1024, nullptr, 1, l);
  float* rope = (float*)(p.ws + OFF_ROPE);
  for (int i = blockIdx.x * 512 + otid(); i < 4112 * 32; i += gridDim.x * 512) {
    int pos = i >> 5, j = i & 31;
    float inv = __builtin_amdgcn_exp2f(-(float)j * (13.287712379549449f / 32.f));
    float ang = (float)pos * inv;
    float n = rintf(ang * 0.15915494309189535f);
    float rr = fmaf(-n, 6.28318548202514648f, ang); rr = fmaf(-n, -1.7484555e-7f, rr);
    float s = __sinf(rr), c = __cosf(rr);
    rope[pos * 64 + j] = c; rope[pos * 64 + 32 + j] = s;
  }
}

DI void phase_hn(const Params& p, int g, int layer) {
  const int lane = otid() & 63, wv = otid() >> 6;
  u16* HN = (u16*)(p.ws + OFF_HN);
  const float* h1m = (const float*)(p.ws + OFF_H1M);
  for (int row = blockIdx.x * 8 + wv; row < GR; row += gridDim.x * 8) {
    int seq = row / TP, r = row % TP, pos = r - PADR, sg = g * GS + seq;
    u16* dst = HN + (long)row * D;
    if (pos < 0) {
      u32x2 z = {0u, 0u};
#pragma unroll
      for (int i = 0; i < 4; ++i) *(u32x2*)(dst + i * 256 + lane * 4) = z;
      continue;
    }
    const float* src;
    if (layer == 0) src = h0_row(p, sg, pos);
    else src = pos < 16 ? h1m + ((long)sg * 16 + pos) * D : p.out + ((long)sg * SEQ + pos - 16) * D;
    float4 v[4]; float ss = 0.f;
#pragma unroll
    for (int i = 0; i < 4; ++i) { v[i] = *(const float4*)(src + i * 256 + lane * 4); ss += v[i].x * v[i].x + v[i].y * v[i].y + v[i].z * v[i].z + v[i].w * v[i].w; }
    ss = wave_sum(ss);
    float rs = rsqrtf(ss * (1.f / 1024.f) + EPS);
#pragma unroll
    for (int i = 0; i < 4; ++i) { u32x2 w = {pk2(v[i].x * rs, v[i].y * rs), pk2(v[i].z * rs, v[i].w * rs)}; *(u32x2*)(dst + i * 256 + lane * 4) = w; }
  }
}

template <int WM, int WN, int MT, int NT, class Epi>
DI void gemm_tile(const u16* __restrict__ A, int lda, const u16* __restrict__ Bt, int ldb, int K, int m0, int n0, char* lds, const Epi& epi) {
  constexpr int BM = WM * MT * 32, BN = WN * NT * 32, NA = BM * 8 / 512, NB = BN * 8 / 512;
  static_assert(WM * WN == 8, "8 waves");
  const int tid = otid(), lane = tid & 63, wid = tid >> 6, r32 = lane & 31, hi = lane >> 5;
  const int wm = wid / WN, wn = wid % WN;
  char* As = lds; char* Bs = lds + 2 * BM * 128;
  f32x16 acc[MT][NT];
#pragma unroll
  for (int a = 0; a < MT; ++a)
#pragma unroll
    for (int b = 0; b < NT; ++b)
#pragma unroll
      for (int r = 0; r < 16; ++r) acc[a][b][r] = 0.f;
  u32x4 ra[NA], rb[NB];
  const int nk = K / 64;
#define GLOAD(kt) do { _Pragma("unroll") for (int i = 0; i < NA; ++i) { int q = tid + 512 * i; int row = q >> 3, c = q & 7; \
      ra[i] = *(const u32x4*)(A + (long)(m0 + row) * lda + (kt) * 64 + c * 8); } \
    _Pragma("unroll") for (int i = 0; i < NB; ++i) { int q = tid + 512 * i; int row = q >> 3, c = q & 7; \
      rb[i] = *(const u32x4*)(Bt + (long)(n0 + row) * ldb + (kt) * 64 + c * 8); } } while (0)
#define SWRITE(buf) do { _Pragma("unroll") for (int i = 0; i < NA; ++i) { int q = tid + 512 * i; int row = q >> 3, c = q & 7; \
      *(u32x4*)(As + (buf) * BM * 128 + row * 128 + ((c ^ (row & 7)) << 4)) = ra[i]; } \
    _Pragma("unroll") for (int i = 0; i < NB; ++i) { int q = tid + 512 * i; int row = q >> 3, c = q & 7; \
      *(u32x4*)(Bs + (buf) * BN * 128 + row * 128 + ((c ^ (row & 7)) << 4)) = rb[i]; } } while (0)
  GLOAD(0); SWRITE(0); if (nk > 1) GLOAD(1);
  __syncthreads();
  for (int kt = 0; kt < nk; ++kt) {
    const int cur = kt & 1;
#pragma unroll
    for (int ks = 0; ks < 4; ++ks) {
      bf16x8 af[MT], bfr[NT];
      const int c = ks * 2 + hi;
#pragma unroll
      for (int a = 0; a < MT; ++a) { int row = (wm * MT + a) * 32 + r32; af[a] = *(const bf16x8*)(As + cur * BM * 128 + row * 128 + ((c ^ (row & 7)) << 4)); }
#pragma unroll
      for (int b = 0; b < NT; ++b) { int row = (wn * NT + b) * 32 + r32; bfr[b] = *(const bf16x8*)(Bs + cur * BN * 128 + row * 128 + ((c ^ (row & 7)) << 4)); }
#pragma unroll
      for (int a = 0; a < MT; ++a)
#pragma unroll
        for (int b = 0; b < NT; ++b) acc[a][b] = __builtin_amdgcn_mfma_f32_32x32x16_bf16(af[a], bfr[b], acc[a][b], 0, 0, 0);
    }
    if (kt + 1 < nk) { SWRITE(cur ^ 1); if (kt + 2 < nk) GLOAD(kt + 2); }
    __syncthreads();
  }
#undef GLOAD
#undef SWRITE
  epi(acc, m0 + wm * MT * 32, n0 + wn * NT * 32, lane);
}

template <int NT> struct EpiGin { u16 *P, *HALO, *Z; float* BA;
  DI void operator()(f32x16 (&acc)[2][NT], int m0, int n0, int lane) const {
    const int r32 = lane & 31, hi = lane >> 5;
#pragma unroll
    for (int a = 0; a < 2; ++a)
#pragma unroll
      for (int b = 0; b < NT; ++b) {
        const int col = n0 + b * 32 + r32;
#pragma unroll
        for (int r = 0; r < 16; ++r) {
          const int row = m0 + a * 32 + crow(r, hi); const float v = acc[a][b][r];
          if (col < 4096) { u16 bv = f2bf(v); P[(long)row * 4096 + col] = bv; int rm = row & 63;
            if (rm < 2 || rm >= 62) HALO[((long)(row >> 6) * 4 + (rm < 2 ? rm : rm - 60)) * 4096 + col] = bv; }
          else if (col < 6144) Z[(long)row * 2048 + col - 4096] = f2bf(v);
          else if (col < GIN) BA[(long)row * 32 + col - 6144] = v;
        }
      }
  } };

struct EpiGout { Params p; int g; float* h1m;
  DI void operator()(f32x16 (&acc)[2][2], int m0, int n0, int lane) const {
    const int r32 = lane & 31, hi = lane >> 5;
#pragma unroll
    for (int a = 0; a < 2; ++a)
#pragma unroll
      for (int r = 0; r < 16; ++r) {
        const int row = m0 + a * 32 + crow(r, hi);
        const int seq = row / TP, rr = row % TP, pos = rr - PADR, sg = g * GS + seq;
        if (pos < 0) continue;
        const float* h0 = h0_row(p, sg, pos);
        float* dst = pos < 16 ? h1m + ((long)sg * 16 + pos) * D : p.out + ((long)sg * SEQ + pos - 16) * D;
#pragma unroll
        for (int b = 0; b < 2; ++b) { const int col = n0 + b * 32 + r32; dst[col] = h0[col] + acc[a][b][r]; }
      }
  } };

struct EpiMin { u16 *CQ, *CKV, *Z; float* KPE;
  DI void operator()(f32x16 (&acc)[2][2], int m0, int n0, int lane) const {
    const int r32 = lane & 31, hi = lane >> 5;
#pragma unroll
    for (int a = 0; a < 2; ++a)
#pragma unroll
      for (int b = 0; b < 2; ++b) {
        const int col = n0 + b * 32 + r32;
#pragma unroll
        for (int r = 0; r < 16; ++r) {
          const int row = m0 + a * 32 + crow(r, hi); const float v = acc[a][b][r];
          if (col < 512) CQ[(long)row * 512 + col] = f2bf(v);
          else if (col < 768) CKV[(long)row * 256 + col - 512] = f2bf(v);
          else if (col < 832) KPE[(long)row * 64 + col - 768] = v;
          else if (col < MIN_) Z[(long)row * 2048 + col - 832] = f2bf(v);
        }
      }
  } };

struct EpiQ { const float *rowst, *gq, *rope; u16* Q;
  DI void operator()(f32x16 (&acc)[1][6], int m0, int n0, int lane) const {
    const int r32 = lane & 31, hi = lane >> 5, head = n0 / 192;
    float ss[16];
#pragma unroll
    for (int r = 0; r < 16; ++r) {
      const int row = m0 + crow(r, hi); const float rq = rowst[row * 4 + 0]; float s = 0.f;
#pragma unroll
      for (int b = 0; b < 6; ++b) { acc[0][b][r] *= rq; s += acc[0][b][r] * acc[0][b][r]; }
      ss[r] = s;
    }
#pragma unroll
    for (int r = 0; r < 16; ++r) {
      float v = ss[r];
      v = DPP_ADD(v, 0xB1, 0xF); v = DPP_ADD(v, 0x4E, 0xF); v = DPP_ADD(v, 0x141, 0xF); v = DPP_ADD(v, 0x140, 0xF);
      ss[r] = v + __shfl_xor(v, 16, 64);
    }
    float gc[6];
#pragma unroll
    for (int b = 0; b < 6; ++b) gc[b] = gq[b * 32 + r32];
#pragma unroll
    for (int r = 0; r < 16; ++r) {
      const int row = m0 + crow(r, hi); const int seq = row / TP, rr = row % TP; int pos = rr - PADR; pos = pos < 0 ? 0 : pos;
      const float rs = rsqrtf(ss[r] * (1.f / 192.f) + EPS);
      const float c = rope[pos * 64 + r32], s = rope[pos * 64 + 32 + r32];
      float x[6];
#pragma unroll
      for (int b = 0; b < 6; ++b) x[b] = acc[0][b][r] * rs * gc[b];
      const float x1 = x[4] * c - x[5] * s, x2 = x[5] * c + x[4] * s; x[4] = x1; x[5] = x2;
      u16* dst = Q + ((long)(seq * 16 + head) * TP + rr) * 192;
#pragma unroll
      for (int b = 0; b < 6; ++b) dst[b * 32 + r32] = f2bf(x[b]);
    }
  } };

struct EpiKV { const float *rowst, *gk, *kper; u16 *Kd, *Vd;
  DI void operator()(f32x16 (&acc)[1][4], int m0, int n0, int lane) const {
    const int r32 = lane & 31, hi = lane >> 5, head = n0 >> 8, isv = (n0 >> 7) & 1;
    if (isv) {
#pragma unroll
      for (int r = 0; r < 16; ++r) {
        const int row = m0 + crow(r, hi); const int seq = row / TP, rr = row % TP; const float rk = rowst[row * 4 + 1];
        u16* vd = Vd + ((long)(seq * 16 + head) * TP + rr) * 128;
#pragma unroll
        for (int b = 0; b < 4; ++b) vd[b * 32 + r32] = f2bf(acc[0][b][r] * rk);
      }
      return;
    }
    float ss[16];
#pragma unroll
    for (int r = 0; r < 16; ++r) {
      const int row = m0 + crow(r, hi); const float rk = rowst[row * 4 + 1]; float s = 0.f;
#pragma unroll
      for (int b = 0; b < 4; ++b) { acc[0][b][r] *= rk; s += acc[0][b][r] * acc[0][b][r]; }
      ss[r] = s;
    }
#pragma unroll
    for (int r = 0; r < 16; ++r) {
      float v = ss[r];
      v = DPP_ADD(v, 0xB1, 0xF); v = DPP_ADD(v, 0x4E, 0xF); v = DPP_ADD(v, 0x141, 0xF); v = DPP_ADD(v, 0x140, 0xF);
      ss[r] = v + __shfl_xor(v, 16, 64);
    }
    float gc[4];
#pragma unroll
    for (int b = 0; b < 4; ++b) gc[b] = gk[b * 32 + r32];
#pragma unroll
    for (int r = 0; r < 16; ++r) {
      const int row = m0 + crow(r, hi); const int seq = row / TP, rr = row % TP;
      const float rs = rsqrtf((ss[r] + rowst[row * 4 + 2]) * (1.f / 192.f) + EPS);
      u16* kd = Kd + ((long)(seq * 16 + head) * TP + rr) * 192;
#pragma unroll
      for (int b = 0; b < 4; ++b) kd[b * 32 + r32] = f2bf(acc[0][b][r] * rs * gc[b]);
      kd[128 + r32] = f2bf(kper[(long)row * 64 + r32] * rs);
      kd[160 + r32] = f2bf(kper[(long)row * 64 + 32 + r32] * rs);
    }
  } };

struct EpiMout { float* out; int g;
  DI void operator()(f32x16 (&acc)[2][2], int m0, int n0, int lane) const {
    const int r32 = lane & 31, hi = lane >> 5;
#pragma unroll
    for (int a = 0; a < 2; ++a)
#pragma unroll
      for (int r = 0; r < 16; ++r) {
        const int row = m0 + a * 32 + crow(r, hi);
        const int seq = row / TP, rr = row % TP, pos = rr - PADR, sg = g * GS + seq;
        if (pos < 16) continue;
        float* dst = out + ((long)sg * SEQ + pos - 16) * D;
#pragma unroll
        for (int b = 0; b < 2; ++b) { const int col = n0 + b * 32 + r32; dst[col] += acc[a][b][r]; }
      }
  } };

template <int WM, int WN, int MT, int NT, class Epi>
DI void gemm_phase(const u16* A, int lda, const u16* Bt, int ldb, int K, int Npad, char* lds, const Epi& epi) {
  constexpr int BM = WM * MT * 32, BN = WN * NT * 32;
  constexpr int nM = GR / BM;
  const int nN = Npad / BN, total = nM * nN;
  if (gridDim.x == 256 && nM == 65) {
    const int vb = vbid(lds), x = vb >> 5, lb = vb & 31, full = 64 * nN;
    for (int i = 0;; ++i) {
      const int L = (i * 8 + x) * 32 + lb;
      if (L >= total) break;
      int tm, tn;
      if (L < full) { const int panel = L / (4 * nN), w = L % (4 * nN); tn = w >> 2; tm = panel * 4 + (w & 3); }
      else { tm = 64; tn = L - full; }
      gemm_tile<WM, WN, MT, NT, Epi>(A, lda, Bt, ldb, K, tm * BM, tn * BN, lds, epi);
    }
  } else {
    for (int t = blockIdx.x; t < total; t += gridDim.x) {
      const int tm = t % nM, tn = t / nM;
      gemm_tile<WM, WN, MT, NT, Epi>(A, lda, Bt, ldb, K, tm * BM, tn * BN, lds, epi);
    }
  }
}

#include <hip/hip_runtime.h>
namespace pg8 {
#define PG8_LAS __attribute__((address_space(3)))
typedef unsigned short bf16_t;
typedef short bf16x8 __attribute__((ext_vector_type(8)));
typedef float f32x4 __attribute__((ext_vector_type(4)));
typedef unsigned u32x4 __attribute__((ext_vector_type(4)));
constexpr int BM = 256, BK = 64, HALF = 128, HTB = HALF * BK * 2  , STAGE_BYTES = 8 * HTB, NXCD = 8, WGM = 8;

__host__ __device__ __forceinline__ int lds_byte(int r, int c) { const int st = (r >> 4) * 2 + (c >> 5), rr = r & 15, cc = c & 31, ob = rr * 64 + cc * 2; return st * 1024 + (ob ^ (((ob >> 9) & 1) << 5)); }
__host__ __device__ __forceinline__ void stage_rc(int b, int& R, int& C) { const int st = b / 1024, sb = b % 1024, swz = sb ^ (((sb >> 9) & 1) << 5); R = (st >> 1) * 16 + swz / 64; C = (st & 1) * 32 + (swz % 64) / 2; }
__host__ __device__ __forceinline__ int perm32(int rho) { const int n = rho >> 4, i = rho & 15; return 8 * (i >> 2) + 4 * n + (i & 3); }

struct Unit { int pm, pn; };
struct Gemm { const bf16_t* A; const bf16_t* Bt; int M, N, K; };

struct StaticOrder {
    int nM, nN, nwg, G, c;
    __host__ __device__ void init(int M, int N, int G_, int c_) { nM = M / BM; nN = N / BM; nwg = nM * nN; G = G_; c = c_; }
    __host__ __device__ bool next(int i, Unit& u) const {
        const long L = (long)i * G + c; if (L >= nwg) return false;
        int wgid = (int)L; { const int q = nwg / NXCD, r = nwg % NXCD, xcd = wgid % NXCD, off = wgid / NXCD; wgid = (xcd < r ? xcd * (q + 1) : r * (q + 1) + (xcd - r) * q) + off; }
        const int nig = WGM * nN, gid = wgid / nig, fm = gid * WGM, gsz = (nM - fm) < WGM ? (nM - fm) : WGM;
        u.pm = fm + ((wgid % nig) % gsz); u.pn = (wgid % nig) / gsz; return true;
    }
    __device__ __forceinline__ void a_ready(const Unit&) const {}
    __device__ __forceinline__ void done(const Unit&) const {}
};

struct EpiGinT { static constexpr bool PERM = true, AFTER_DRAIN = false; u16 *P, *HALO, *Z; float* BA;
  DI void operator()(const f32x4 (&acc)[2][2][4][2], const Unit& u, int wr, int wc, int fr, int fq) const {
#pragma unroll
    for (int ai = 0; ai < 2; ++ai)
#pragma unroll
      for (int m = 0; m < 4; ++m) { const int row = u.pm * 256 + ai * 128 + wr * 64 + m * 16 + fr; const int rm = row & 63;
#pragma unroll
        for (int bj = 0; bj < 2; ++bj) { const int col = u.pn * 256 + bj * 128 + wc * 32 + 8 * fq; const f32x4 v0 = acc[ai][bj][m][0], v1 = acc[ai][bj][m][1];
          if (col < 6144) { ::u32x4 w = {pk2(v0[0], v0[1]), pk2(v0[2], v0[3]), pk2(v1[0], v1[1]), pk2(v1[2], v1[3])};
            if (col < 4096) { *(::u32x4*)(P + (long)row * 4096 + col) = w;
              if (rm < 2 || rm >= 62) *(::u32x4*)(HALO + ((long)(row >> 6) * 4 + (rm < 2 ? rm : rm - 60)) * 4096 + col) = w; }
            else *(::u32x4*)(Z + (long)row * 2048 + col - 4096) = w; }
          else if (col < GIN) { float* d = BA + (long)row * 32 + col - 6144; *(f32x4*)d = v0; *(f32x4*)(d + 4) = v1; } } }
  } };
struct EpiMinT { static constexpr bool PERM = true, AFTER_DRAIN = false; u16 *CQ, *CKV, *Z; float* KPE;
  DI void operator()(const f32x4 (&acc)[2][2][4][2], const Unit& u, int wr, int wc, int fr, int fq) const {
#pragma unroll
    for (int ai = 0; ai < 2; ++ai)
#pragma unroll
      for (int m = 0; m < 4; ++m) { const int row = u.pm * 256 + ai * 128 + wr * 64 + m * 16 + fr;
#pragma unroll
        for (int bj = 0; bj < 2; ++bj) { const int col = u.pn * 256 + bj * 128 + wc * 32 + 8 * fq; const f32x4 v0 = acc[ai][bj][m][0], v1 = acc[ai][bj][m][1];
          ::u32x4 w = {pk2(v0[0], v0[1]), pk2(v0[2], v0[3]), pk2(v1[0], v1[1]), pk2(v1[2], v1[3])};
          if (col < 512) *(::u32x4*)(CQ + (long)row * 512 + col) = w;
          else if (col < 768) *(::u32x4*)(CKV + (long)row * 256 + col - 512) = w;
          else if (col < 832) { float* d = KPE + (long)row * 64 + col - 768; *(f32x4*)d = v0; *(f32x4*)(d + 4) = v1; }
          else if (col < MIN_) *(::u32x4*)(Z + (long)row * 2048 + col - 832) = w; } }
  } };
struct EpiGoutT { static constexpr bool PERM = false, AFTER_DRAIN = false; Params p; int g; float* h1m;
  DI void operator()(const f32x4 (&acc)[2][2][4][2], const Unit& u, int wr, int wc, int fr, int fq) const {
#pragma unroll
    for (int ai = 0; ai < 2; ++ai)
#pragma unroll
      for (int m = 0; m < 4; ++m) { const int row = u.pm * 256 + ai * 128 + wr * 64 + m * 16 + fr;
        const int seq = row / TP, rr = row % TP, pos = rr - PADR, sg = g * GS + seq;
        if (pos < 0) continue;
        const float* h0 = h0_row(p, sg, pos);
        float* dst = pos < 16 ? h1m + ((long)sg * 16 + pos) * D : p.out + ((long)sg * SEQ + pos - 16) * D;
#pragma unroll
        for (int bj = 0; bj < 2; ++bj)
#pragma unroll
          for (int n = 0; n < 2; ++n) { const int col = u.pn * 256 + bj * 128 + wc * 32 + 16 * n + 4 * fq;
            *(f32x4*)(dst + col) = *(const f32x4*)(h0 + col) + acc[ai][bj][m][n]; } }
  } };
struct EpiMoutT { static constexpr bool PERM = false, AFTER_DRAIN = false; float* out; int g;
  DI void operator()(const f32x4 (&acc)[2][2][4][2], const Unit& u, int wr, int wc, int fr, int fq) const {
#pragma unroll
    for (int ai = 0; ai < 2; ++ai)
#pragma unroll
      for (int m = 0; m < 4; ++m) { const int row = u.pm * 256 + ai * 128 + wr * 64 + m * 16 + fr;
        float* dst = out + ((long)(g * GS) * SEQ + row) * D;
#pragma unroll
        for (int bj = 0; bj < 2; ++bj)
#pragma unroll
          for (int n = 0; n < 2; ++n) { const int col = u.pn * 256 + bj * 128 + wc * 32 + 16 * n + 4 * fq;
            *(f32x4*)(dst + col) = *(const f32x4*)(dst + col) + acc[ai][bj][m][n]; } }
  } };

template <class Epi, class Sched, bool STAMP = false>
__device__ __forceinline__ void gemm_phase(PG8_LAS unsigned char* lds, const Gemm g, const Sched& S, const Epi& E, unsigned long long* stamps) {
    const int tid = otid(), wid = __builtin_amdgcn_readfirstlane(tid >> 6), lane = tid & 63, wr = wid >> 2, wc = wid & 3, fr = lane & 15, fq = lane >> 4;
    const int K = g.K, nt = K / BK;
    int ts_lo = 0, ts_hi = 0, nts = 0; const unsigned long long rt_entry = STAMP ? (unsigned long long)wall_clock64() : 0ull;
#define PG8_STAMP() do { if (STAMP && wid == 0 && nts < 64) { const unsigned long long _c = (unsigned long long)clock64(); \
        ts_lo = (lane == nts) ? (int)(unsigned)_c : ts_lo; ts_hi = (lane == nts) ? (int)(unsigned)(_c >> 32) : ts_hi; ++nts; } } while (0)
    PG8_STAMP();
    unsigned voffA[2], voffB[2];
#pragma unroll
    for (int i = 0; i < 2; ++i) { int R, C; stage_rc(tid * 16 + i * 8192, R, C); const int Rb = Epi::PERM ? ((R & ~31) + perm32(R & 31)) : R;
        voffA[i] = (unsigned)(R * K + C) * 2u; voffB[i] = (unsigned)(Rb * K + C) * 2u; }
    const size_t kstep = (size_t)(BK * 2);
    const size_t hstep = (size_t)HALF * K * 2;
    const size_t tstep = 2 * hstep;
    const unsigned ldsw = (unsigned)wid * 1024u;
    const int aoff = lds_byte(wr * 64 + fr, fq * 8), boff = lds_byte(wc * 32 + fr, fq * 8);
#define PG8_SA(b, h) (((b) * 2 + (h)) * HTB)
#define PG8_SB(b, h) ((4 + (b) * 2 + (h)) * HTB)
#define PG8_STAGE(bufoff, gbase, voff) do { _Pragma("unroll") for (int _i = 0; _i < 2; ++_i) \
        __builtin_amdgcn_global_load_lds((const unsigned*)((const char*)(gbase) + (voff)[_i]), (PG8_LAS unsigned*)(lds + (bufoff) + ldsw + _i * 8192), 16, 0, 0); } while (0)
#define PG8_LDA(dst, b, h) do { _Pragma("unroll") for (int m = 0; m < 4; ++m) _Pragma("unroll") for (int k = 0; k < 2; ++k) dst[m][k] = *(const PG8_LAS bf16x8*)(lds + PG8_SA(b, h) + aoff + m * 2048 + k * 1024); } while (0)
#define PG8_LDB(dst, b, h) do { _Pragma("unroll") for (int n = 0; n < 2; ++n) _Pragma("unroll") for (int k = 0; k < 2; ++k) dst[n][k] = *(const PG8_LAS bf16x8*)(lds + PG8_SB(b, h) + boff + n * 2048 + k * 1024); } while (0)
#define PG8_MMA(ai, bj, At, Bt) do { __builtin_amdgcn_s_setprio(1); _Pragma("unroll") for (int m = 0; m < 4; ++m) _Pragma("unroll") for (int n = 0; n < 2; ++n) _Pragma("unroll") for (int k = 0; k < 2; ++k) \
        acc[ai][bj][m][n] = __builtin_amdgcn_mfma_f32_16x16x32_bf16(Bt[n][k], At[m][k], acc[ai][bj][m][n], 0, 0, 0); __builtin_amdgcn_s_setprio(0); } while (0)
#define PG8_WAIT_V(n) asm volatile("s_waitcnt vmcnt(" #n ")" ::: "memory")
#define PG8_WAIT_L(n) asm volatile("s_waitcnt lgkmcnt(" #n ")" ::: "memory")
#define PG8_BAR __builtin_amdgcn_s_barrier()
#define PG8_SCHED __builtin_amdgcn_sched_barrier(0)
    Unit cur, nxt; int ui = 0;
    if (!S.next(0, cur)) return;
    f32x4 acc[2][2][4][2];
#pragma unroll
    for (int a = 0; a < 2; ++a)
#pragma unroll
        for (int b = 0; b < 2; ++b)
#pragma unroll
            for (int m = 0; m < 4; ++m)
#pragma unroll
                for (int n = 0; n < 2; ++n) acc[a][b][m][n] = (f32x4){0.f, 0.f, 0.f, 0.f};
    bf16x8 At[4][2], B0[2][2], B1[2][2];
    const char* cA = (const char*)g.A + (size_t)cur.pm * tstep; const char* cB = (const char*)g.Bt + (size_t)cur.pn * tstep;
    S.a_ready(cur);
    PG8_STAGE(PG8_SB(0, 0), cB, voffB); PG8_STAGE(PG8_SA(0, 0), cA, voffA); PG8_STAGE(PG8_SB(0, 1), cB + hstep, voffB); PG8_STAGE(PG8_SA(0, 1), cA + hstep, voffA);
    if (wr == 1) PG8_BAR;
    PG8_WAIT_V(4); PG8_BAR;
    PG8_STAGE(PG8_SB(1, 0), cB + kstep, voffB); PG8_STAGE(PG8_SA(1, 0), cA + kstep, voffA); PG8_STAGE(PG8_SB(1, 1), cB + hstep + kstep, voffB);
    PG8_WAIT_V(6); PG8_BAR;
    PG8_STAMP();
    for (;;) {
        const bool has_next = S.next(ui + 1, nxt);
        const char* nA = has_next ? (const char*)g.A + (size_t)nxt.pm * tstep : cA; const char* nB = has_next ? (const char*)g.Bt + (size_t)nxt.pn * tstep : cB;
        for (int t = 0; t < nt; t += 2) {
            const bool last = (t == nt - 2);
            const char* a1 = cA + (size_t)(t + 1) * kstep;
            const char* a2 = last ? nA : cA + (size_t)(t + 2) * kstep; const char* b2 = last ? nB : cB + (size_t)(t + 2) * kstep;
            const char* a3 = a2 + kstep; const char* b3 = b2 + kstep;
            if (last && has_next) S.a_ready(nxt);
            PG8_LDB(B0, 0, 0); PG8_SCHED; PG8_LDA(At, 0, 0); PG8_STAGE(PG8_SA(1, 1), a1 + hstep, voffA);
            PG8_WAIT_L(8); PG8_BAR; PG8_WAIT_L(0); PG8_MMA(0, 0, At, B0); PG8_BAR; PG8_SCHED;
            PG8_LDB(B1, 0, 1); PG8_STAGE(PG8_SB(0, 0), b2, voffB);
            PG8_BAR; PG8_WAIT_L(0); PG8_MMA(0, 1, At, B1); PG8_BAR;
            PG8_LDA(At, 0, 1); PG8_STAGE(PG8_SA(0, 0), a2, voffA);
            PG8_BAR; PG8_WAIT_L(0); PG8_MMA(1, 0, At, B0); PG8_BAR; PG8_SCHED;
            PG8_STAGE(PG8_SB(0, 1), b2 + hstep, voffB);
            PG8_WAIT_V(6); PG8_BAR; PG8_MMA(1, 1, At, B1); PG8_BAR;
            PG8_LDB(B0, 1, 0); PG8_SCHED; PG8_LDA(At, 1, 0); PG8_STAGE(PG8_SA(0, 1), a2 + hstep, voffA);
            PG8_WAIT_L(8); PG8_BAR; PG8_WAIT_L(0); PG8_MMA(0, 0, At, B0); PG8_BAR; PG8_SCHED;
            PG8_LDB(B1, 1, 1); PG8_STAGE(PG8_SB(1, 0), b3, voffB);
            PG8_BAR; PG8_WAIT_L(0); PG8_MMA(0, 1, At, B1); PG8_BAR;
            PG8_LDA(At, 1, 1); PG8_STAGE(PG8_SA(1, 0), a3, voffA);
            PG8_BAR; PG8_WAIT_L(0); PG8_MMA(1, 0, At, B0); PG8_BAR; PG8_SCHED;
            PG8_STAGE(PG8_SB(1, 1), b3 + hstep, voffB);
            PG8_WAIT_V(6); PG8_BAR; PG8_MMA(1, 1, At, B1); PG8_BAR;
        }
        PG8_STAMP();
        if constexpr (!Epi::AFTER_DRAIN) { E(acc, cur, wr, wc, fr, fq); S.done(cur); }
        PG8_STAMP();
        if (!has_next) break;
#pragma unroll
        for (int a = 0; a < 2; ++a)
#pragma unroll
            for (int b = 0; b < 2; ++b)
#pragma unroll
                for (int m = 0; m < 4; ++m)
#pragma unroll
                    for (int n = 0; n < 2; ++n) acc[a][b][m][n] = (f32x4){0.f, 0.f, 0.f, 0.f};
        cur = nxt; cA = nA; cB = nB; ++ui;
    }
    PG8_WAIT_V(0);
    if (wr == 0) PG8_BAR;
    PG8_BAR;
    if constexpr (Epi::AFTER_DRAIN) { E.fused(acc, cur, wr, wc, fr, fq, lds, wid, lane); S.done(cur); }
    PG8_STAMP();
    if (STAMP && wid == 0) { stamps[lane] = lane < nts ? (((unsigned long long)(unsigned)ts_hi << 32) | (unsigned)ts_lo) : 0ull;
        if (lane == 62) stamps[62] = rt_entry; if (lane == 63) stamps[63] = (unsigned long long)wall_clock64(); }
#undef PG8_STAMP
#undef PG8_SA
#undef PG8_SB
#undef PG8_STAGE
#undef PG8_LDA
#undef PG8_LDB
#undef PG8_MMA
#undef PG8_WAIT_V
#undef PG8_WAIT_L
#undef PG8_BAR
#undef PG8_SCHED
}
}

#define LDM4(X, ROW0, B) do { \
    asm volatile("ds_read_b128 %0, %1 offset:%2" : "=v"(X##0) : "v"(mbase), "n"(((ROW0) + 0) * 256 + (B) * 4) : "memory"); \
    asm volatile("ds_read_b128 %0, %1 offset:%2" : "=v"(X##1) : "v"(mbase), "n"(((ROW0) + 1) * 256 + (B) * 4) : "memory"); \
    asm volatile("ds_read_b128 %0, %1 offset:%2" : "=v"(X##2) : "v"(mbase), "n"(((ROW0) + 2) * 256 + (B) * 4) : "memory"); \
    asm volatile("ds_read_b128 %0, %1 offset:%2" : "=v"(X##3) : "v"(mbase), "n"(((ROW0) + 3) * 256 + (B) * 4) : "memory"); } while (0)
#define WAITM(N, X) asm volatile("s_waitcnt lgkmcnt(" #N ")" : "+v"(X##0), "+v"(X##1), "+v"(X##2), "+v"(X##3) :: "memory")
#define FMA4(X, B) do { \
    c0 = fmaf(-X##0[0], t[(B)], c0); c1 = fmaf(-X##1[0], t[(B)], c1); c2 = fmaf(-X##2[0], t[(B)], c2); c3 = fmaf(-X##3[0], t[(B)], c3); \
    c0 = fmaf(-X##0[1], t[(B) + 1], c0); c1 = fmaf(-X##1[1], t[(B) + 1], c1); c2 = fmaf(-X##2[1], t[(B) + 1], c2); c3 = fmaf(-X##3[1], t[(B) + 1], c3); \
    c0 = fmaf(-X##0[2], t[(B) + 2], c0); c1 = fmaf(-X##1[2], t[(B) + 2], c1); c2 = fmaf(-X##2[2], t[(B) + 2], c2); c3 = fmaf(-X##3[2], t[(B) + 2], c3); \
    c0 = fmaf(-X##0[3], t[(B) + 3], c0); c1 = fmaf(-X##1[3], t[(B) + 3], c1); c2 = fmaf(-X##2[3], t[(B) + 3], c2); c3 = fmaf(-X##3[3], t[(B) + 3], c3); } while (0)
template <int KB, int JB> struct SolveStep {
  static DI void run(float (&t)[64], int mbase, float& c0, float& c1, float& c2, float& c3, f32x4& A0, f32x4& A1, f32x4& A2, f32x4& A3, f32x4& B0, f32x4& B1, f32x4& B2, f32x4& B3) {
    if constexpr (JB < KB) {
      if constexpr (JB + 1 < KB) { LDM4(B, KB * 4, (JB + 1) * 4); WAITM(4, A); } else { WAITM(0, A); }
      FMA4(A, JB * 4);
      SolveStep<KB, JB + 1>::run(t, mbase, c0, c1, c2, c3, B0, B1, B2, B3, A0, A1, A2, A3);
    }
  }
};
template <int KB> DI void solve_block_r(float (&t)[64], int mbase, int lane) {
  constexpr int a0 = KB * 4;
  float c0 = (a0 + 0 == lane) ? 1.f : 0.f, c1 = (a0 + 1 == lane) ? 1.f : 0.f, c2 = (a0 + 2 == lane) ? 1.f : 0.f, c3 = (a0 + 3 == lane) ? 1.f : 0.f;
  f32x4 D0, D1, D2, D3, A0, A1, A2, A3, B0, B1, B2, B3;
  LDM4(D, a0, a0);
  if constexpr (KB > 0) { LDM4(A, a0, 0); }
  SolveStep<KB, 0>::run(t, mbase, c0, c1, c2, c3, A0, A1, A2, A3, B0, B1, B2, B3);
  WAITM(0, D);
  c1 = fmaf(-D1[0], c0, c1);
  c2 = fmaf(-D2[0], c0, c2); c2 = fmaf(-D2[1], c1, c2);
  c3 = fmaf(-D3[0], c0, c3); c3 = fmaf(-D3[1], c1, c3); c3 = fmaf(-D3[2], c2, c3);
  t[a0] = c0; t[a0 + 1] = c1; t[a0 + 2] = c2; t[a0 + 3] = c3;
}

DI void phase_chunk(const Params& p, char* lds) {
  u16* P = (u16*)(p.ws + OFF_P); const u16* HALO = (const u16*)(p.ws + OFF_HALO);
  const float* BA = (const float*)(p.ws + OFF_BA); float* SCg = (float*)(p.ws + OFF_SC);
  u16* TQg = (u16*)(p.ws + OFF_TQ); u16* KTg = (u16*)(p.ws + OFF_KT);
  char* Qs = lds; char* Ks = lds + 16384; float* M0 = (float*)(lds + 32768);
  float* sbeta = (float*)(lds + 98304); float* sg = sbeta + 128; float* sgc = sg + 128;
  const int tid0 = otid();
  for (int item = blockIdx.x; item < GS * 8 * NCHUNK; item += gridDim.x) {
    int tid = tid0; asm volatile("" : "+v"(tid));
    const int lane = tid & 63, wid = tid >> 6, cp = tid & 255, rh = tid >> 8, part = (tid >> 6) & 3;
    const int ch = cp * 2;
    const int chunk = item % NCHUNK, h = (item / NCHUNK) % 8, seq = item / (NCHUNK * 8);
    const int col = ch < 128 ? h * 128 + ch : (ch < 256 ? 1024 + h * 128 + (ch - 128) : 2048 + h * 256 + (ch - 256));
    const int R0 = seq * TP + chunk * 64, cg_ = seq * NCHUNK + chunk;
    unsigned outv[32];
    {
      float w0[5], w1[5];
#pragma unroll
      for (int j = 0; j < 5; ++j) { w0[j] = p.g_conv[j * 4096 + col]; w1[j] = p.g_conv[j * 4096 + col + 1]; }
      unsigned x[36];
#pragma unroll
      for (int i = 0; i < 36; ++i) {
        const int rr = rh * 32 + i - 2;
        unsigned v = 0u;
        if (rr >= 0 && rr < 64) v = *(const unsigned*)(P + (long)(R0 + rr) * 4096 + col);
        else if (rr < 0) { if (cg_ > 0) v = *(const unsigned*)(HALO + ((long)(cg_ - 1) * 4 + 2 + (rr + 2)) * 4096 + col); }
        else { if (cg_ + 1 < GS * NCHUNK) v = *(const unsigned*)(HALO + ((long)(cg_ + 1) * 4 + (rr - 64)) * 4096 + col); }
        x[i] = v;
      }
#pragma unroll
      for (int o = 0; o < 32; ++o) {
        float a0 = 0.f, a1 = 0.f;
#pragma unroll
        for (int j = 0; j < 5; ++j) { a0 += w0[j] * bflo(x[o + j]); a1 += w1[j] * bfhi(x[o + j]); }
        a0 = silu(a0); a1 = silu(a1);
        if (part < 2) {
          float ss = wave_sum(a0 * a0 + a1 * a1);
          float sc = rsqrtf(ss + EPS) * (part == 0 ? 0.08838834764831845f : 1.f);
          a0 *= sc; a1 *= sc;
        }
        const int row = rh * 32 + o;
        if (chunk == 0 && row < PADR) { a0 = 0.f; a1 = 0.f; }
        outv[o] = pk2(a0, a1);
        if ((o & 3) == 3) SBAR();
      }
    }
    __syncthreads();
#pragma unroll
    for (int o = 0; o < 32; ++o) *(unsigned*)(P + (long)(R0 + rh * 32 + o) * 4096 + col) = outv[o];
    if (part < 2) {
      char* dstT = part == 0 ? Qs : Ks; const int chl = ch - part * 128;
#pragma unroll
      for (int o = 0; o < 32; ++o) { const int row = rh * 32 + o;
        *(unsigned*)(dstT + row * 256 + ((((chl >> 3) ^ (row & 7))) << 4) + (chl & 7) * 2) = outv[o]; }
      if (part == 1) {
        u16* kt = KTg + ((long)(seq * 8 + h) * NCHUNK + chunk) * 8192 + (long)chl * 64 + rh * 32;
#pragma unroll
        for (int q4 = 0; q4 < 4; ++q4) {
          u32x4 lo, hi4;
#pragma unroll
          for (int e = 0; e < 4; ++e) { const unsigned a = outv[q4 * 8 + 2 * e], b = outv[q4 * 8 + 2 * e + 1];
            lo[e] = (a & 0xffffu) | (b << 16); hi4[e] = (a >> 16) | (b & 0xffff0000u); }
          *(u32x4*)(kt + q4 * 8) = lo; *(u32x4*)(kt + 64 + q4 * 8) = hi4;
          SBAR();
        }
      }
    }
    if (tid < 128) {
      const int r = tid & 63, dir = tid >> 6; const long row = R0 + r;
      const float b = BA[row * 32 + dir * 8 + h], a = BA[row * 32 + 16 + dir * 8 + h];
      float beta = 1.f / (1.f + __expf(-b));
      float xx = a + p.g_dtb[dir * 8 + h];
      float sp = xx > 20.f ? xx : __logf(1.f + __expf(xx));
      float gg = -__expf(p.g_alog[dir * 8 + h]) * sp;
      if (chunk == 0 && r < PADR) { beta = 0.f; gg = 0.f; }
      float gc = gg;
#pragma unroll
      for (int off = 1; off < 64; off <<= 1) {
        const float up = __shfl_up(gc, off, 64), dn = __shfl_down(gc, off, 64);
        if (dir == 0) { if (r >= off) gc += up; } else { if (r + off < 64) gc += dn; }
      }
      const float gl = __shfl(gc, dir == 0 ? 63 : 0, 64);
      sbeta[dir * 64 + r] = beta; sgc[dir * 64 + r] = gc;
      f32x4 st = {beta, __expf(gc), __expf(gl - gc), __expf(gl)};
      *(f32x4*)(SCg + ((long)((seq * 8 + h) * 2 + dir) * TP + chunk * 64 + r) * 4) = st;
    }
    __syncthreads();
    {
      const int kind = wid >> 2, qi = (wid >> 1) & 1, qj = wid & 1;
      int r32 = lane & 31, hi = lane >> 5;
      asm volatile("" : "+v"(r32), "+v"(hi));
      const char* At = kind ? Qs : Ks;
      f32x16 acc;
#pragma unroll
      for (int r = 0; r < 16; ++r) acc[r] = 0.f;
#pragma unroll
      for (int ks = 0; ks < 8; ++ks) {
        const int c = ks * 2 + hi; const int ra = qi * 32 + r32, rb = qj * 32 + r32;
        bf16x8 af = *(const bf16x8*)(At + ra * 256 + ((c ^ (ra & 7)) << 4));
        bf16x8 bfr = *(const bf16x8*)(Ks + rb * 256 + ((c ^ (rb & 7)) << 4));
        acc = __builtin_amdgcn_mfma_f32_32x32x16_bf16(af, bfr, acc, 0, 0, 0);
        if (ks & 1) SBAR();
      }
      const int j = qj * 32 + r32;
      u16* Ag0 = TQg + ((long)((seq * 8 + h) * 2 + 0) * NCHUNK + chunk) * 8192 + 4096;
      u16* Ag1 = TQg + ((long)((seq * 8 + h) * 2 + 1) * NCHUNK + chunk) * 8192 + 4096;
      const float gj0 = sgc[j], gj1 = sgc[64 + j];
#pragma unroll
      for (int r = 0; r < 16; ++r) {
        const int i = qi * 32 + crow(r, hi);
        const float e0 = __expf(fminf(sgc[i] - gj0, 0.f)), e1 = __expf(fminf(sgc[64 + i] - gj1, 0.f));
        if (kind == 0) {
          M0[i * 64 + j] = j < i ? sbeta[i] * acc[r] * e0 : 0.f;
          M0[4096 + (63 - i) * 64 + (63 - j)] = j > i ? sbeta[64 + i] * acc[r] * e1 : 0.f;
        } else {
          Ag0[i * 64 + j] = f2bf(j <= i ? acc[r] * e0 : 0.f);
          Ag1[i * 64 + j] = f2bf(j >= i ? acc[r] * e1 : 0.f);
        }
        SBAR();
      }
    }
    __syncthreads();
    if (wid < 2) {
      const int d = wid; const float* M = M0 + d * 4096; float* Tl = M0 + 8192 + d * 4096;
      float t[64];
      const int mbase = (int)(uintptr_t)M;
      solve_block_r<0>(t, mbase, lane); solve_block_r<1>(t, mbase, lane); solve_block_r<2>(t, mbase, lane); solve_block_r<3>(t, mbase, lane);
      solve_block_r<4>(t, mbase, lane); solve_block_r<5>(t, mbase, lane); solve_block_r<6>(t, mbase, lane); solve_block_r<7>(t, mbase, lane);
      solve_block_r<8>(t, mbase, lane); solve_block_r<9>(t, mbase, lane); solve_block_r<10>(t, mbase, lane); solve_block_r<11>(t, mbase, lane);
      solve_block_r<12>(t, mbase, lane); solve_block_r<13>(t, mbase, lane); solve_block_r<14>(t, mbase, lane); solve_block_r<15>(t, mbase, lane);
      u16* Tg = TQg + ((long)((seq * 8 + h) * 2 + d) * NCHUNK + chunk) * 8192;
      const int tbase = d ? 63 * 64 + 63 - lane : lane, tstride = d ? -64 : 64;
#pragma unroll
      for (int a = 0; a < 64; ++a) Tg[tbase + a * tstride] = f2bf(t[a]);
    }
  }
}

DI bf16x8 pack8(f32x4 a, f32x4 b) { u32x4 w = {pk2(a[0], a[1]), pk2(a[2], a[3]), pk2(b[0], b[1]), pk2(b[2], b[3])}; return __builtin_bit_cast(bf16x8, w); }
DI bf16x8 ld_frag(const char* ptr) { u32x2 lo = *(const u32x2*)ptr; u32x2 hi = *(const u32x2*)(ptr + 32); u32x4 w = {lo[0], lo[1], hi[0], hi[1]}; return __builtin_bit_cast(bf16x8, w); }
#define MFMA16(a, b, c) __builtin_amdgcn_mfma_f32_16x16x32_bf16((a), (b), (c), 0, 0, 0)
constexpr int SB_Q = 0, SB_K = 17408, SB_KT = 34816, SB_T = 53248, SB_A = 62464, SB_V = 71680, SB_SC = 79872, SB_SIZE = 80896;

struct ScanRegs { u32x4 rq[4], rk[4], rkt[4], rt[2], ra[2], rv[2]; f32x4 rs; };
DI void scan_issue(const Params& p, int seq, int h, int dir, int dvq, int cc, int lt, ScanRegs& R) {
  const u16* P = (const u16*)(p.ws + OFF_P);
  const long R0 = (long)seq * TP + cc * 64;
  const u16* Pq = P + R0 * 4096 + h * 128; const u16* Pk = Pq + 1024; const u16* Pv = P + R0 * 4096 + 2048 + h * 256 + dvq * 64;
  const u16* KTg = (const u16*)(p.ws + OFF_KT) + ((long)(seq * 8 + h) * NCHUNK + cc) * 8192;
  const u16* Tg = (const u16*)(p.ws + OFF_TQ) + ((long)((seq * 8 + h) * 2 + dir) * NCHUNK + cc) * 8192;
  const float* SCg = (const float*)(p.ws + OFF_SC) + ((long)((seq * 8 + h) * 2 + dir) * TP + cc * 64) * 4;
#pragma unroll
  for (int i = 0; i < 4; ++i) { const int e = lt + 256 * i, row = e >> 4, c = e & 15;
    R.rq[i] = *(const u32x4*)(Pq + (long)row * 4096 + c * 8); R.rk[i] = *(const u32x4*)(Pk + (long)row * 4096 + c * 8); }
#pragma unroll
  for (int i = 0; i < 4; ++i) { const int e = lt + 256 * i, row = e >> 3, c = e & 7; R.rkt[i] = *(const u32x4*)(KTg + row * 64 + c * 8); }
#pragma unroll
  for (int i = 0; i < 2; ++i) { const int e = lt + 256 * i, row = e >> 3, c = e & 7;
    R.rt[i] = *(const u32x4*)(Tg + row * 64 + c * 8); R.ra[i] = *(const u32x4*)(Tg + 4096 + row * 64 + c * 8);
    R.rv[i] = *(const u32x4*)(Pv + (long)row * 4096 + c * 8); }
  R.rs = (f32x4){0.f, 0.f, 0.f, 0.f};
  if (lt < 64) R.rs = *(const f32x4*)(SCg + lt * 4);
}
DI void scan_commit(char* B, int lt, const ScanRegs& R) {
#pragma unroll
  for (int i = 0; i < 4; ++i) { const int e = lt + 256 * i, row = e >> 4, c = e & 15;
    *(u32x4*)(B + SB_Q + row * 272 + c * 16) = R.rq[i]; *(u32x4*)(B + SB_K + row * 272 + c * 16) = R.rk[i]; }
#pragma unroll
  for (int i = 0; i < 4; ++i) { const int e = lt + 256 * i, row = e >> 3, c = e & 7; *(u32x4*)(B + SB_KT + row * 144 + c * 16) = R.rkt[i]; }
#pragma unroll
  for (int i = 0; i < 2; ++i) { const int e = lt + 256 * i, row = e >> 3, c = e & 7;
    *(u32x4*)(B + SB_T + row * 144 + c * 16) = R.rt[i]; *(u32x4*)(B + SB_A + row * 144 + c * 16) = R.ra[i];
    *(u32x4*)(B + SB_V + row * 128 + c * 16) = R.rv[i]; }
  if (lt < 64) *(f32x4*)(B + SB_SC + lt * 16) = R.rs;
}

DI void scan_compute(f32x4 (&S)[8], const char* B, u16* __restrict__ Orow, int wid, int n, int quad) {
  const char* bK = B + SB_K + n * 272 + 8 * quad; const char* bQ = B + SB_Q + n * 272 + 8 * quad;
  const char* bT = B + SB_T + n * 144 + 8 * quad; const char* bA = B + SB_A + n * 144 + 8 * quad; const char* bKT = B + SB_KT + n * 144 + 8 * quad;
  bf16x8 fa[8], fb[8];
#define LD_KQ(F, mt) do { _Pragma("unroll") for (int ks = 0; ks < 4; ++ks) { F[ks] = ld_frag(bK + (mt) * 16 * 272 + 64 * ks); F[4 + ks] = ld_frag(bQ + (mt) * 16 * 272 + 64 * ks); } } while (0)
#define LD_64(F, base) do { _Pragma("unroll") for (int mt = 0; mt < 4; ++mt) { F[2 * mt] = ld_frag(base + mt * 16 * 144); F[2 * mt + 1] = ld_frag(base + mt * 16 * 144 + 64); } } while (0)
#define GRP() do { __builtin_amdgcn_sched_group_barrier(0x100, 8, 0); __builtin_amdgcn_sched_group_barrier(0x008, 8, 0); SBAR(); } while (0)
  bf16x8 Sb[4];
#pragma unroll
  for (int ks = 0; ks < 4; ++ks) Sb[ks] = pack8(S[2 * ks], S[2 * ks + 1]);
  f32x4 KS[4], QS[4];
#pragma unroll
  for (int mt = 0; mt < 4; ++mt) { KS[mt] = (f32x4){0.f, 0.f, 0.f, 0.f}; QS[mt] = (f32x4){0.f, 0.f, 0.f, 0.f}; }
#define MM_KQ(F, mt) do { _Pragma("unroll") for (int ks = 0; ks < 4; ++ks) { KS[mt] = MFMA16(F[ks], Sb[ks], KS[mt]); QS[mt] = MFMA16(F[4 + ks], Sb[ks], QS[mt]); } } while (0)
  LD_KQ(fa, 0); SBAR();
  LD_KQ(fb, 1); MM_KQ(fa, 0); GRP();
  LD_KQ(fa, 2); MM_KQ(fb, 1); GRP();
  LD_KQ(fb, 3); MM_KQ(fa, 2); GRP();
  LD_64(fa, bT); MM_KQ(fb, 3); GRP();
  f32x4 rhs[4], o[4]; float egl = 1.f;
#pragma unroll
  for (int mt = 0; mt < 4; ++mt)
#pragma unroll
    for (int i = 0; i < 4; ++i) {
      const int row = 16 * mt + 4 * quad + i;
      const f32x4 sc = *(const f32x4*)(B + SB_SC + row * 16);
      const float v = bf2f(*(const u16*)(B + SB_V + row * 128 + (wid * 16 + n) * 2));
      egl = sc[3];
      rhs[mt][i] = sc[0] * (v - sc[1] * KS[mt][i]);
      o[mt][i] = QS[mt][i] * sc[1];
    }
  bf16x8 Rb[2];
#pragma unroll
  for (int k2 = 0; k2 < 2; ++k2) Rb[k2] = pack8(rhs[2 * k2], rhs[2 * k2 + 1]);
  SBAR();
  f32x4 VN[4];
  LD_64(fb, bA);
#pragma unroll
  for (int mt = 0; mt < 4; ++mt) { VN[mt] = (f32x4){0.f, 0.f, 0.f, 0.f}; VN[mt] = MFMA16(fa[2 * mt], Rb[0], VN[mt]); VN[mt] = MFMA16(fa[2 * mt + 1], Rb[1], VN[mt]); }
  GRP();
  bf16x8 Vb[2], Vd[2];
#pragma unroll
  for (int k2 = 0; k2 < 2; ++k2) {
    Vb[k2] = pack8(VN[2 * k2], VN[2 * k2 + 1]);
    f32x4 e0, e1;
#pragma unroll
    for (int i = 0; i < 4; ++i) { e0[i] = *(const float*)(B + SB_SC + (32 * k2 + 4 * quad + i) * 16 + 8); e1[i] = *(const float*)(B + SB_SC + (32 * k2 + 16 + 4 * quad + i) * 16 + 8); }
    Vd[k2] = pack8(VN[2 * k2] * e0, VN[2 * k2 + 1] * e1);
  }
  SBAR();
  LD_64(fa, bKT);
#pragma unroll
  for (int mt = 0; mt < 4; ++mt) { o[mt] = MFMA16(fb[2 * mt], Vb[0], o[mt]); o[mt] = MFMA16(fb[2 * mt + 1], Vb[1], o[mt]); }
  GRP();
  LD_64(fb, bKT + 64 * 144);
#pragma unroll
  for (int t = 0; t < 4; ++t) { S[t] = S[t] * egl; S[t] = MFMA16(fa[2 * t], Vd[0], S[t]); S[t] = MFMA16(fa[2 * t + 1], Vd[1], S[t]); }
  GRP();
#pragma unroll
  for (int t = 0; t < 4; ++t) { S[4 + t] = S[4 + t] * egl; S[4 + t] = MFMA16(fb[2 * t], Vd[0], S[4 + t]); S[4 + t] = MFMA16(fb[2 * t + 1], Vd[1], S[4 + t]); }
#pragma unroll
  for (int mt = 0; mt < 4; ++mt)
#pragma unroll
    for (int i = 0; i < 4; ++i) *(u16*)((char*)B + SB_V + (16 * mt + 4 * quad + i) * 128 + (wid * 16 + n) * 2) = f2bf(o[mt][i]);
#undef LD_KQ
#undef LD_64
#undef GRP
#undef MM_KQ
}

DI void phase_scan(const Params& p, char* lds) {
  for (int item = blockIdx.x; item < GS * 8 * 2 * 4; item += gridDim.x) {
    const int tid = otid(), wid = tid >> 6, lane = tid & 63, n = lane & 15, quad = lane >> 4, lt = tid - 256;
    int dvq = item & 3, tri = item >> 2;
    if (gridDim.x == 256) { const int vb = vbid(lds), x = vb >> 5, lb = vb & 31; dvq = lb & 3; tri = x + 8 * (lb >> 2); }
    const int dir = tri & 1, h = (tri >> 1) & 7, seq = tri >> 4;
    u16* O = (u16*)(p.ws + (dir ? OFF_OB : OFF_OF)) + (long)seq * TP * 2048 + h * 256 + dvq * 64 + (wid & 3) * 16 + n;
    const int wid_s = __builtin_amdgcn_readfirstlane(wid);
#define CHK(c) (dir ? NCHUNK - 1 - (c) : (c))
    if (wid_s >= 4) {
      ScanRegs LA;
      __syncthreads();
      scan_issue(p, seq, h, dir, dvq, CHK(0), lt, LA); scan_commit(lds, lt, LA); scan_issue(p, seq, h, dir, dvq, CHK(1), lt, LA);
      __syncthreads();
      u16* Og = (u16*)(p.ws + (dir ? OFF_OB : OFF_OF)) + (long)seq * TP * 2048 + h * 256 + dvq * 64;
#define OFLUSH(Bp, cc) do { _Pragma("unroll") for (int i = 0; i < 2; ++i) { const int e = lt + 256 * i, row = e >> 3, c16 = e & 7; \
          *(u32x4*)(Og + ((long)(cc) * 64 + row) * 2048 + c16 * 8) = *(const u32x4*)((Bp) + SB_V + row * 128 + c16 * 16); } } while (0)
#pragma unroll 1
      for (int c = 0; c < NCHUNK; ++c) {
        if (c > 0) OFLUSH(lds + ((c + 1) & 1) * SB_SIZE, CHK(c - 1));
        if (c + 1 < NCHUNK) scan_commit(lds + ((c + 1) & 1) * SB_SIZE, lt, LA);
        if (c + 2 < NCHUNK) scan_issue(p, seq, h, dir, dvq, CHK(c + 2), lt, LA);
        __syncthreads();
      }
      OFLUSH(lds + ((NCHUNK - 1) & 1) * SB_SIZE, CHK(NCHUNK - 1));
#undef OFLUSH
    } else {
      f32x4 S[8];
#pragma unroll
      for (int t = 0; t < 8; ++t) S[t] = (f32x4){0.f, 0.f, 0.f, 0.f};
      __builtin_amdgcn_s_setprio(2);
      __syncthreads();
      __syncthreads();
#pragma unroll 1
      for (int c = 0; c < NCHUNK; ++c) {
        scan_compute(S, lds + (c & 1) * SB_SIZE, O + (long)CHK(c) * 64 * 2048, wid, n, quad);
        __syncthreads();
      }
      __builtin_amdgcn_s_setprio(0);
    }
#undef CHK
  }
}

DI void phase_gate(const Params& p) {
  u16* OFp = (u16*)(p.ws + OFF_OF); const u16* OBp = (const u16*)(p.ws + OFF_OB); const u16* Z = (const u16*)(p.ws + OFF_Z);
  const int lane = otid() & 63, wv = otid() >> 6;
  constexpr int UN = 4;
  for (int it0 = (blockIdx.x * 8 + wv) * UN; it0 < GR * 8; it0 += gridDim.x * 8 * UN) {
    u32x2 a[UN], b[UN], z[UN];
#pragma unroll
    for (int u = 0; u < UN; ++u) { const long off = (long)(it0 + u) * 256 + lane * 4;
      a[u] = __builtin_nontemporal_load((const u32x2*)(OFp + off)); b[u] = __builtin_nontemporal_load((const u32x2*)(OBp + off)); z[u] = __builtin_nontemporal_load((const u32x2*)(Z + off)); }
#pragma unroll
    for (int u = 0; u < UN; ++u) { const long off = (long)(it0 + u) * 256 + lane * 4;
      float o0 = bflo(a[u][0]) + bflo(b[u][0]), o1 = bfhi(a[u][0]) + bfhi(b[u][0]), o2 = bflo(a[u][1]) + bflo(b[u][1]), o3 = bfhi(a[u][1]) + bfhi(b[u][1]);
      float ss = wave_sum(o0 * o0 + o1 * o1 + o2 * o2 + o3 * o3);
      float rs = rsqrtf(ss * (1.f / 256.f) + EPS);
      u32x2 w = {pk2(o0 * rs * silu(bflo(z[u][0])), o1 * rs * silu(bfhi(z[u][0]))), pk2(o2 * rs * silu(bflo(z[u][1])), o3 * rs * silu(bfhi(z[u][1])))};
      *(u32x2*)(OFp + off) = w; }
  }
}

DI void phase_rowstats(const Params& p) {
  const u16* CQ = (const u16*)(p.ws + OFF_CQ); const u16* CKV = (const u16*)(p.ws + OFF_CKV); const float* KPE = (const float*)(p.ws + OFF_KPE);
  float* rowst = (float*)(p.ws + OFF_ROWST); float* kper = (float*)(p.ws + OFF_KPER); const float* rope = (const float*)(p.ws + OFF_ROPE);
  const int lane = otid() & 63, wv = otid() >> 6;
  for (int row = blockIdx.x * 8 + wv; row < GR; row += gridDim.x * 8) {
    u32x4 q = *(const u32x4*)(CQ + (long)row * 512 + lane * 8);
    float sq = 0.f;
#pragma unroll
    for (int j = 0; j < 4; ++j) { float a = bflo(q[j]), b = bfhi(q[j]); sq += a * a + b * b; }
    u32x2 kv = *(const u32x2*)(CKV + (long)row * 256 + lane * 4);
    float sk = 0.f;
#pragma unroll
    for (int j = 0; j < 2; ++j) { float a = bflo(kv[j]), b = bfhi(kv[j]); sk += a * a + b * b; }
    const float kp = KPE[(long)row * 64 + lane];
    sq = wave_sum(sq); sk = wave_sum(sk); const float sp = wave_sum(kp * kp);
    const float val = kp * p.m_kg[128 + lane];
    const float oth = __shfl_xor(val, 32, 64);
    int pos = row % TP - PADR; pos = pos < 0 ? 0 : pos;
    const int i = lane & 31; const float c = rope[pos * 64 + i], s = rope[pos * 64 + 32 + i];
    kper[(long)row * 64 + lane] = lane < 32 ? val * c - oth * s : val * c + oth * s;
    if (lane == 0) { f32x4 st = {rsqrtf(sq * (1.f / 512.f) + EPS), rsqrtf(sk * (1.f / 256.f) + EPS), sp, 0.f}; *(f32x4*)(rowst + (long)row * 4) = st; }
  }
}

constexpr float ATT_SCALE = 0.07216878364870322f;
constexpr float ATT_THR = 8.f;
constexpr int SHM_V = 64 * 128 * 2, SHM_K = 64 * 192 * 2;
DI int v_st(int k, int c) { const int kk = (k & ~0xC) | ((k & 4) << 1) | ((k & 8) >> 1); return ((kk >> 3) * 4 + (c >> 5)) * 512 + ((kk & 7) * 32 + (c & 31)) * 2; }
DI int v_rd_base(int lane) { return ((lane & 3) << 3) | (((lane >> 2) & 3) << 6) | (((lane >> 4) & 1) << 5) | (((lane >> 5) & 1) << 8); }
constexpr int v_rd_off(int d0, int ks, int half) { return d0 * 512 + ks * 4096 + half * 2048; }
template <int OFF> DI s16x4 tr_read(int vb) {
  s16x4 r; asm volatile("ds_read_b64_tr_b16 %0, %1 offset:%2" : "=&v"(r) : "v"(vb), "i"(OFF) : "memory"); return r;
}
#define RD8(D0, X) do { X##0 = tr_read<v_rd_off(D0, 0, 0)>(vb); X##1 = tr_read<v_rd_off(D0, 0, 1)>(vb); X##2 = tr_read<v_rd_off(D0, 1, 0)>(vb); X##3 = tr_read<v_rd_off(D0, 1, 1)>(vb); \
    X##4 = tr_read<v_rd_off(D0, 2, 0)>(vb); X##5 = tr_read<v_rd_off(D0, 2, 1)>(vb); X##6 = tr_read<v_rd_off(D0, 3, 0)>(vb); X##7 = tr_read<v_rd_off(D0, 3, 1)>(vb); } while (0)
#define PKV(L, H) (bf16x8){L[0], L[1], L[2], L[3], H[0], H[1], H[2], H[3]}
#define MM4(OD, X) do { OD = __builtin_amdgcn_mfma_f32_32x32x16_bf16(pa0, PKV(X##0, X##1), OD, 0, 0, 0); OD = __builtin_amdgcn_mfma_f32_32x32x16_bf16(pa1, PKV(X##2, X##3), OD, 0, 0, 0); \
    OD = __builtin_amdgcn_mfma_f32_32x32x16_bf16(pa2, PKV(X##4, X##5), OD, 0, 0, 0); OD = __builtin_amdgcn_mfma_f32_32x32x16_bf16(pa3, PKV(X##6, X##7), OD, 0, 0, 0); } while (0)
DI void pv_all(f32x16* o, int vb, bf16x8 pa0, bf16x8 pa1, bf16x8 pa2, bf16x8 pa3) {
  s16x4 a0, a1, a2, a3, a4, a5, a6, a7;
  RD8(0, a); asm volatile("s_waitcnt lgkmcnt(0)" ::: "memory"); SBAR(); MM4(o[0], a); SBAR();
  RD8(1, a); asm volatile("s_waitcnt lgkmcnt(0)" ::: "memory"); SBAR(); MM4(o[1], a); SBAR();
  RD8(2, a); asm volatile("s_waitcnt lgkmcnt(0)" ::: "memory"); SBAR(); MM4(o[2], a); SBAR();
  RD8(3, a); asm volatile("s_waitcnt lgkmcnt(0)" ::: "memory"); SBAR(); MM4(o[3], a); SBAR();
}
#undef RD8
#undef MM4
#undef PKV

DI void attn_item(const u16* __restrict__ Qb, const u16* __restrict__ Kh, const u16* __restrict__ Vh, int q0,
                  u16* __restrict__ Yb, const u16* __restrict__ Zb, char* lds) {
  const int tid = otid(), wid = tid >> 6, lane = tid & 63, r32 = lane & 31, hi = lane >> 5;
  char* V_lds = lds; char* K_lds = lds + 3 * SHM_V;
  float* wsf = (float*)(lds + 3 * SHM_V + 3 * SHM_K) + wid * 64; float* li_l = wsf; float* al_l = wsf + 32;
  constexpr float C = ATT_SCALE * 1.4426950408889634f;
  float m_reg = -1e30f, l_reg = 0.f;
  f32x16 o[4];
#pragma unroll
  for (int d = 0; d < 4; ++d)
#pragma unroll
    for (int r = 0; r < 16; ++r) o[d][r] = 0.f;
  bf16x8 qr[12];
  const int qrow = q0 + wid * 32 + r32;
#pragma unroll
  for (int d0 = 0; d0 < 12; ++d0) {
    bf16x8 z = {0, 0, 0, 0, 0, 0, 0, 0};
    qr[d0] = qrow < TP ? *(const bf16x8*)(Qb + (long)qrow * 192 + d0 * 16 + hi * 8) : z;
  }
  const int vb0 = (int)(uintptr_t)V_lds + v_rd_base(lane);
  int koff[3], voff[2];
#pragma unroll
  for (int i = 0; i < 3; ++i) { const int P = (wid * 3 + i) * 1024 + lane * 16, row = P / 384, b = P % 384; koff[i] = row * 192 + ((b ^ ((row & 7) << 4)) >> 1); }
#pragma unroll
  for (int i = 0; i < 2; ++i) { const int P = (wid * 2 + i) * 1024 + lane * 16, sub = P >> 9, within = P & 511;
    const int kk = (sub >> 2) * 8 + (within >> 6), k = (kk & ~0xC) | ((kk & 4) << 1) | ((kk & 8) >> 1), c = (sub & 3) * 32 + ((within & 63) >> 1);
    voff[i] = k * 128 + c; }
#define GLDS16(gp, lp) __builtin_amdgcn_global_load_lds((const unsigned*)(gp), (__attribute__((address_space(3))) unsigned*)(lp), 16, 0, 0)
#define STAGE(k0, slot) do { \
    _Pragma("unroll") for (int i = 0; i < 3; ++i) GLDS16(Kh + (long)(k0) * 192 + koff[i], K_lds + (slot) * SHM_K + (wid * 3 + i) * 1024 + lane * 16); \
    _Pragma("unroll") for (int i = 0; i < 2; ++i) GLDS16(Vh + (long)(k0) * 128 + voff[i], V_lds + (slot) * SHM_V + (wid * 2 + i) * 1024 + lane * 16); } while (0)
  constexpr int NT = TP / 64;
#define ATT_QK(slot) do { \
    _Pragma("unroll") for (int r = 0; r < 16; ++r) { p0[r] = 0.f; p1[r] = 0.f; } \
    const char* Kc = K_lds + (slot) * SHM_K; const int swz = (r32 & 7) << 4; \
    const char* Kr0 = Kc + r32 * 384; const char* Kr1 = Kc + (32 + r32) * 384; \
    _Pragma("unroll") for (int d0 = 0; d0 < 12; ++d0) { const int cb = (d0 * 16 + hi * 8) * 2; \
      bf16x8 b0 = *(const bf16x8*)(Kr0 + (cb ^ swz)); bf16x8 b1 = *(const bf16x8*)(Kr1 + (cb ^ swz)); \
      p0 = __builtin_amdgcn_mfma_f32_32x32x16_bf16(b0, qr[d0], p0, 0, 0, 0); \
      p1 = __builtin_amdgcn_mfma_f32_32x32x16_bf16(b1, qr[d0], p1, 0, 0, 0); \
      if ((d0 & 1) == 1) SBAR(); } } while (0)
#define KFLOAD(G, S)
#define ATT_MASK0() do { _Pragma("unroll") for (int r = 0; r < 16; ++r) p0[r] = -1e30f; _Pragma("unroll") for (int r = 0; r < 8; ++r) p1[r] = -1e30f; } while (0)
#define PK4(PP, BASE, OUT) do { unsigned a0 = pk2(PP[BASE + 0], PP[BASE + 1]), a1 = pk2(PP[BASE + 2], PP[BASE + 3]); \
    unsigned b0 = pk2(PP[BASE + 4], PP[BASE + 5]), b1 = pk2(PP[BASE + 6], PP[BASE + 7]); \
    auto r0 = __builtin_amdgcn_permlane32_swap(a0, b0, false, false); auto r1 = __builtin_amdgcn_permlane32_swap(a1, b1, false, false); \
    u32x4 w = {r0[0], r1[0], r0[1], r1[1]}; OUT = __builtin_bit_cast(bf16x8, w); } while (0)
#define ATT_SM() do { \
    float pmax = p0[0]; \
    _Pragma("unroll") for (int r = 1; r < 16; ++r) pmax = fmaxf(pmax, p0[r]); \
    _Pragma("unroll") for (int r = 0; r < 16; ++r) pmax = fmaxf(pmax, p1[r]); \
    { auto rr = __builtin_amdgcn_permlane32_swap(__float_as_uint(pmax), __float_as_uint(pmax), false, false); \
      pmax = fmaxf(__uint_as_float(rr[0]), __uint_as_float(rr[1])); } \
    float mn, alpha; \
    if (__all(pmax - m_reg <= ATT_THR / ATT_SCALE)) { mn = m_reg; alpha = 1.f; } \
    else { mn = fmaxf(m_reg, pmax); alpha = __builtin_amdgcn_exp2f((m_reg - mn) * C); m_reg = mn; } \
    if (__any(alpha < 1.f)) { \
      if (hi == 0) al_l[r32] = alpha; \
      asm volatile("s_waitcnt lgkmcnt(0)" ::: "memory"); \
      _Pragma("unroll") for (int r = 0; r < 16; ++r) { const float a = al_l[crow(r, hi)]; \
        _Pragma("unroll") for (int d = 0; d < 4; ++d) o[d][r] *= a; } } \
    const float mnC = -mn * C; float ps = 0.f; \
    _Pragma("unroll") for (int r = 0; r < 16; ++r) { p0[r] = __builtin_amdgcn_exp2f(fmaf(p0[r], C, mnC)); p1[r] = __builtin_amdgcn_exp2f(fmaf(p1[r], C, mnC)); ps += p0[r] + p1[r]; } \
    { auto rr = __builtin_amdgcn_permlane32_swap(__float_as_uint(ps), __float_as_uint(ps), false, false); \
      ps = __uint_as_float(rr[0]) + __uint_as_float(rr[1]); } \
    l_reg = l_reg * alpha + ps; \
    PK4(p0, 0, pa0); PK4(p0, 8, pa1); PK4(p1, 0, pa2); PK4(p1, 8, pa3); } while (0)

  __syncthreads();
  STAGE(0, 0); STAGE(64, 1);
  __syncthreads();
  f32x16 p0, p1;
  bf16x8 pa0, pa1, pa2, pa3;
  const int wid_s = __builtin_amdgcn_readfirstlane(wid);
  if (wid_s < 4) {
    ATT_QK(0); ATT_MASK0(); ATT_SM();
    int sK = 1, sV = 0, sW = 2;
#pragma unroll 1
    for (int j = 1; j < NT; ++j) {
      if (j + 1 < NT) STAGE((j + 1) * 64, sW);
      pv_all(o, vb0 + sV * SHM_V, pa0, pa1, pa2, pa3);
      ATT_QK(sK);
      ATT_SM();
      sV = sK; sK = sW; sW = (sW == 2) ? 0 : sW + 1;
      __syncthreads();
    }
    pv_all(o, vb0 + sV * SHM_V, pa0, pa1, pa2, pa3);
  } else {
    ATT_QK(0); ATT_MASK0();
    int sK = 1, sV = 0, sW = 2;
#pragma unroll 1
    for (int j = 1; j < NT; ++j) {
      if (j + 1 < NT) STAGE((j + 1) * 64, sW);
      ATT_SM();
      pv_all(o, vb0 + sV * SHM_V, pa0, pa1, pa2, pa3);
      ATT_QK(sK);
      sV = sK; sK = sW; sW = (sW == 2) ? 0 : sW + 1;
      __syncthreads();
    }
    ATT_SM();
    pv_all(o, vb0 + sV * SHM_V, pa0, pa1, pa2, pa3);
  }
#undef ATT_QK
#undef KFLOAD
#undef ATT_MASK0
#undef PK4
#undef ATT_SM
#undef STAGE
#undef GLDS16
  if (hi == 0) li_l[r32] = l_reg;
  asm volatile("s_waitcnt lgkmcnt(0)" ::: "memory");
#pragma unroll
  for (int r = 0; r < 16; ++r) {
    const int orow = q0 + wid * 32 + crow(r, hi);
    const float rl = 1.f / li_l[crow(r, hi)];
    if (orow < TP) {
#pragma unroll
      for (int d0 = 0; d0 < 4; ++d0) {
        const long off = (long)orow * 2048 + d0 * 32 + r32;
        Yb[off - 64 * 2048] = f2bf(o[d0][r] * rl * silu(bf2f(Zb[off])));
      }
    }
  }
}

DI void phase_attn(const Params& p, char* lds) {
  const u16* QM = (const u16*)(p.ws + OFF_QM); const u16* KM = (const u16*)(p.ws + OFF_KM); const u16* VM = (const u16*)(p.ws + OFF_VM);
  u16* Y = (u16*)(p.ws + OFF_Y); const u16* Z = (const u16*)(p.ws + OFF_Z);
  const int b = blockIdx.x, vb = vbid(lds), x = vb >> 5, lb = vb & 31;
  if (gridDim.x == 256) {
    for (int it = 0; it < 4; ++it) {
      const int pair = x + 8 * (2 * it + (lb >> 4)), qb = lb & 15;
      const int seq = pair >> 4, head = pair & 15;
      attn_item(QM + (long)pair * TP * 192, KM + (long)pair * TP * 192, VM + (long)pair * TP * 128, 64 + qb * 256,
                Y + (long)seq * SEQ * 2048 + head * 128, Z + (long)seq * TP * 2048 + head * 128, lds);
    }
  } else {
    for (int item = b; item < 64 * 16; item += gridDim.x) {
      const int pair = item >> 4, qb = item & 15; const int seq = pair >> 4, head = pair & 15;
      attn_item(QM + (long)pair * TP * 192, KM + (long)pair * TP * 192, VM + (long)pair * TP * 128, 64 + qb * 256,
                Y + (long)seq * SEQ * 2048 + head * 128, Z + (long)seq * TP * 2048 + head * 128, lds);
    }
  }
}

#define XB_TMO      128
#define XB_XCNT(j)  (256  + 64 * (j))
#define XB_XSUB(j)  (1280 + 64 * (j))
#define XB_XGEN(j)  (2304 + 64 * (j))
#define XB_TOP      3328
#define XB_TOPGEN   3392
#define XCD_BAR_WORDS 3456
#define XB_SPIN_CAP (1u << 18)
#define LAS __attribute__((address_space(3)))
DI unsigned xb_ld(unsigned* p)              { return __hip_atomic_load(p, __ATOMIC_RELAXED, __HIP_MEMORY_SCOPE_AGENT); }
DI unsigned xb_add(unsigned* p, unsigned v) { return __hip_atomic_fetch_add(p, v, __ATOMIC_RELAXED, __HIP_MEMORY_SCOPE_AGENT); }
DI unsigned xb_xcc_id() { return (unsigned)__builtin_amdgcn_s_getreg((3 << 11) | 20) & 0xFu; }
#define XB_SPIN(cond, bar) do { unsigned _sp = 0; while (cond) { __builtin_amdgcn_s_sleep(1); \
    if ((++_sp & 255u) == 0u) { if (xb_ld(&(bar)[XB_TMO])) break; if (_sp > XB_SPIN_CAP) { atomicAdd(&(bar)[XB_TMO], 1u); break; } } } } while (0)
struct XcdBarrier { unsigned* bar; unsigned x; volatile LAS unsigned* st; };
DI XcdBarrier xcd_barrier_post(unsigned* bar, volatile LAS unsigned* st) {
  XcdBarrier b; b.bar = bar; b.x = xb_xcc_id(); b.st = st;
  if (__builtin_amdgcn_workitem_id_x() == 0) (void)xb_add(&bar[XB_XCNT(b.x)], 1u);
  return b;
}
DI void xcd_barrier_complete(unsigned* bar, unsigned x, unsigned& nloc, unsigned& nx) {
  const unsigned G = gridDim.x * gridDim.y * gridDim.z;
  unsigned sum, cnt, mine, sp = 0u;
  for (;;) {
    sum = 0u; cnt = 0u; mine = 0u;
#pragma unroll
    for (unsigned j = 0; j < 16; ++j) { const unsigned c = xb_ld(&bar[XB_XCNT(j)]); sum += c; cnt += (c > 0u) ? 1u : 0u; mine = (j == x) ? c : mine; }
    if (sum == G) break;
    __builtin_amdgcn_s_sleep(1);
    if ((++sp & 255u) == 0u) { if (xb_ld(&bar[XB_TMO])) break; if (sp > XB_SPIN_CAP) { atomicAdd(&bar[XB_TMO], 1u); break; } }
  }
  nloc = mine > 0u ? mine : 1u; nx = cnt > 0u ? cnt : 1u;
}
DI void xcd_barrier(const XcdBarrier& b) {
  asm volatile("s_waitcnt vmcnt(0)" ::: "memory");
  __syncthreads();
  if (__builtin_amdgcn_workitem_id_x() == 0) {
    unsigned* bar = b.bar;
    __builtin_amdgcn_s_waitcnt(0);
    unsigned nloc = b.st[0], nx = b.st[1];
    if (nloc == 0u) { xcd_barrier_complete(bar, b.x, nloc, nx); b.st[0] = nloc; b.st[1] = nx; }
    const unsigned old = xb_add(&bar[XB_XSUB(b.x)], 1u);
    const unsigned gen = old / nloc;
    if (old + 1u == (gen + 1u) * nloc) {
      __builtin_amdgcn_fence(__ATOMIC_RELEASE, "agent");
      asm volatile("s_waitcnt vmcnt(0)" ::: "memory");
      const unsigned og = xb_add(&bar[XB_TOP], 1u);
      const unsigned tg = og / nx;
      if (og + 1u == (tg + 1u) * nx) xb_add(&bar[XB_TOPGEN], 1u);
      else XB_SPIN(xb_ld(&bar[XB_TOPGEN]) == tg, bar);
      __builtin_amdgcn_fence(__ATOMIC_ACQUIRE, "agent");
      xb_add(&bar[XB_XGEN(b.x)], 1u);
      asm volatile("s_waitcnt vmcnt(0)" ::: "memory");
    } else {
      XB_SPIN(xb_ld(&bar[XB_XGEN(b.x)]) == gen, bar);
      __builtin_amdgcn_fence(__ATOMIC_ACQUIRE, "agent");
      asm volatile("s_waitcnt vmcnt(0)" ::: "memory");
    }
  }
  __syncthreads();
}

__global__ void __launch_bounds__(512) fwd_mega(Params p) {
  extern __shared__ __attribute__((aligned(16))) char lds[];
  cg::grid_group grid = cg::this_grid();
  char* ws = p.ws;
  unsigned* barw = (unsigned*)(ws + OFF_BAR);
  if (blockIdx.x == 0) for (int i = otid(); i < XCD_BAR_WORDS + 256; i += 512) barw[i] = 0u;
  volatile LAS unsigned* xst = (volatile LAS unsigned*)(lds + LDS_BYTES - 16);
  if (otid() == 0) { xst[0] = 0u; xst[1] = 0u; }
  grid.sync();
  const XcdBarrier xb = xcd_barrier_post(barw, xst);
  if (otid() == 0) { const unsigned xc = xb_xcc_id(); xst[2] = xb_add(&barw[XCD_BAR_WORDS + 16 * xc], 1u); xst[3] = blockIdx.x; }
  phase_prep(p, lds);
  for (int g = 0; g < NGRP; ++g) {
    if (g == 0) { phase_hn(p, 0, 0); xcd_barrier(xb); }
    if (g == 0) {
      if (otid() == 0) { const unsigned xc = xb_xcc_id(); unsigned base = 0;
        for (unsigned j = 0; j < 16; ++j) { const unsigned c = xb_ld(&barw[XCD_BAR_WORDS + 16 * j]); base += (j < xc) ? c : 0u; }
        xst[3] = base + xst[2]; }
      __syncthreads();
    }
    { pg8::StaticOrder so; so.init(GR, 6400, (int)gridDim.x, (gridDim.x == 256) ? ((vbid(lds) & 31) * 8 + (vbid(lds) >> 5)) : (int)blockIdx.x);
      pg8::EpiGinT e{(u16*)(ws + OFF_P), (u16*)(ws + OFF_HALO), (u16*)(ws + OFF_Z), (float*)(ws + OFF_BA)};
      pg8::gemm_phase<pg8::EpiGinT, pg8::StaticOrder, false>((PG8_LAS unsigned char*)lds, pg8::Gemm{(const u16*)(ws + OFF_HN), (const u16*)(ws + OFF_WGIN), GR, 6400, 1024}, so, e, nullptr); }
    xcd_barrier(xb);
    phase_chunk(p, lds);
    xcd_barrier(xb);
    for (int rep = 0; rep < REP_SCAN; ++rep) phase_scan(p, lds);
    xcd_barrier(xb);
    phase_gate(p);
    xcd_barrier(xb);
    { pg8::StaticOrder so; so.init(GR, 1024, (int)gridDim.x, (gridDim.x == 256) ? ((vbid(lds) & 31) * 8 + (vbid(lds) >> 5)) : (int)blockIdx.x);
      pg8::EpiGoutT e{p, g, (float*)(ws + OFF_H1M)};
      pg8::gemm_phase<pg8::EpiGoutT, pg8::StaticOrder, false>((PG8_LAS unsigned char*)lds, pg8::Gemm{(const u16*)(ws + OFF_OF), (const u16*)(ws + OFF_WGOUT), GR, 1024, 2048}, so, e, nullptr); }
    xcd_barrier(xb);
    phase_hn(p, g, 1);
    xcd_barrier(xb);
    { pg8::StaticOrder so; so.init(GR, 3072, (int)gridDim.x, (gridDim.x == 256) ? ((vbid(lds) & 31) * 8 + (vbid(lds) >> 5)) : (int)blockIdx.x);
      pg8::EpiMinT e{(u16*)(ws + OFF_CQ), (u16*)(ws + OFF_CKV), (u16*)(ws + OFF_Z), (float*)(ws + OFF_KPE)};
      pg8::gemm_phase<pg8::EpiMinT, pg8::StaticOrder, false>((PG8_LAS unsigned char*)lds, pg8::Gemm{(const u16*)(ws + OFF_HN), (const u16*)(ws + OFF_WMIN), GR, 3072, 1024}, so, e, nullptr); }
    xcd_barrier(xb);
    phase_rowstats(p);
    xcd_barrier(xb);
    { EpiQ e{(const float*)(ws + OFF_ROWST), p.m_qg, (const float*)(ws + OFF_ROPE), (u16*)(ws + OFF_QM)};
      for (int rep = 0; rep < REP_GEMM; ++rep) gemm_phase<8, 1, 1, 6>((const u16*)(ws + OFF_CQ), 512, (const u16*)(ws + OFF_WUQ), 512, 512, 3072, lds, e); }
    { EpiKV e{(const float*)(ws + OFF_ROWST), p.m_kg, (const float*)(ws + OFF_KPER), (u16*)(ws + OFF_KM), (u16*)(ws + OFF_VM)};
      for (int rep = 0; rep < REP_GEMM; ++rep) gemm_phase<8, 1, 1, 4>((const u16*)(ws + OFF_CKV), 256, (const u16*)(ws + OFF_WUKV), 256, 256, 4096, lds, e); }
    xcd_barrier(xb);
    for (int rep = 0; rep < REP_ATTN; ++rep) phase_attn(p, lds);
    xcd_barrier(xb);
    { pg8::StaticOrder so; so.init(GS * SEQ, 1024, (int)gridDim.x, (gridDim.x == 256) ? ((vbid(lds) & 31) * 8 + (vbid(lds) >> 5)) : (int)blockIdx.x);
      pg8::EpiMoutT e{p.out, g};
      pg8::gemm_phase<pg8::EpiMoutT, pg8::StaticOrder, false>((PG8_LAS unsigned char*)lds, pg8::Gemm{(const u16*)(ws + OFF_Y), (const u16*)(ws + OFF_WMOUT), GS * SEQ, 1024, 2048}, so, e, nullptr); }
    if (g + 1 < NGRP) phase_hn(p, g + 1, 0);
    xcd_barrier(xb);
  }
}

extern "C" void kernel_launch(void* const* d_in, const int* in_sizes, int n_in,
                              void* d_out, int out_size, void* d_ws, size_t ws_size,
                              hipStream_t stream) {
  static int grid_blocks = 0;
  if (!grid_blocks) {
    int dev = 0, cus = 0, per_cu = 0;
    (void)hipGetDevice(&dev);
    (void)hipDeviceGetAttribute(&cus, hipDeviceAttributeMultiprocessorCount, dev);
    (void)hipFuncSetAttribute((const void*)fwd_mega, hipFuncAttributeMaxDynamicSharedMemorySize, LDS_BYTES);
    (void)hipOccupancyMaxActiveBlocksPerMultiprocessor(&per_cu, fwd_mega, 512, LDS_BYTES);
    if (per_cu < 1) { fprintf(stderr, "occupancy query returned %d\n", per_cu); per_cu = 1; }
    if (per_cu > 1) per_cu = 1;
    grid_blocks = cus * per_cu;
  }
  if (ws_size < WS_NEED) { fprintf(stderr, "workspace too small: %zu < %zu\n", ws_size, (size_t)WS_NEED); return; }
  Params p{};
  p.xp = (const float*)d_in[0]; p.xs = (const float*)d_in[1]; p.meta = (const float*)d_in[2]; p.ln_g = (const float*)d_in[3];
  p.g_win = (const float*)d_in[4]; p.g_conv = (const float*)d_in[5]; p.g_alog = (const float*)d_in[6]; p.g_dtb = (const float*)d_in[7];
  p.g_onorm = (const float*)d_in[8]; p.g_wout = (const float*)d_in[9]; p.m_win = (const float*)d_in[10]; p.m_qn = (const float*)d_in[11];
  p.m_kvn = (const float*)d_in[12]; p.m_wuq = (const float*)d_in[13]; p.m_wukv = (const float*)d_in[14]; p.m_qg = (const float*)d_in[15];
  p.m_kg = (const float*)d_in[16]; p.m_wout = (const float*)d_in[17]; p.out = (float*)d_out; p.ws = (char*)d_ws;
  void* args[] = {&p};
  hipError_t e = hipLaunchCooperativeKernel((void*)fwd_mega, dim3(grid_blocks), dim3(512), args, LDS_BYTES, stream);
  if (e != hipSuccess) fprintf(stderr, "cooperative launch failed: %s (grid %d)\n", hipGetErrorString(e), grid_blocks);
}
```

```cpp
#include <hip/hip_runtime.h>
#include <hip/hip_cooperative_groups.h>
#include <cstdio>
#include <cstdint>
namespace cg = cooperative_groups;

typedef unsigned short u16;
typedef __bf16 bf2_t __attribute__((ext_vector_type(2)));
typedef float f2_t __attribute__((ext_vector_type(2)));
using bf16x8 = __attribute__((ext_vector_type(8))) short;
using s16x4  = __attribute__((ext_vector_type(4))) short;
using f32x16 = __attribute__((ext_vector_type(16))) float;
using f32x4  = __attribute__((ext_vector_type(4))) float;
using u32x4  = __attribute__((ext_vector_type(4))) unsigned;
using u32x2  = __attribute__((ext_vector_type(2))) unsigned;
#define DI __device__ __forceinline__
#define SBAR() __builtin_amdgcn_sched_barrier(0)

DI unsigned pk2(float a, float b) { f2_t v = {a, b}; bf2_t r = __builtin_convertvector(v, bf2_t); return __builtin_bit_cast(unsigned, r); }
DI u16 f2bf(float a) { return (u16)(pk2(a, 0.f) & 0xffffu); }
DI float bf2f(u16 v) { return __uint_as_float(((unsigned)v) << 16); }
DI float bflo(unsigned v) { return __uint_as_float(v << 16); }
DI float bfhi(unsigned v) { return __uint_as_float(v & 0xffff0000u); }
DI int otid() { int t = __builtin_amdgcn_workitem_id_x(); asm volatile("" : "+v"(t)); return t; }
DI int crow(int r, int hi) { return (r & 3) + 8 * (r >> 2) + 4 * hi; }
#define DPP_ADD(v, ctrl, rm) ((v) + __builtin_bit_cast(float, __builtin_amdgcn_update_dpp(0, __builtin_bit_cast(int, (v)), (ctrl), (rm), 0xF, false)))
DI float wave_sum(float v) {
  v = DPP_ADD(v, 0xB1, 0xF);
  v = DPP_ADD(v, 0x4E, 0xF);
  v = DPP_ADD(v, 0x141, 0xF);
  v = DPP_ADD(v, 0x140, 0xF);
  v = DPP_ADD(v, 0x142, 0xA);
  v = DPP_ADD(v, 0x143, 0xC);
  return __builtin_bit_cast(float, __builtin_amdgcn_readlane(__builtin_bit_cast(int, v), 63));
}
DI float silu(float x) { return x * __builtin_amdgcn_rcpf(1.f + __expf(-x)); }

constexpr int D = 1024, TP = 4160, GS = 4, GR = GS * TP, NGRP = 3, PADR = 48, SEQ = 4096;
constexpr int GIN = 6176, GINP = 6400, MIN_ = 2880, MINP = 3072;
constexpr float EPS = 1e-6f;
constexpr int NCHUNK = 65;

constexpr size_t al256(size_t x) { return (x + 255) / 256 * 256; }
constexpr size_t OFF_WGIN  = 0;
constexpr size_t OFF_WGOUT = OFF_WGIN  + al256((size_t)GINP * 1024 * 2);
constexpr size_t OFF_WMIN  = OFF_WGOUT + al256((size_t)1024 * 2048 * 2);
constexpr size_t OFF_WUQ   = OFF_WMIN  + al256((size_t)MINP * 1024 * 2);
constexpr size_t OFF_WUKV  = OFF_WUQ   + al256((size_t)3072 * 512 * 2);
constexpr size_t OFF_WMOUT = OFF_WUKV  + al256((size_t)4096 * 256 * 2);
constexpr size_t OFF_ROPE  = OFF_WMOUT + al256((size_t)1024 * 2048 * 2);
constexpr size_t OFF_H1M   = OFF_ROPE  + al256((size_t)4112 * 64 * 4);
constexpr size_t OFF_HN    = OFF_H1M   + al256((size_t)12 * 16 * 1024 * 4);
constexpr size_t OFF_Z     = OFF_HN    + al256((size_t)GR * 1024 * 2);
constexpr size_t OFF_R     = OFF_Z     + al256((size_t)GR * 2048 * 2);
constexpr size_t OFF_P     = OFF_R;
constexpr size_t OFF_HALO  = OFF_P     + al256((size_t)GR * 4096 * 2);
constexpr size_t OFF_BA    = OFF_HALO  + al256((size_t)(GR / 64) * 4 * 4096 * 2);
constexpr size_t OFF_SC    = OFF_BA    + al256((size_t)GR * 32 * 4);
constexpr size_t OFF_TQ    = OFF_SC    + al256((size_t)GS * 8 * 2 * TP * 16);
constexpr size_t OFF_KT    = OFF_TQ    + al256((size_t)GS * 8 * 2 * NCHUNK * 16384);
constexpr size_t OFF_OF    = OFF_KT    + al256((size_t)GS * 8 * NCHUNK * 16384);
constexpr size_t OFF_OB    = OFF_OF    + al256((size_t)GR * 2048 * 2);
constexpr size_t END_GDN   = OFF_OB    + al256((size_t)GR * 2048 * 2);
constexpr size_t OFF_CQ    = OFF_R;
constexpr size_t OFF_CKV   = OFF_CQ    + al256((size_t)GR * 512 * 2);
constexpr size_t OFF_KPE   = OFF_CKV   + al256((size_t)GR * 256 * 2);
constexpr size_t OFF_ROWST = OFF_KPE   + al256((size_t)GR * 64 * 4);
constexpr size_t OFF_KPER  = OFF_ROWST + al256((size_t)GR * 4 * 4);
constexpr size_t OFF_QM    = OFF_KPER  + al256((size_t)GR * 64 * 4);
constexpr size_t OFF_KM    = OFF_QM    + al256((size_t)GR * 16 * 192 * 2);
constexpr size_t OFF_VM    = OFF_KM    + al256((size_t)GR * 16 * 192 * 2);
constexpr size_t OFF_Y     = OFF_VM    + al256((size_t)GR * 16 * 128 * 2);
constexpr size_t END_MLA   = OFF_Y     + al256((size_t)GR * 2048 * 2);
constexpr size_t OFF_BAR   = END_MLA > END_GDN ? END_MLA : END_GDN;
constexpr size_t WS_NEED   = OFF_BAR + 16384;

constexpr int LDS_BYTES = 160 * 1024;
#ifndef REP_ATTN
#define REP_ATTN 1
#endif
#ifndef REP_SCAN
#define REP_SCAN 1
#endif
#ifndef REP_GEMM
#define REP_GEMM 1
#endif

struct Params {
  const float *xp, *xs, *meta, *ln_g, *g_win, *g_conv, *g_alog, *g_dtb, *g_onorm, *g_wout;
  const float *m_win, *m_qn, *m_kvn, *m_wuq, *m_wukv, *m_qg, *m_kg, *m_wout;
  float* out; char* ws;
};

DI const float* h0_row(const Params& p, int sg, int pos) {
  return pos < 16 ? p.meta + (long)pos * D
                  : (sg < 4 ? p.xp + ((long)sg * SEQ + pos - 16) * D : p.xs + ((long)(sg - 4) * SEQ + pos - 16) * D);
}

#define LASP __attribute__((address_space(3)))
DI int vbid(const char* lds) { return __builtin_amdgcn_readfirstlane((int)*(const volatile LASP unsigned*)(lds + LDS_BYTES - 4)); }

DI void transpose_cvt(const float* __restrict__ src, u16* __restrict__ dst, int K, int N, int Npad,
                      const float* __restrict__ gain, int gmod, float* lds) {
  const int tid = otid();
  const int tK = K / 64, tN = Npad / 64;
  for (int tile = blockIdx.x; tile < tK * tN; tile += gridDim.x) {
    const int tk = tile % tK, tn = tile / tK;
#pragma unroll
    for (int i = 0; i < 2; ++i) {
      int kk = (tid >> 4) + 32 * i, nn = (tid & 15) * 4;
      int k = tk * 64 + kk, n = tn * 64 + nn;
      float4 v = make_float4(0.f, 0.f, 0.f, 0.f);
      if (n < N) v = *(const float4*)(src + (long)k * N + n);
      float gsc = gain ? gain[k % gmod] : 1.f;
      lds[kk * 65 + nn + 0] = v.x * gsc; lds[kk * 65 + nn + 1] = v.y * gsc;
      lds[kk * 65 + nn + 2] = v.z * gsc; lds[kk * 65 + nn + 3] = v.w * gsc;
    }
    __syncthreads();
    {
      int n = tid >> 3, k8 = (tid & 7) * 8;
      float f[8];
#pragma unroll
      for (int j = 0; j < 8; ++j) f[j] = lds[(k8 + j) * 65 + n];
      u32x4 w = {pk2(f[0], f[1]), pk2(f[2], f[3]), pk2(f[4], f[5]), pk2(f[6], f[7])};
      *(u32x4*)(dst + (long)(tn * 64 + n) * K + tk * 64 + k8) = w;
    }
    __syncthreads();
  }
}

DI void phase_prep(const Params& p, char* lds) {
  float* l = (float*)lds;
  transpose_cvt(p.g_win, (u16*)(p.ws + OFF_WGIN), 1024, GIN, GINP, p.ln_g, 1024, l);
  transpose_cvt(p.g_wout, (u16*)(p.ws + OFF_WGOUT), 2048, 1024, 1024, p.g_onorm, 256, l);
  transpose_cvt(p.m_win, (u16*)(p.ws + OFF_WMIN), 1024, MIN_, MINP, p.ln_g + 1024, 1024, l);
  transpose_cvt(p.m_wuq, (u16*)(p.ws + OFF_WUQ), 512, 3072, 3072, p.m_qn, 512, l);
  transpose_cvt(p.m_wukv, (u16*)(p.ws + OFF_WUKV), 256, 4096, 4096, p.m_kvn, 256, l);
  transpose_cvt(p.m_wout, (u16*)(p.ws + OFF_WMOUT), 2048, 1024, 1024, nullptr, 1, l);
  float* rope = (float*)(p.ws + OFF_ROPE);
  for (int i = blockIdx.x * 512 + otid(); i < 4112 * 32; i += gridDim.x * 512) {
    int pos = i >> 5, j = i & 31;
    float inv = __builtin_amdgcn_exp2f(-(float)j * (13.287712379549449f / 32.f));
    float ang = (float)pos * inv;
    float n = rintf(ang * 0.15915494309189535f);
    float rr = fmaf(-n, 6.28318548202514648f, ang); rr = fmaf(-n, -1.7484555e-7f, rr);
    float s = __sinf(rr), c = __cosf(rr);
    rope[pos * 64 + j] = c; rope[pos * 64 + 32 + j] = s;
  }
}

DI void phase_hn(const Params& p, int g, int layer) {
  const int lane = otid() & 63, wv = otid() >> 6;
  u16* HN = (u16*)(p.ws + OFF_HN);
  const float* h1m = (const float*)(p.ws + OFF_H1M);
  for (int row = blockIdx.x * 8 + wv; row < GR; row += gridDim.x * 8) {
    int seq = row / TP, r = row % TP, pos = r - PADR, sg = g * GS + seq;
    u16* dst = HN + (long)row * D;
    if (pos < 0) {
      u32x2 z = {0u, 0u};
#pragma unroll
      for (int i = 0; i < 4; ++i) *(u32x2*)(dst + i * 256 + lane * 4) = z;
      continue;
    }
    const float* src;
    if (layer == 0) src = h0_row(p, sg, pos);
    else src = pos < 16 ? h1m + ((long)sg * 16 + pos) * D : p.out + ((long)sg * SEQ + pos - 16) * D;
    float4 v[4]; float ss = 0.f;
#pragma unroll
    for (int i = 0; i < 4; ++i) { v[i] = *(const float4*)(src + i * 256 + lane * 4); ss += v[i].x * v[i].x + v[i].y * v[i].y + v[i].z * v[i].z + v[i].w * v[i].w; }
    ss = wave_sum(ss);
    float rs = rsqrtf(ss * (1.f / 1024.f) + EPS);
#pragma unroll
    for (int i = 0; i < 4; ++i) { u32x2 w = {pk2(v[i].x * rs, v[i].y * rs), pk2(v[i].z * rs, v[i].w * rs)}; *(u32x2*)(dst + i * 256 + lane * 4) = w; }
  }
}

template <int WM, int WN, int MT, int NT, class Epi>
DI void gemm_tile(const u16* __restrict__ A, int lda, const u16* __restrict__ Bt, int ldb, int K, int m0, int n0, char* lds, const Epi& epi) {
  constexpr int BM = WM * MT * 32, BN = WN * NT * 32, NA = BM * 8 / 512, NB = BN * 8 / 512;
  static_assert(WM * WN == 8, "8 waves");
  const int tid = otid(), lane = tid & 63, wid = tid >> 6, r32 = lane & 31, hi = lane >> 5;
  const int wm = wid / WN, wn = wid % WN;
  char* As = lds; char* Bs = lds + 2 * BM * 128;
  f32x16 acc[MT][NT];
#pragma unroll
  for (int a = 0; a < MT; ++a)
#pragma unroll
    for (int b = 0; b < NT; ++b)
#pragma unroll
      for (int r = 0; r < 16; ++r) acc[a][b][r] = 0.f;
  u32x4 ra[NA], rb[NB];
  const int nk = K / 64;
#define GLOAD(kt) do { _Pragma("unroll") for (int i = 0; i < NA; ++i) { int q = tid + 512 * i; int row = q >> 3, c = q & 7; \
      ra[i] = *(const u32x4*)(A + (long)(m0 + row) * lda + (kt) * 64 + c * 8); } \
    _Pragma("unroll") for (int i = 0; i < NB; ++i) { int q = tid + 512 * i; int row = q >> 3, c = q & 7; \
      rb[i] = *(const u32x4*)(Bt + (long)(n0 + row) * ldb + (kt) * 64 + c * 8); } } while (0)
#define SWRITE(buf) do { _Pragma("unroll") for (int i = 0; i < NA; ++i) { int q = tid + 512 * i; int row = q >> 3, c = q & 7; \
      *(u32x4*)(As + (buf) * BM * 128 + row * 128 + ((c ^ (row & 7)) << 4)) = ra[i]; } \
    _Pragma("unroll") for (int i = 0; i < NB; ++i) { int q = tid + 512 * i; int row = q >> 3, c = q & 7; \
      *(u32x4*)(Bs + (buf) * BN * 128 + row * 128 + ((c ^ (row & 7)) << 4)) = rb[i]; } } while (0)
  GLOAD(0); SWRITE(0); if (nk > 1) GLOAD(1);
  __syncthreads();
  for (int kt = 0; kt < nk; ++kt) {
    const int cur = kt & 1;
#pragma unroll
    for (int ks = 0; ks < 4; ++ks) {
      bf16x8 af[MT], bfr[NT];
      const int c = ks * 2 + hi;
#pragma unroll
      for (int a = 0; a < MT; ++a) { int row = (wm * MT + a) * 32 + r32; af[a] = *(const bf16x8*)(As + cur * BM * 128 + row * 128 + ((c ^ (row & 7)) << 4)); }
#pragma unroll
      for (int b = 0; b < NT; ++b) { int row = (wn * NT + b) * 32 + r32; bfr[b] = *(const bf16x8*)(Bs + cur * BN * 128 + row * 128 + ((c ^ (row & 7)) << 4)); }
#pragma unroll
      for (int a = 0; a < MT; ++a)
#pragma unroll
        for (int b = 0; b < NT; ++b) acc[a][b] = __builtin_amdgcn_mfma_f32_32x32x16_bf16(af[a], bfr[b], acc[a][b], 0, 0, 0);
    }
    if (kt + 1 < nk) { SWRITE(cur ^ 1); if (kt + 2 < nk) GLOAD(kt + 2); }
    __syncthreads();
  }
#undef GLOAD
#undef SWRITE
  epi(acc, m0 + wm * MT * 32, n0 + wn * NT * 32, lane);
}

template <int NT> struct EpiGin { u16 *P, *HALO, *Z; float* BA;
  DI void operator()(f32x16 (&acc)[2][NT], int m0, int n0, int lane) const {
    const int r32 = lane & 31, hi = lane >> 5;
#pragma unroll
    for (int a = 0; a < 2; ++a)
#pragma unroll
      for (int b = 0; b < NT; ++b) {
        const int col = n0 + b * 32 + r32;
#pragma unroll
        for (int r = 0; r < 16; ++r) {
          const int row = m0 + a * 32 + crow(r, hi); const float v = acc[a][b][r];
          if (col < 4096) { u16 bv = f2bf(v); P[(long)row * 4096 + col] = bv; int rm = row & 63;
            if (rm < 2 || rm >= 62) HALO[((long)(row >> 6) * 4 + (rm < 2 ? rm : rm - 60)) * 4096 + col] = bv; }
          else if (col < 6144) Z[(long)row * 2048 + col - 4096] = f2bf(v);
          else if (col < GIN) BA[(long)row * 32 + col - 6144] = v;
        }
      }
  } };

struct EpiGout { Params p; int g; float* h1m;
  DI void operator()(f32x16 (&acc)[2][2], int m0, int n0, int lane) const {
    const int r32 = lane & 31, hi = lane >> 5;
#pragma unroll
    for (int a = 0; a < 2; ++a)
#pragma unroll
      for (int r = 0; r < 16; ++r) {
        const int row = m0 + a * 32 + crow(r, hi);
        const int seq = row / TP, rr = row % TP, pos = rr - PADR, sg = g * GS + seq;
        if (pos < 0) continue;
        const float* h0 = h0_row(p, sg, pos);
        float* dst = pos < 16 ? h1m + ((long)sg * 16 + pos) * D : p.out + ((long)sg * SEQ + pos - 16) * D;
#pragma unroll
        for (int b = 0; b < 2; ++b) { const int col = n0 + b * 32 + r32; dst[col] = h0[col] + acc[a][b][r]; }
      }
  } };

struct EpiMin { u16 *CQ, *CKV, *Z; float* KPE;
  DI void operator()(f32x16 (&acc)[2][2], int m0, int n0, int lane) const {
    const int r32 = lane & 31, hi = lane >> 5;
#pragma unroll
    for (int a = 0; a < 2; ++a)
#pragma unroll
      for (int b = 0; b < 2; ++b) {
        const int col = n0 + b * 32 + r32;
#pragma unroll
        for (int r = 0; r < 16; ++r) {
          const int row = m0 + a * 32 + crow(r, hi); const float v = acc[a][b][r];
          if (col < 512) CQ[(long)row * 512 + col] = f2bf(v);
          else if (col < 768) CKV[(long)row * 256 + col - 512] = f2bf(v);
          else if (col < 832) KPE[(long)row * 64 + col - 768] = v;
          else if (col < MIN_) Z[(long)row * 2048 + col - 832] = f2bf(v);
        }
      }
  } };

struct EpiQ { const float *rowst, *gq, *rope; u16* Q;
  DI void operator()(f32x16 (&acc)[1][6], int m0, int n0, int lane) const {
    const int r32 = lane & 31, hi = lane >> 5, head = n0 / 192;
    float ss[16];
#pragma unroll
    for (int r = 0; r < 16; ++r) {
      const int row = m0 + crow(r, hi); const float rq = rowst[row * 4 + 0]; float s = 0.f;
#pragma unroll
      for (int b = 0; b < 6; ++b) { acc[0][b][r] *= rq; s += acc[0][b][r] * acc[0][b][r]; }
      ss[r] = s;
    }
#pragma unroll
    for (int r = 0; r < 16; ++r) {
      float v = ss[r];
      v = DPP_ADD(v, 0xB1, 0xF); v = DPP_ADD(v, 0x4E, 0xF); v = DPP_ADD(v, 0x141, 0xF); v = DPP_ADD(v, 0x140, 0xF);
      ss[r] = v + __shfl_xor(v, 16, 64);
    }
    float gc[6];
#pragma unroll
    for (int b = 0; b < 6; ++b) gc[b] = gq[b * 32 + r32];
#pragma unroll
    for (int r = 0; r < 16; ++r) {
      const int row = m0 + crow(r, hi); const int seq = row / TP, rr = row % TP; int pos = rr - PADR; pos = pos < 0 ? 0 : pos;
      const float rs = rsqrtf(ss[r] * (1.f / 192.f) + EPS);
      const float c = rope[pos * 64 + r32], s = rope[pos * 64 + 32 + r32];
      float x[6];
#pragma unroll
      for (int b = 0; b < 6; ++b) x[b] = acc[0][b][r] * rs * gc[b];
      const float x1 = x[4] * c - x[5] * s, x2 = x[5] * c + x[4] * s; x[4] = x1; x[5] = x2;
      u16* dst = Q + ((long)(seq * 16 + head) * TP + rr) * 192;
#pragma unroll
      for (int b = 0; b < 6; ++b) dst[b * 32 + r32] = f2bf(x[b]);
    }
  } };

struct EpiKV { const float *rowst, *gk, *kper; u16 *Kd, *Vd;
  DI void operator()(f32x16 (&acc)[1][4], int m0, int n0, int lane) const {
    const int r32 = lane & 31, hi = lane >> 5, head = n0 >> 8, isv = (n0 >> 7) & 1;
    if (isv) {
#pragma unroll
      for (int r = 0; r < 16; ++r) {
        const int row = m0 + crow(r, hi); const int seq = row / TP, rr = row % TP; const float rk = rowst[row * 4 + 1];
        u16* vd = Vd + ((long)(seq * 16 + head) * TP + rr) * 128;
#pragma unroll
        for (int b = 0; b < 4; ++b) vd[b * 32 + r32] = f2bf(acc[0][b][r] * rk);
      }
      return;
    }
    float ss[16];
#pragma unroll
    for (int r = 0; r < 16; ++r) {
      const int row = m0 + crow(r, hi); const float rk = rowst[row * 4 + 1]; float s = 0.f;
#pragma unroll
      for (int b = 0; b < 4; ++b) { acc[0][b][r] *= rk; s += acc[0][b][r] * acc[0][b][r]; }
      ss[r] = s;
    }
#pragma unroll
    for (int r = 0; r < 16; ++r) {
      float v = ss[r];
      v = DPP_ADD(v, 0xB1, 0xF); v = DPP_ADD(v, 0x4E, 0xF); v = DPP_ADD(v, 0x141, 0xF); v = DPP_ADD(v, 0x140, 0xF);
      ss[r] = v + __shfl_xor(v, 16, 64);
    }
    float gc[4];
#pragma unroll
    for (int b = 0; b < 4; ++b) gc[b] = gk[b * 32 + r32];
#pragma unroll
    for (int r = 0; r < 16; ++r) {
      const int row = m0 + crow(r, hi); const int seq = row / TP, rr = row % TP;
      const float rs = rsqrtf((ss[r] + rowst[row * 4 + 2]) * (1.f / 192.f) + EPS);
      u16* kd = Kd + ((long)(seq * 16 + head) * TP + rr) * 192;
#pragma unroll
      for (int b = 0; b < 4; ++b) kd[b * 32 + r32] = f2bf(acc[0][b][r] * rs * gc[b]);
      kd[128 + r32] = f2bf(kper[(long)row * 64 + r32] * rs);
      kd[160 + r32] = f2bf(kper[(long)row * 64 + 32 + r32] * rs);
    }
  } };

struct EpiMout { float* out; int g;
  DI void operator()(f32x16 (&acc)[2][2], int m0, int n0, int lane) const {
    const int r32 = lane & 31, hi = lane >> 5;
#pragma unroll
    for (int a = 0; a < 2; ++a)
#pragma unroll
      for (int r = 0; r < 16; ++r) {
        const int row = m0 + a * 32 + crow(r, hi);
        const int seq = row / TP, rr = row % TP, pos = rr - PADR, sg = g * GS + seq;
        if (pos < 16) continue;
        float* dst = out + ((long)sg * SEQ + pos - 16) * D;
#pragma unroll
        for (int b = 0; b < 2; ++b) { const int col = n0 + b * 32 + r32; dst[col] += acc[a][b][r]; }
      }
  } };

template <int WM, int WN, int MT, int NT, class Epi>
DI void gemm_phase(const u16* A, int lda, const u16* Bt, int ldb, int K, int Npad, char* lds, const Epi& epi) {
  constexpr int BM = WM * MT * 32, BN = WN * NT * 32;
  constexpr int nM = GR / BM;
  const int nN = Npad / BN, total = nM * nN;
  if (gridDim.x == 256 && nM == 65) {
    const int vb = vbid(lds), x = vb >> 5, lb = vb & 31, full = 64 * nN;
    for (int i = 0;; ++i) {
      const int L = (i * 8 + x) * 32 + lb;
      if (L >= total) break;
      int tm, tn;
      if (L < full) { const int panel = L / (4 * nN), w = L % (4 * nN); tn = w >> 2; tm = panel * 4 + (w & 3); }
      else { tm = 64; tn = L - full; }
      gemm_tile<WM, WN, MT, NT, Epi>(A, lda, Bt, ldb, K, tm * BM, tn * BN, lds, epi);
    }
  } else {
    for (int t = blockIdx.x; t < total; t += gridDim.x) {
      const int tm = t % nM, tn = t / nM;
      gemm_tile<WM, WN, MT, NT, Epi>(A, lda, Bt, ldb, K, tm * BM, tn * BN, lds, epi);
    }
  }
}

#include <hip/hip_runtime.h>
namespace pg8 {
#define PG8_LAS __attribute__((address_space(3)))
typedef unsigned short bf16_t;
typedef short bf16x8 __attribute__((ext_vector_type(8)));
typedef float f32x4 __attribute__((ext_vector_type(4)));
typedef unsigned u32x4 __attribute__((ext_vector_type(4)));
constexpr int BM = 256, BK = 64, HALF = 128, HTB = HALF * BK * 2  , STAGE_BYTES = 8 * HTB, NXCD = 8, WGM = 8;

__host__ __device__ __forceinline__ int lds_byte(int r, int c) { const int st = (r >> 4) * 2 + (c >> 5), rr = r & 15, cc = c & 31, ob = rr * 64 + cc * 2; return st * 1024 + (ob ^ (((ob >> 9) & 1) << 5)); }
__host__ __device__ __forceinline__ void stage_rc(int b, int& R, int& C) { const int st = b / 1024, sb = b % 1024, swz = sb ^ (((sb >> 9) & 1) << 5); R = (st >> 1) * 16 + swz / 64; C = (st & 1) * 32 + (swz % 64) / 2; }
__host__ __device__ __forceinline__ int perm32(int rho) { const int n = rho >> 4, i = rho & 15; return 8 * (i >> 2) + 4 * n + (i & 3); }

struct Unit { int pm, pn; };
struct Gemm { const bf16_t* A; const bf16_t* Bt; int M, N, K; };

struct StaticOrder {
    int nM, nN, nwg, G, c;
    __host__ __device__ void init(int M, int N, int G_, int c_) { nM = M / BM; nN = N / BM; nwg = nM * nN; G = G_; c = c_; }
    __host__ __device__ bool next(int i, Unit& u) const {
        const long L = (long)i * G + c; if (L >= nwg) return false;
        int wgid = (int)L; { const int q = nwg / NXCD, r = nwg % NXCD, xcd = wgid % NXCD, off = wgid / NXCD; wgid = (xcd < r ? xcd * (q + 1) : r * (q + 1) + (xcd - r) * q) + off; }
        const int nig = WGM * nN, gid = wgid / nig, fm = gid * WGM, gsz = (nM - fm) < WGM ? (nM - fm) : WGM;
        u.pm = fm + ((wgid % nig) % gsz); u.pn = (wgid % nig) / gsz; return true;
    }
    __device__ __forceinline__ void a_ready(const Unit&) const {}
    __device__ __forceinline__ void done(const Unit&) const {}
};

struct EpiGinT { static constexpr bool PERM = true, AFTER_DRAIN = false; u16 *P, *HALO, *Z; float* BA;
  DI void operator()(const f32x4 (&acc)[2][2][4][2], const Unit& u, int wr, int wc, int fr, int fq) const {
#pragma unroll
    for (int ai = 0; ai < 2; ++ai)
#pragma unroll
      for (int m = 0; m < 4; ++m) { const int row = u.pm * 256 + ai * 128 + wr * 64 + m * 16 + fr; const int rm = row & 63;
#pragma unroll
        for (int bj = 0; bj < 2; ++bj) { const int col = u.pn * 256 + bj * 128 + wc * 32 + 8 * fq; const f32x4 v0 = acc[ai][bj][m][0], v1 = acc[ai][bj][m][1];
          if (col < 6144) { ::u32x4 w = {pk2(v0[0], v0[1]), pk2(v0[2], v0[3]), pk2(v1[0], v1[1]), pk2(v1[2], v1[3])};
            if (col < 4096) { *(::u32x4*)(P + (long)row * 4096 + col) = w;
              if (rm < 2 || rm >= 62) *(::u32x4*)(HALO + ((long)(row >> 6) * 4 + (rm < 2 ? rm : rm - 60)) * 4096 + col) = w; }
            else *(::u32x4*)(Z + (long)row * 2048 + col - 4096) = w; }
          else if (col < GIN) { float* d = BA + (long)row * 32 + col - 6144; *(f32x4*)d = v0; *(f32x4*)(d + 4) = v1; } } }
  } };
struct EpiMinT { static constexpr bool PERM = true, AFTER_DRAIN = false; u16 *CQ, *CKV, *Z; float* KPE;
  DI void operator()(const f32x4 (&acc)[2][2][4][2], const Unit& u, int wr, int wc, int fr, int fq) const {
#pragma unroll
    for (int ai = 0; ai < 2; ++ai)
#pragma unroll
      for (int m = 0; m < 4; ++m) { const int row = u.pm * 256 + ai * 128 + wr * 64 + m * 16 + fr;
#pragma unroll
        for (int bj = 0; bj < 2; ++bj) { const int col = u.pn * 256 + bj * 128 + wc * 32 + 8 * fq; const f32x4 v0 = acc[ai][bj][m][0], v1 = acc[ai][bj][m][1];
          ::u32x4 w = {pk2(v0[0], v0[1]), pk2(v0[2], v0[3]), pk2(v1[0], v1[1]), pk2(v1[2], v1[3])};
          if (col < 512) *(::u32x4*)(CQ + (long)row * 512 + col) = w;
          else if (col < 768) *(::u32x4*)(CKV + (long)row * 256 + col - 512) = w;
          else if (col < 832) { float* d = KPE + (long)row * 64 + col - 768; *(f32x4*)d = v0; *(f32x4*)(d + 4) = v1; }
          else if (col < MIN_) *(::u32x4*)(Z + (long)row * 2048 + col - 832) = w; } }
  } };
struct EpiGoutT { static constexpr bool PERM = false, AFTER_DRAIN = false; Params p; int g; float* h1m;
  DI void operator()(const f32x4 (&acc)[2][2][4][2], const Unit& u, int wr, int wc, int fr, int fq) const {
#pragma unroll
    for (int ai = 0; ai < 2; ++ai)
#pragma unroll
      for (int m = 0; m < 4; ++m) { const int row = u.pm * 256 + ai * 128 + wr * 64 + m * 16 + fr;
        const int seq = row / TP, rr = row % TP, pos = rr - PADR, sg = g * GS + seq;
        if (pos < 0) continue;
        const float* h0 = h0_row(p, sg, pos);
        float* dst = pos < 16 ? h1m + ((long)sg * 16 + pos) * D : p.out + ((long)sg * SEQ + pos - 16) * D;
#pragma unroll
        for (int bj = 0; bj < 2; ++bj)
#pragma unroll
          for (int n = 0; n < 2; ++n) { const int col = u.pn * 256 + bj * 128 + wc * 32 + 16 * n + 4 * fq;
            *(f32x4*)(dst + col) = *(const f32x4*)(h0 + col) + acc[ai][bj][m][n]; } }
  } };
struct EpiMoutT { static constexpr bool PERM = false, AFTER_DRAIN = false; float* out; int g;
  DI void operator()(const f32x4 (&acc)[2][2][4][2], const Unit& u, int wr, int wc, int fr, int fq) const {
#pragma unroll
    for (int ai = 0; ai < 2; ++ai)
#pragma unroll
      for (int m = 0; m < 4; ++m) { const int row = u.pm * 256 + ai * 128 + wr * 64 + m * 16 + fr;
        float* dst = out + ((long)(g * GS) * SEQ + row) * D;
#pragma unroll
        for (int bj = 0; bj < 2; ++bj)
#pragma unroll
          for (int n = 0; n < 2; ++n) { const int col = u.pn * 256 + bj * 128 + wc * 32 + 16 * n + 4 * fq;
            *(f32x4*)(dst + col) = *(const f32x4*)(dst + col) + acc[ai][bj][m][n]; } }
  } };

template <class Epi, class Sched, bool STAMP = false>
__device__ __forceinline__ void gemm_phase(PG8_LAS unsigned char* lds, const Gemm g, const Sched& S, const Epi& E, unsigned long long* stamps) {
    const int tid = otid(), wid = __builtin_amdgcn_readfirstlane(tid >> 6), lane = tid & 63, wr = wid >> 2, wc = wid & 3, fr = lane & 15, fq = lane >> 4;
    const int K = g.K, nt = K / BK;
    int ts_lo = 0, ts_hi = 0, nts = 0; const unsigned long long rt_entry = STAMP ? (unsigned long long)wall_clock64() : 0ull;
#define PG8_STAMP() do { if (STAMP && wid == 0 && nts < 64) { const unsigned long long _c = (unsigned long long)clock64(); \
        ts_lo = (lane == nts) ? (int)(unsigned)_c : ts_lo; ts_hi = (lane == nts) ? (int)(unsigned)(_c >> 32) : ts_hi; ++nts; } } while (0)
    PG8_STAMP();
    unsigned voffA[2], voffB[2];
#pragma unroll
    for (int i = 0; i < 2; ++i) { int R, C; stage_rc(tid * 16 + i * 8192, R, C); const int Rb = Epi::PERM ? ((R & ~31) + perm32(R & 31)) : R;
        voffA[i] = (unsigned)(R * K + C) * 2u; voffB[i] = (unsigned)(Rb * K + C) * 2u; }
    const size_t kstep = (size_t)(BK * 2);
    const size_t hstep = (size_t)HALF * K * 2;
    const size_t tstep = 2 * hstep;
    const unsigned ldsw = (unsigned)wid * 1024u;
    const int aoff = lds_byte(wr * 64 + fr, fq * 8), boff = lds_byte(wc * 32 + fr, fq * 8);
#define PG8_SA(b, h) (((b) * 2 + (h)) * HTB)
#define PG8_SB(b, h) ((4 + (b) * 2 + (h)) * HTB)
#define PG8_STAGE(bufoff, gbase, voff) do { _Pragma("unroll") for (int _i = 0; _i < 2; ++_i) \
        __builtin_amdgcn_global_load_lds((const unsigned*)((const char*)(gbase) + (voff)[_i]), (PG8_LAS unsigned*)(lds + (bufoff) + ldsw + _i * 8192), 16, 0, 0); } while (0)
#define PG8_LDA(dst, b, h) do { _Pragma("unroll") for (int m = 0; m < 4; ++m) _Pragma("unroll") for (int k = 0; k < 2; ++k) dst[m][k] = *(const PG8_LAS bf16x8*)(lds + PG8_SA(b, h) + aoff + m * 2048 + k * 1024); } while (0)
#define PG8_LDB(dst, b, h) do { _Pragma("unroll") for (int n = 0; n < 2; ++n) _Pragma("unroll") for (int k = 0; k < 2; ++k) dst[n][k] = *(const PG8_LAS bf16x8*)(lds + PG8_SB(b, h) + boff + n * 2048 + k * 1024); } while (0)
#define PG8_MMA(ai, bj, At, Bt) do { __builtin_amdgcn_s_setprio(1); _Pragma("unroll") for (int m = 0; m < 4; ++m) _Pragma("unroll") for (int n = 0; n < 2; ++n) _Pragma("unroll") for (int k = 0; k < 2; ++k) \
        acc[ai][bj][m][n] = __builtin_amdgcn_mfma_f32_16x16x32_bf16(Bt[n][k], At[m][k], acc[ai][bj][m][n], 0, 0, 0); __builtin_amdgcn_s_setprio(0); } while (0)
#define PG8_WAIT_V(n) asm volatile("s_waitcnt vmcnt(" #n ")" ::: "memory")
#define PG8_WAIT_L(n) asm volatile("s_waitcnt lgkmcnt(" #n ")" ::: "memory")
#define PG8_BAR __builtin_amdgcn_s_barrier()
#define PG8_SCHED __builtin_amdgcn_sched_barrier(0)
    Unit cur, nxt; int ui = 0;
    if (!S.next(0, cur)) return;
    f32x4 acc[2][2][4][2];
#pragma unroll
    for (int a = 0; a < 2; ++a)
#pragma unroll
        for (int b = 0; b < 2; ++b)
#pragma unroll
            for (int m = 0; m < 4; ++m)
#pragma unroll
                for (int n = 0; n < 2; ++n) acc[a][b][m][n] = (f32x4){0.f, 0.f, 0.f, 0.f};
    bf16x8 At[4][2], B0[2][2], B1[2][2];
    const char* cA = (const char*)g.A + (size_t)cur.pm * tstep; const char* cB = (const char*)g.Bt + (size_t)cur.pn * tstep;
    S.a_ready(cur);
    PG8_STAGE(PG8_SB(0, 0), cB, voffB); PG8_STAGE(PG8_SA(0, 0), cA, voffA); PG8_STAGE(PG8_SB(0, 1), cB + hstep, voffB); PG8_STAGE(PG8_SA(0, 1), cA + hstep, voffA);
    if (wr == 1) PG8_BAR;
    PG8_WAIT_V(4); PG8_BAR;
    PG8_STAGE(PG8_SB(1, 0), cB + kstep, voffB); PG8_STAGE(PG8_SA(1, 0), cA + kstep, voffA); PG8_STAGE(PG8_SB(1, 1), cB + hstep + kstep, voffB);
    PG8_WAIT_V(6); PG8_BAR;
    PG8_STAMP();
    for (;;) {
        const bool has_next = S.next(ui + 1, nxt);
        const char* nA = has_next ? (const char*)g.A + (size_t)nxt.pm * tstep : cA; const char* nB = has_next ? (const char*)g.Bt + (size_t)nxt.pn * tstep : cB;
        for (int t = 0; t < nt; t += 2) {
            const bool last = (t == nt - 2);
            const char* a1 = cA + (size_t)(t + 1) * kstep;
            const char* a2 = last ? nA : cA + (size_t)(t + 2) * kstep; const char* b2 = last ? nB : cB + (size_t)(t + 2) * kstep;
            const char* a3 = a2 + kstep; const char* b3 = b2 + kstep;
            if (last && has_next) S.a_ready(nxt);
            PG8_LDB(B0, 0, 0); PG8_SCHED; PG8_LDA(At, 0, 0); PG8_STAGE(PG8_SA(1, 1), a1 + hstep, voffA);
            PG8_WAIT_L(8); PG8_BAR; PG8_WAIT_L(0); PG8_MMA(0, 0, At, B0); PG8_BAR; PG8_SCHED;
            PG8_LDB(B1, 0, 1); PG8_STAGE(PG8_SB(0, 0), b2, voffB);
            PG8_BAR; PG8_WAIT_L(0); PG8_MMA(0, 1, At, B1); PG8_BAR;
            PG8_LDA(At, 0, 1); PG8_STAGE(PG8_SA(0, 0), a2, voffA);
            PG8_BAR; PG8_WAIT_L(0); PG8_MMA(1, 0, At, B0); PG8_BAR; PG8_SCHED;
            PG8_STAGE(PG8_SB(0, 1), b2 + hstep, voffB);
            PG8_WAIT_V(6); PG8_BAR; PG8_MMA(1, 1, At, B1); PG8_BAR;
            PG8_LDB(B0, 1, 0); PG8_SCHED; PG8_LDA(At, 1, 0); PG8_STAGE(PG8_SA(0, 1), a2 + hstep, voffA);
            PG8_WAIT_L(8); PG8_BAR; PG8_WAIT_L(0); PG8_MMA(0, 0, At, B0); PG8_BAR; PG8_SCHED;
            PG8_LDB(B1, 1, 1); PG8_STAGE(PG8_SB(1, 0), b3, voffB);
            PG8_BAR; PG8_WAIT_L(0); PG8_MMA(0, 1, At, B1); PG8_BAR;
            PG8_LDA(At, 1, 1); PG8_STAGE(PG8_SA(1, 0), a3, voffA);
            PG8_BAR; PG8_WAIT_L(0); PG8_MMA(1, 0, At, B0); PG8_BAR; PG8_SCHED;
            PG8_STAGE(PG8_SB(1, 1), b3 + hstep, voffB);
            PG8_WAIT_V(6); PG8_BAR; PG8_MMA(1, 1, At, B1); PG8_BAR;
        }
        PG8_STAMP();
        if constexpr (!Epi::AFTER_DRAIN) { E(acc, cur, wr, wc, fr, fq); S.done(cur); }
        PG8_STAMP();
        if (!has_next) break;
#pragma unroll
        for (int a = 0; a < 2; ++a)
#pragma unroll
            for (int b = 0; b < 2; ++b)
#pragma unroll
                for (int m = 0; m < 4; ++m)
#pragma unroll
                    for (int n = 0; n < 2; ++n) acc[a][b][m][n] = (f32x4){0.f, 0.f, 0.f, 0.f};
        cur = nxt; cA = nA; cB = nB; ++ui;
    }
    PG8_WAIT_V(0);
    if (wr == 0) PG8_BAR;
    PG8_BAR;
    if constexpr (Epi::AFTER_DRAIN) { E.fused(acc, cur, wr, wc, fr, fq, lds, wid, lane); S.done(cur); }
    PG8_STAMP();
    if (STAMP && wid == 0) { stamps[lane] = lane < nts ? (((unsigned long long)(unsigned)ts_hi << 32) | (unsigned)ts_lo) : 0ull;
        if (lane == 62) stamps[62] = rt_entry; if (lane == 63) stamps[63] = (unsigned long long)wall_clock64(); }
#undef PG8_STAMP
#undef PG8_SA
#undef PG8_SB
#undef PG8_STAGE
#undef PG8_LDA
#undef PG8_LDB
#undef PG8_MMA
#undef PG8_WAIT_V
#undef PG8_WAIT_L
#undef PG8_BAR
#undef PG8_SCHED
}
}

#define LDM4(X, ROW0, B) do { \
    asm volatile("ds_read_b128 %0, %1 offset:%2" : "=v"(X##0) : "v"(mbase), "n"(((ROW0) + 0) * 256 + (B) * 4) : "memory"); \
    asm volatile("ds_read_b128 %0, %1 offset:%2" : "=v"(X##1) : "v"(mbase), "n"(((ROW0) + 1) * 256 + (B) * 4) : "memory"); \
    asm volatile("ds_read_b128 %0, %1 offset:%2" : "=v"(X##2) : "v"(mbase), "n"(((ROW0) + 2) * 256 + (B) * 4) : "memory"); \
    asm volatile("ds_read_b128 %0, %1 offset:%2" : "=v"(X##3) : "v"(mbase), "n"(((ROW0) + 3) * 256 + (B) * 4) : "memory"); } while (0)
#define WAITM(N, X) asm volatile("s_waitcnt lgkmcnt(" #N ")" : "+v"(X##0), "+v"(X##1), "+v"(X##2), "+v"(X##3) :: "memory")
#define FMA4(X, B) do { \
    c0 = fmaf(-X##0[0], t[(B)], c0); c1 = fmaf(-X##1[0], t[(B)], c1); c2 = fmaf(-X##2[0], t[(B)], c2); c3 = fmaf(-X##3[0], t[(B)], c3); \
    c0 = fmaf(-X##0[1], t[(B) + 1], c0); c1 = fmaf(-X##1[1], t[(B) + 1], c1); c2 = fmaf(-X##2[1], t[(B) + 1], c2); c3 = fmaf(-X##3[1], t[(B) + 1], c3); \
    c0 = fmaf(-X##0[2], t[(B) + 2], c0); c1 = fmaf(-X##1[2], t[(B) + 2], c1); c2 = fmaf(-X##2[2], t[(B) + 2], c2); c3 = fmaf(-X##3[2], t[(B) + 2], c3); \
    c0 = fmaf(-X##0[3], t[(B) + 3], c0); c1 = fmaf(-X##1[3], t[(B) + 3], c1); c2 = fmaf(-X##2[3], t[(B) + 3], c2); c3 = fmaf(-X##3[3], t[(B) + 3], c3); } while (0)
template <int KB, int JB> struct SolveStep {
  static DI void run(float (&t)[64], int mbase, float& c0, float& c1, float& c2, float& c3, f32x4& A0, f32x4& A1, f32x4& A2, f32x4& A3, f32x4& B0, f32x4& B1, f32x4& B2, f32x4& B3) {
    if constexpr (JB < KB) {
      if constexpr (JB + 1 < KB) { LDM4(B, KB * 4, (JB + 1) * 4); WAITM(4, A); } else { WAITM(0, A); }
      FMA4(A, JB * 4);
      SolveStep<KB, JB + 1>::run(t, mbase, c0, c1, c2, c3, B0, B1, B2, B3, A0, A1, A2, A3);
    }
  }
};
template <int KB> DI void solve_block_r(float (&t)[64], int mbase, int lane) {
  constexpr int a0 = KB * 4;
  float c0 = (a0 + 0 == lane) ? 1.f : 0.f, c1 = (a0 + 1 == lane) ? 1.f : 0.f, c2 = (a0 + 2 == lane) ? 1.f : 0.f, c3 = (a0 + 3 == lane) ? 1.f : 0.f;
  f32x4 D0, D1, D2, D3, A0, A1, A2, A3, B0, B1, B2, B3;
  LDM4(D, a0, a0);
  if constexpr (KB > 0) { LDM4(A, a0, 0); }
  SolveStep<KB, 0>::run(t, mbase, c0, c1, c2, c3, A0, A1, A2, A3, B0, B1, B2, B3);
  WAITM(0, D);
  c1 = fmaf(-D1[0], c0, c1);
  c2 = fmaf(-D2[0], c0, c2); c2 = fmaf(-D2[1], c1, c2);
  c3 = fmaf(-D3[0], c0, c3); c3 = fmaf(-D3[1], c1, c3); c3 = fmaf(-D3[2], c2, c3);
  t[a0] = c0; t[a0 + 1] = c1; t[a0 + 2] = c2; t[a0 + 3] = c3;
}

DI void phase_chunk(const Params& p, char* lds) {
  u16* P = (u16*)(p.ws + OFF_P); const u16* HALO = (const u16*)(p.ws + OFF_HALO);
  const float* BA = (const float*)(p.ws + OFF_BA); float* SCg = (float*)(p.ws + OFF_SC);
  u16* TQg = (u16*)(p.ws + OFF_TQ); u16* KTg = (u16*)(p.ws + OFF_KT);
  char* Qs = lds; char* Ks = lds + 16384; float* M0 = (float*)(lds + 32768);
  float* sbeta = (float*)(lds + 98304); float* sg = sbeta + 128; float* sgc = sg + 128;
  const int tid0 = otid();
  for (int item = blockIdx.x; item < GS * 8 * NCHUNK; item += gridDim.x) {
    int tid = tid0; asm volatile("" : "+v"(tid));
    const int lane = tid & 63, wid = tid >> 6, cp = tid & 255, rh = tid >> 8, part = (tid >> 6) & 3;
    const int ch = cp * 2;
    const int chunk = item % NCHUNK, h = (item / NCHUNK) % 8, seq = item / (NCHUNK * 8);
    const int col = ch < 128 ? h * 128 + ch : (ch < 256 ? 1024 + h * 128 + (ch - 128) : 2048 + h * 256 + (ch - 256));
    const int R0 = seq * TP + chunk * 64, cg_ = seq * NCHUNK + chunk;
    unsigned outv[32];
    {
      float w0[5], w1[5];
#pragma unroll
      for (int j = 0; j < 5; ++j) { w0[j] = p.g_conv[j * 4096 + col]; w1[j] = p.g_conv[j * 4096 + col + 1]; }
      unsigned x[36];
#pragma unroll
      for (int i = 0; i < 36; ++i) {
        const int rr = rh * 32 + i - 2;
        unsigned v = 0u;
        if (rr >= 0 && rr < 64) v = *(const unsigned*)(P + (long)(R0 + rr) * 4096 + col);
        else if (rr < 0) { if (cg_ > 0) v = *(const unsigned*)(HALO + ((long)(cg_ - 1) * 4 + 2 + (rr + 2)) * 4096 + col); }
        else { if (cg_ + 1 < GS * NCHUNK) v = *(const unsigned*)(HALO + ((long)(cg_ + 1) * 4 + (rr - 64)) * 4096 + col); }
        x[i] = v;
      }
#pragma unroll
      for (int o = 0; o < 32; ++o) {
        float a0 = 0.f, a1 = 0.f;
#pragma unroll
        for (int j = 0; j < 5; ++j) { a0 += w0[j] * bflo(x[o + j]); a1 += w1[j] * bfhi(x[o + j]); }
        a0 = silu(a0); a1 = silu(a1);
        if (part < 2) {
          float ss = wave_sum(a0 * a0 + a1 * a1);
          float sc = rsqrtf(ss + EPS) * (part == 0 ? 0.08838834764831845f : 1.f);
          a0 *= sc; a1 *= sc;
        }
        const int row = rh * 32 + o;
        if (chunk == 0 && row < PADR) { a0 = 0.f; a1 = 0.f; }
        outv[o] = pk2(a0, a1);
        if ((o & 3) == 3) SBAR();
      }
    }
    __syncthreads();
#pragma unroll
    for (int o = 0; o < 32; ++o) *(unsigned*)(P + (long)(R0 + rh * 32 + o) * 4096 + col) = outv[o];
    if (part < 2) {
      char* dstT = part == 0 ? Qs : Ks; const int chl = ch - part * 128;
#pragma unroll
      for (int o = 0; o < 32; ++o) { const int row = rh * 32 + o;
        *(unsigned*)(dstT + row * 256 + ((((chl >> 3) ^ (row & 7))) << 4) + (chl & 7) * 2) = outv[o]; }
      if (part == 1) {
        u16* kt = KTg + ((long)(seq * 8 + h) * NCHUNK + chunk) * 8192 + (long)chl * 64 + rh * 32;
#pragma unroll
        for (int q4 = 0; q4 < 4; ++q4) {
          u32x4 lo, hi4;
#pragma unroll
          for (int e = 0; e < 4; ++e) { const unsigned a = outv[q4 * 8 + 2 * e], b = outv[q4 * 8 + 2 * e + 1];
            lo[e] = (a & 0xffffu) | (b << 16); hi4[e] = (a >> 16) | (b & 0xffff0000u); }
          *(u32x4*)(kt + q4 * 8) = lo; *(u32x4*)(kt + 64 + q4 * 8) = hi4;
          SBAR();
        }
      }
    }
    if (tid < 128) {
      const int r = tid & 63, dir = tid >> 6; const long row = R0 + r;
      const float b = BA[row * 32 + dir * 8 + h], a = BA[row * 32 + 16 + dir * 8 + h];
      float beta = 1.f / (1.f + __expf(-b));
      float xx = a + p.g_dtb[dir * 8 + h];
      float sp = xx > 20.f ? xx : __logf(1.f + __expf(xx));
      float gg = -__expf(p.g_alog[dir * 8 + h]) * sp;
      if (chunk == 0 && r < PADR) { beta = 0.f; gg = 0.f; }
      float gc = gg;
#pragma unroll
      for (int off = 1; off < 64; off <<= 1) {
        const float up = __shfl_up(gc, off, 64), dn = __shfl_down(gc, off, 64);
        if (dir == 0) { if (r >= off) gc += up; } else { if (r + off < 64) gc += dn; }
      }
      const float gl = __shfl(gc, dir == 0 ? 63 : 0, 64);
      sbeta[dir * 64 + r] = beta; sgc[dir * 64 + r] = gc;
      f32x4 st = {beta, __expf(gc), __expf(gl - gc), __expf(gl)};
      *(f32x4*)(SCg + ((long)((seq * 8 + h) * 2 + dir) * TP + chunk * 64 + r) * 4) = st;
    }
    __syncthreads();
    {
      const int kind = wid >> 2, qi = (wid >> 1) & 1, qj = wid & 1;
      int r32 = lane & 31, hi = lane >> 5;
      asm volatile("" : "+v"(r32), "+v"(hi));
      const char* At = kind ? Qs : Ks;
      f32x16 acc;
#pragma unroll
      for (int r = 0; r < 16; ++r) acc[r] = 0.f;
#pragma unroll
      for (int ks = 0; ks < 8; ++ks) {
        const int c = ks * 2 + hi; const int ra = qi * 32 + r32, rb = qj * 32 + r32;
        bf16x8 af = *(const bf16x8*)(At + ra * 256 + ((c ^ (ra & 7)) << 4));
        bf16x8 bfr = *(const bf16x8*)(Ks + rb * 256 + ((c ^ (rb & 7)) << 4));
        acc = __builtin_amdgcn_mfma_f32_32x32x16_bf16(af, bfr, acc, 0, 0, 0);
        if (ks & 1) SBAR();
      }
      const int j = qj * 32 + r32;
      u16* Ag0 = TQg + ((long)((seq * 8 + h) * 2 + 0) * NCHUNK + chunk) * 8192 + 4096;
      u16* Ag1 = TQg + ((long)((seq * 8 + h) * 2 + 1) * NCHUNK + chunk) * 8192 + 4096;
      const float gj0 = sgc[j], gj1 = sgc[64 + j];
#pragma unroll
      for (int r = 0; r < 16; ++r) {
        const int i = qi * 32 + crow(r, hi);
        const float e0 = __expf(fminf(sgc[i] - gj0, 0.f)), e1 = __expf(fminf(sgc[64 + i] - gj1, 0.f));
        if (kind == 0) {
          M0[i * 64 + j] = j < i ? sbeta[i] * acc[r] * e0 : 0.f;
          M0[4096 + (63 - i) * 64 + (63 - j)] = j > i ? sbeta[64 + i] * acc[r] * e1 : 0.f;
        } else {
          Ag0[i * 64 + j] = f2bf(j <= i ? acc[r] * e0 : 0.f);
          Ag1[i * 64 + j] = f2bf(j >= i ? acc[r] * e1 : 0.f);
        }
        SBAR();
      }
    }
    __syncthreads();
    if (wid < 2) {
      const int d = wid; const float* M = M0 + d * 4096; float* Tl = M0 + 8192 + d * 4096;
      float t[64];
      const int mbase = (int)(uintptr_t)M;
      solve_block_r<0>(t, mbase, lane); solve_block_r<1>(t, mbase, lane); solve_block_r<2>(t, mbase, lane); solve_block_r<3>(t, mbase, lane);
      solve_block_r<4>(t, mbase, lane); solve_block_r<5>(t, mbase, lane); solve_block_r<6>(t, mbase, lane); solve_block_r<7>(t, mbase, lane);
      solve_block_r<8>(t, mbase, lane); solve_block_r<9>(t, mbase, lane); solve_block_r<10>(t, mbase, lane); solve_block_r<11>(t, mbase, lane);
      solve_block_r<12>(t, mbase, lane); solve_block_r<13>(t, mbase, lane); solve_block_r<14>(t, mbase, lane); solve_block_r<15>(t, mbase, lane);
      u16* Tg = TQg + ((long)((seq * 8 + h) * 2 + d) * NCHUNK + chunk) * 8192;
      const int tbase = d ? 63 * 64 + 63 - lane : lane, tstride = d ? -64 : 64;
#pragma unroll
      for (int a = 0; a < 64; ++a) Tg[tbase + a * tstride] = f2bf(t[a]);
    }
  }
}

DI bf16x8 pack8(f32x4 a, f32x4 b) { u32x4 w = {pk2(a[0], a[1]), pk2(a[2], a[3]), pk2(b[0], b[1]), pk2(b[2], b[3])}; return __builtin_bit_cast(bf16x8, w); }
DI bf16x8 ld_frag(const char* ptr) { u32x2 lo = *(const u32x2*)ptr; u32x2 hi = *(const u32x2*)(ptr + 32); u32x4 w = {lo[0], lo[1], hi[0], hi[1]}; return __builtin_bit_cast(bf16x8, w); }
#define MFMA16(a, b, c) __builtin_amdgcn_mfma_f32_16x16x32_bf16((a), (b), (c), 0, 0, 0)
constexpr int SB_Q = 0, SB_K = 17408, SB_KT = 34816, SB_T = 53248, SB_A = 62464, SB_V = 71680, SB_SC = 79872, SB_SIZE = 80896;

struct ScanRegs { u32x4 rq[4], rk[4], rkt[4], rt[2], ra[2], rv[2]; f32x4 rs; };
DI void scan_issue(const Params& p, int seq, int h, int dir, int dvq, int cc, int lt, ScanRegs& R) {
  const u16* P = (const u16*)(p.ws + OFF_P);
  const long R0 = (long)seq * TP + cc * 64;
  const u16* Pq = P + R0 * 4096 + h * 128; const u16* Pk = Pq + 1024; const u16* Pv = P + R0 * 4096 + 2048 + h * 256 + dvq * 64;
  const u16* KTg = (const u16*)(p.ws + OFF_KT) + ((long)(seq * 8 + h) * NCHUNK + cc) * 8192;
  const u16* Tg = (const u16*)(p.ws + OFF_TQ) + ((long)((seq * 8 + h) * 2 + dir) * NCHUNK + cc) * 8192;
  const float* SCg = (const float*)(p.ws + OFF_SC) + ((long)((seq * 8 + h) * 2 + dir) * TP + cc * 64) * 4;
#pragma unroll
  for (int i = 0; i < 4; ++i) { const int e = lt + 256 * i, row = e >> 4, c = e & 15;
    R.rq[i] = *(const u32x4*)(Pq + (long)row * 4096 + c * 8); R.rk[i] = *(const u32x4*)(Pk + (long)row * 4096 + c * 8); }
#pragma unroll
  for (int i = 0; i < 4; ++i) { const int e = lt + 256 * i, row = e >> 3, c = e & 7; R.rkt[i] = *(const u32x4*)(KTg + row * 64 + c * 8); }
#pragma unroll
  for (int i = 0; i < 2; ++i) { const int e = lt + 256 * i, row = e >> 3, c = e & 7;
    R.rt[i] = *(const u32x4*)(Tg + row * 64 + c * 8); R.ra[i] = *(const u32x4*)(Tg + 4096 + row * 64 + c * 8);
    R.rv[i] = *(const u32x4*)(Pv + (long)row * 4096 + c * 8); }
  R.rs = (f32x4){0.f, 0.f, 0.f, 0.f};
  if (lt < 64) R.rs = *(const f32x4*)(SCg + lt * 4);
}
DI void scan_commit(char* B, int lt, const ScanRegs& R) {
#pragma unroll
  for (int i = 0; i < 4; ++i) { const int e = lt + 256 * i, row = e >> 4, c = e & 15;
    *(u32x4*)(B + SB_Q + row * 272 + c * 16) = R.rq[i]; *(u32x4*)(B + SB_K + row * 272 + c * 16) = R.rk[i]; }
#pragma unroll
  for (int i = 0; i < 4; ++i) { const int e = lt + 256 * i, row = e >> 3, c = e & 7; *(u32x4*)(B + SB_KT + row * 144 + c * 16) = R.rkt[i]; }
#pragma unroll
  for (int i = 0; i < 2; ++i) { const int e = lt + 256 * i, row = e >> 3, c = e & 7;
    *(u32x4*)(B + SB_T + row * 144 + c * 16) = R.rt[i]; *(u32x4*)(B + SB_A + row * 144 + c * 16) = R.ra[i];
    *(u32x4*)(B + SB_V + row * 128 + c * 16) = R.rv[i]; }
  if (lt < 64) *(f32x4*)(B + SB_SC + lt * 16) = R.rs;
}

DI void scan_compute(f32x4 (&S)[8], const char* B, u16* __restrict__ Orow, int wid, int n, int quad) {
  const char* bK = B + SB_K + n * 272 + 8 * quad; const char* bQ = B + SB_Q + n * 272 + 8 * quad;
  const char* bT = B + SB_T + n * 144 + 8 * quad; const char* bA = B + SB_A + n * 144 + 8 * quad; const char* bKT = B + SB_KT + n * 144 + 8 * quad;
  bf16x8 fa[8], fb[8];
#define LD_KQ(F, mt) do { _Pragma("unroll") for (int ks = 0; ks < 4; ++ks) { F[ks] = ld_frag(bK + (mt) * 16 * 272 + 64 * ks); F[4 + ks] = ld_frag(bQ + (mt) * 16 * 272 + 64 * ks); } } while (0)
#define LD_64(F, base) do { _Pragma("unroll") for (int mt = 0; mt < 4; ++mt) { F[2 * mt] = ld_frag(base + mt * 16 * 144); F[2 * mt + 1] = ld_frag(base + mt * 16 * 144 + 64); } } while (0)
#define GRP() do { __builtin_amdgcn_sched_group_barrier(0x100, 8, 0); __builtin_amdgcn_sched_group_barrier(0x008, 8, 0); SBAR(); } while (0)
  bf16x8 Sb[4];
#pragma unroll
  for (int ks = 0; ks < 4; ++ks) Sb[ks] = pack8(S[2 * ks], S[2 * ks + 1]);
  f32x4 KS[4], QS[4];
#pragma unroll
  for (int mt = 0; mt < 4; ++mt) { KS[mt] = (f32x4){0.f, 0.f, 0.f, 0.f}; QS[mt] = (f32x4){0.f, 0.f, 0.f, 0.f}; }
#define MM_KQ(F, mt) do { _Pragma("unroll") for (int ks = 0; ks < 4; ++ks) { KS[mt] = MFMA16(F[ks], Sb[ks], KS[mt]); QS[mt] = MFMA16(F[4 + ks], Sb[ks], QS[mt]); } } while (0)
  LD_KQ(fa, 0); SBAR();
  LD_KQ(fb, 1); MM_KQ(fa, 0); GRP();
  LD_KQ(fa, 2); MM_KQ(fb, 1); GRP();
  LD_KQ(fb, 3); MM_KQ(fa, 2); GRP();
  LD_64(fa, bT); MM_KQ(fb, 3); GRP();
  f32x4 rhs[4], o[4]; float egl = 1.f;
#pragma unroll
  for (int mt = 0; mt < 4; ++mt)
#pragma unroll
    for (int i = 0; i < 4; ++i) {
      const int row = 16 * mt + 4 * quad + i;
      const f32x4 sc = *(const f32x4*)(B + SB_SC + row * 16);
      const float v = bf2f(*(const u16*)(B + SB_V + row * 128 + (wid * 16 + n) * 2));
      egl = sc[3];
      rhs[mt][i] = sc[0] * (v - sc[1] * KS[mt][i]);
      o[mt][i] = QS[mt][i] * sc[1];
    }
  bf16x8 Rb[2];
#pragma unroll
  for (int k2 = 0; k2 < 2; ++k2) Rb[k2] = pack8(rhs[2 * k2], rhs[2 * k2 + 1]);
  SBAR();
  f32x4 VN[4];
  LD_64(fb, bA);
#pragma unroll
  for (int mt = 0; mt < 4; ++mt) { VN[mt] = (f32x4){0.f, 0.f, 0.f, 0.f}; VN[mt] = MFMA16(fa[2 * mt], Rb[0], VN[mt]); VN[mt] = MFMA16(fa[2 * mt + 1], Rb[1], VN[mt]); }
  GRP();
  bf16x8 Vb[2], Vd[2];
#pragma unroll
  for (int k2 = 0; k2 < 2; ++k2) {
    Vb[k2] = pack8(VN[2 * k2], VN[2 * k2 + 1]);
    f32x4 e0, e1;
#pragma unroll
    for (int i = 0; i < 4; ++i) { e0[i] = *(const float*)(B + SB_SC + (32 * k2 + 4 * quad + i) * 16 + 8); e1[i] = *(const float*)(B + SB_SC + (32 * k2 + 16 + 4 * quad + i) * 16 + 8); }
    Vd[k2] = pack8(VN[2 * k2] * e0, VN[2 * k2 + 1] * e1);
  }
  SBAR();
  LD_64(fa, bKT);
#pragma unroll
  for (int mt = 0; mt < 4; ++mt) { o[mt] = MFMA16(fb[2 * mt], Vb[0], o[mt]); o[mt] = MFMA16(fb[2 * mt + 1], Vb[1], o[mt]); }
  GRP();
  LD_64(fb, bKT + 64 * 144);
#pragma unroll
  for (int t = 0; t < 4; ++t) { S[t] = S[t] * egl; S[t] = MFMA16(fa[2 * t], Vd[0], S[t]); S[t] = MFMA16(fa[2 * t + 1], Vd[1], S[t]); }
  GRP();
#pragma unroll
  for (int t = 0; t < 4; ++t) { S[4 + t] = S[4 + t] * egl; S[4 + t] = MFMA16(fb[2 * t], Vd[0], S[4 + t]); S[4 + t] = MFMA16(fb[2 * t + 1], Vd[1], S[4 + t]); }
#pragma unroll
  for (int mt = 0; mt < 4; ++mt)
#pragma unroll
    for (int i = 0; i < 4; ++i) *(u16*)((char*)B + SB_V + (16 * mt + 4 * quad + i) * 128 + (wid * 16 + n) * 2) = f2bf(o[mt][i]);
#undef LD_KQ
#undef LD_64
#undef GRP
#undef MM_KQ
}

DI void phase_scan(const Params& p, char* lds) {
  for (int item = blockIdx.x; item < GS * 8 * 2 * 4; item += gridDim.x) {
    const int tid = otid(), wid = tid >> 6, lane = tid & 63, n = lane & 15, quad = lane >> 4, lt = tid - 256;
    int dvq = item & 3, tri = item >> 2;
    if (gridDim.x == 256) { const int vb = vbid(lds), x = vb >> 5, lb = vb & 31; dvq = lb & 3; tri = x + 8 * (lb >> 2); }
    const int dir = tri & 1, h = (tri >> 1) & 7, seq = tri >> 4;
    u16* O = (u16*)(p.ws + (dir ? OFF_OB : OFF_OF)) + (long)seq * TP * 2048 + h * 256 + dvq * 64 + (wid & 3) * 16 + n;
    const int wid_s = __builtin_amdgcn_readfirstlane(wid);
#define CHK(c) (dir ? NCHUNK - 1 - (c) : (c))
    if (wid_s >= 4) {
      ScanRegs LA;
      __syncthreads();
      scan_issue(p, seq, h, dir, dvq, CHK(0), lt, LA); scan_commit(lds, lt, LA); scan_issue(p, seq, h, dir, dvq, CHK(1), lt, LA);
      __syncthreads();
      u16* Og = (u16*)(p.ws + (dir ? OFF_OB : OFF_OF)) + (long)seq * TP * 2048 + h * 256 + dvq * 64;
#define OFLUSH(Bp, cc) do { _Pragma("unroll") for (int i = 0; i < 2; ++i) { const int e = lt + 256 * i, row = e >> 3, c16 = e & 7; \
          *(u32x4*)(Og + ((long)(cc) * 64 + row) * 2048 + c16 * 8) = *(const u32x4*)((Bp) + SB_V + row * 128 + c16 * 16); } } while (0)
#pragma unroll 1
      for (int c = 0; c < NCHUNK; ++c) {
        if (c > 0) OFLUSH(lds + ((c + 1) & 1) * SB_SIZE, CHK(c - 1));
        if (c + 1 < NCHUNK) scan_commit(lds + ((c + 1) & 1) * SB_SIZE, lt, LA);
        if (c + 2 < NCHUNK) scan_issue(p, seq, h, dir, dvq, CHK(c + 2), lt, LA);
        __syncthreads();
      }
      OFLUSH(lds + ((NCHUNK - 1) & 1) * SB_SIZE, CHK(NCHUNK - 1));
#undef OFLUSH
    } else {
      f32x4 S[8];
#pragma unroll
      for (int t = 0; t < 8; ++t) S[t] = (f32x4){0.f, 0.f, 0.f, 0.f};
      __builtin_amdgcn_s_setprio(2);
      __syncthreads();
      __syncthreads();
#pragma unroll 1
      for (int c = 0; c < NCHUNK; ++c) {
        scan_compute(S, lds + (c & 1) * SB_SIZE, O + (long)CHK(c) * 64 * 2048, wid, n, quad);
        __syncthreads();
      }
      __builtin_amdgcn_s_setprio(0);
    }
#undef CHK
  }
}

DI void phase_gate(const Params& p) {
  u16* OFp = (u16*)(p.ws + OFF_OF); const u16* OBp = (const u16*)(p.ws + OFF_OB); const u16* Z = (const u16*)(p.ws + OFF_Z);
  const int lane = otid() & 63, wv = otid() >> 6;
  constexpr int UN = 4;
  for (int it0 = (blockIdx.x * 8 + wv) * UN; it0 < GR * 8; it0 += gridDim.x * 8 * UN) {
    u32x2 a[UN], b[UN], z[UN];
#pragma unroll
    for (int u = 0; u < UN; ++u) { const long off = (long)(it0 + u) * 256 + lane * 4;
      a[u] = *(const u32x2*)(OFp + off); b[u] = *(const u32x2*)(OBp + off); z[u] = *(const u32x2*)(Z + off); }
#pragma unroll
    for (int u = 0; u < UN; ++u) { const long off = (long)(it0 + u) * 256 + lane * 4;
      float o0 = bflo(a[u][0]) + bflo(b[u][0]), o1 = bfhi(a[u][0]) + bfhi(b[u][0]), o2 = bflo(a[u][1]) + bflo(b[u][1]), o3 = bfhi(a[u][1]) + bfhi(b[u][1]);
      float ss = wave_sum(o0 * o0 + o1 * o1 + o2 * o2 + o3 * o3);
      float rs = rsqrtf(ss * (1.f / 256.f) + EPS);
      u32x2 w = {pk2(o0 * rs * silu(bflo(z[u][0])), o1 * rs * silu(bfhi(z[u][0]))), pk2(o2 * rs * silu(bflo(z[u][1])), o3 * rs * silu(bfhi(z[u][1])))};
      *(u32x2*)(OFp + off) = w; }
  }
}

DI void phase_rowstats(const Params& p) {
  const u16* CQ = (const u16*)(p.ws + OFF_CQ); const u16* CKV = (const u16*)(p.ws + OFF_CKV); const float* KPE = (const float*)(p.ws + OFF_KPE);
  float* rowst = (float*)(p.ws + OFF_ROWST); float* kper = (float*)(p.ws + OFF_KPER); const float* rope = (const float*)(p.ws + OFF_ROPE);
  const int lane = otid() & 63, wv = otid() >> 6;
  for (int row = blockIdx.x * 8 + wv; row < GR; row += gridDim.x * 8) {
    u32x4 q = *(const u32x4*)(CQ + (long)row * 512 + lane * 8);
    float sq = 0.f;
#pragma unroll
    for (int j = 0; j < 4; ++j) { float a = bflo(q[j]), b = bfhi(q[j]); sq += a * a + b * b; }
    u32x2 kv = *(const u32x2*)(CKV + (long)row * 256 + lane * 4);
    float sk = 0.f;
#pragma unroll
    for (int j = 0; j < 2; ++j) { float a = bflo(kv[j]), b = bfhi(kv[j]); sk += a * a + b * b; }
    const float kp = KPE[(long)row * 64 + lane];
    sq = wave_sum(sq); sk = wave_sum(sk); const float sp = wave_sum(kp * kp);
    const float val = kp * p.m_kg[128 + lane];
    const float oth = __shfl_xor(val, 32, 64);
    int pos = row % TP - PADR; pos = pos < 0 ? 0 : pos;
    const int i = lane & 31; const float c = rope[pos * 64 + i], s = rope[pos * 64 + 32 + i];
    kper[(long)row * 64 + lane] = lane < 32 ? val * c - oth * s : val * c + oth * s;
    if (lane == 0) { f32x4 st = {rsqrtf(sq * (1.f / 512.f) + EPS), rsqrtf(sk * (1.f / 256.f) + EPS), sp, 0.f}; *(f32x4*)(rowst + (long)row * 4) = st; }
  }
}

constexpr float ATT_SCALE = 0.07216878364870322f;
constexpr float ATT_THR = 8.f;
constexpr int SHM_V = 64 * 128 * 2, SHM_K = 64 * 192 * 2;
DI int v_st(int k, int c) { const int kk = (k & ~0xC) | ((k & 4) << 1) | ((k & 8) >> 1); return ((kk >> 3) * 4 + (c >> 5)) * 512 + ((kk & 7) * 32 + (c & 31)) * 2; }
DI int v_rd_base(int lane) { return ((lane & 3) << 3) | (((lane >> 2) & 3) << 6) | (((lane >> 4) & 1) << 5) | (((lane >> 5) & 1) << 8); }
constexpr int v_rd_off(int d0, int ks, int half) { return d0 * 512 + ks * 4096 + half * 2048; }
template <int OFF> DI s16x4 tr_read(int vb) {
  s16x4 r; asm volatile("ds_read_b64_tr_b16 %0, %1 offset:%2" : "=&v"(r) : "v"(vb), "i"(OFF) : "memory"); return r;
}
#define RD8(D0, X) do { X##0 = tr_read<v_rd_off(D0, 0, 0)>(vb); X##1 = tr_read<v_rd_off(D0, 0, 1)>(vb); X##2 = tr_read<v_rd_off(D0, 1, 0)>(vb); X##3 = tr_read<v_rd_off(D0, 1, 1)>(vb); \
    X##4 = tr_read<v_rd_off(D0, 2, 0)>(vb); X##5 = tr_read<v_rd_off(D0, 2, 1)>(vb); X##6 = tr_read<v_rd_off(D0, 3, 0)>(vb); X##7 = tr_read<v_rd_off(D0, 3, 1)>(vb); } while (0)
#define PKV(L, H) (bf16x8){L[0], L[1], L[2], L[3], H[0], H[1], H[2], H[3]}
#define MM4(OD, X) do { OD = __builtin_amdgcn_mfma_f32_32x32x16_bf16(pa0, PKV(X##0, X##1), OD, 0, 0, 0); OD = __builtin_amdgcn_mfma_f32_32x32x16_bf16(pa1, PKV(X##2, X##3), OD, 0, 0, 0); \
    OD = __builtin_amdgcn_mfma_f32_32x32x16_bf16(pa2, PKV(X##4, X##5), OD, 0, 0, 0); OD = __builtin_amdgcn_mfma_f32_32x32x16_bf16(pa3, PKV(X##6, X##7), OD, 0, 0, 0); } while (0)
DI void pv_all(f32x16* o, int vb, bf16x8 pa0, bf16x8 pa1, bf16x8 pa2, bf16x8 pa3) {
  s16x4 a0, a1, a2, a3, a4, a5, a6, a7;
  RD8(0, a); asm volatile("s_waitcnt lgkmcnt(0)" ::: "memory"); SBAR(); MM4(o[0], a); SBAR();
  RD8(1, a); asm volatile("s_waitcnt lgkmcnt(0)" ::: "memory"); SBAR(); MM4(o[1], a); SBAR();
  RD8(2, a); asm volatile("s_waitcnt lgkmcnt(0)" ::: "memory"); SBAR(); MM4(o[2], a); SBAR();
  RD8(3, a); asm volatile("s_waitcnt lgkmcnt(0)" ::: "memory"); SBAR(); MM4(o[3], a); SBAR();
}
#undef RD8
#undef MM4
#undef PKV

DI void attn_item(const u16* __restrict__ Qb, const u16* __restrict__ Kh, const u16* __restrict__ Vh, int q0,
                  u16* __restrict__ Yb, const u16* __restrict__ Zb, char* lds) {
  const int tid = otid(), wid = tid >> 6, lane = tid & 63, r32 = lane & 31, hi = lane >> 5;
  char* V_lds = lds; char* K_lds = lds + 3 * SHM_V;
  float* wsf = (float*)(lds + 3 * SHM_V + 3 * SHM_K) + wid * 64; float* li_l = wsf; float* al_l = wsf + 32;
  constexpr float C = ATT_SCALE * 1.4426950408889634f;
  float m_reg = -1e30f, l_reg = 0.f;
  f32x16 o[4];
#pragma unroll
  for (int d = 0; d < 4; ++d)
#pragma unroll
    for (int r = 0; r < 16; ++r) o[d][r] = 0.f;
  bf16x8 qr[12];
  const int qrow = q0 + wid * 32 + r32;
#pragma unroll
  for (int d0 = 0; d0 < 12; ++d0) {
    bf16x8 z = {0, 0, 0, 0, 0, 0, 0, 0};
    qr[d0] = qrow < TP ? *(const bf16x8*)(Qb + (long)qrow * 192 + d0 * 16 + hi * 8) : z;
  }
  const int vb0 = (int)(uintptr_t)V_lds + v_rd_base(lane);
  int koff[3], voff[2];
#pragma unroll
  for (int i = 0; i < 3; ++i) { const int P = (wid * 3 + i) * 1024 + lane * 16, row = P / 384, b = P % 384; koff[i] = row * 192 + ((b ^ ((row & 7) << 4)) >> 1); }
#pragma unroll
  for (int i = 0; i < 2; ++i) { const int P = (wid * 2 + i) * 1024 + lane * 16, sub = P >> 9, within = P & 511;
    const int kk = (sub >> 2) * 8 + (within >> 6), k = (kk & ~0xC) | ((kk & 4) << 1) | ((kk & 8) >> 1), c = (sub & 3) * 32 + ((within & 63) >> 1);
    voff[i] = k * 128 + c; }
#define GLDS16(gp, lp) __builtin_amdgcn_global_load_lds((const unsigned*)(gp), (__attribute__((address_space(3))) unsigned*)(lp), 16, 0, 0)
#define STAGE(k0, slot) do { \
    _Pragma("unroll") for (int i = 0; i < 3; ++i) GLDS16(Kh + (long)(k0) * 192 + koff[i], K_lds + (slot) * SHM_K + (wid * 3 + i) * 1024 + lane * 16); \
    _Pragma("unroll") for (int i = 0; i < 2; ++i) GLDS16(Vh + (long)(k0) * 128 + voff[i], V_lds + (slot) * SHM_V + (wid * 2 + i) * 1024 + lane * 16); } while (0)
  constexpr int NT = TP / 64;
#define ATT_QK(slot) do { \
    _Pragma("unroll") for (int r = 0; r < 16; ++r) { p0[r] = 0.f; p1[r] = 0.f; } \
    const char* Kc = K_lds + (slot) * SHM_K; const int swz = (r32 & 7) << 4; \
    const char* Kr0 = Kc + r32 * 384; const char* Kr1 = Kc + (32 + r32) * 384; \
    _Pragma("unroll") for (int d0 = 0; d0 < 12; ++d0) { const int cb = (d0 * 16 + hi * 8) * 2; \
      bf16x8 b0 = *(const bf16x8*)(Kr0 + (cb ^ swz)); bf16x8 b1 = *(const bf16x8*)(Kr1 + (cb ^ swz)); \
      p0 = __builtin_amdgcn_mfma_f32_32x32x16_bf16(b0, qr[d0], p0, 0, 0, 0); \
      p1 = __builtin_amdgcn_mfma_f32_32x32x16_bf16(b1, qr[d0], p1, 0, 0, 0); \
      if ((d0 & 1) == 1) SBAR(); } } while (0)
#define KFLOAD(G, S)
#define ATT_MASK0() do { _Pragma("unroll") for (int r = 0; r < 16; ++r) p0[r] = -1e30f; _Pragma("unroll") for (int r = 0; r < 8; ++r) p1[r] = -1e30f; } while (0)
#define PK4(PP, BASE, OUT) do { unsigned a0 = pk2(PP[BASE + 0], PP[BASE + 1]), a1 = pk2(PP[BASE + 2], PP[BASE + 3]); \
    unsigned b0 = pk2(PP[BASE + 4], PP[BASE + 5]), b1 = pk2(PP[BASE + 6], PP[BASE + 7]); \
    auto r0 = __builtin_amdgcn_permlane32_swap(a0, b0, false, false); auto r1 = __builtin_amdgcn_permlane32_swap(a1, b1, false, false); \
    u32x4 w = {r0[0], r1[0], r0[1], r1[1]}; OUT = __builtin_bit_cast(bf16x8, w); } while (0)
#define ATT_SM() do { \
    float pmax = p0[0]; \
    _Pragma("unroll") for (int r = 1; r < 16; ++r) pmax = fmaxf(pmax, p0[r]); \
    _Pragma("unroll") for (int r = 0; r < 16; ++r) pmax = fmaxf(pmax, p1[r]); \
    { auto rr = __builtin_amdgcn_permlane32_swap(__float_as_uint(pmax), __float_as_uint(pmax), false, false); \
      pmax = fmaxf(__uint_as_float(rr[0]), __uint_as_float(rr[1])); } \
    float mn, alpha; \
    if (__all(pmax - m_reg <= ATT_THR / ATT_SCALE)) { mn = m_reg; alpha = 1.f; } \
    else { mn = fmaxf(m_reg, pmax); alpha = __builtin_amdgcn_exp2f((m_reg - mn) * C); m_reg = mn; } \
    if (__any(alpha < 1.f)) { \
      if (hi == 0) al_l[r32] = alpha; \
      asm volatile("s_waitcnt lgkmcnt(0)" ::: "memory"); \
      _Pragma("unroll") for (int r = 0; r < 16; ++r) { const float a = al_l[crow(r, hi)]; \
        _Pragma("unroll") for (int d = 0; d < 4; ++d) o[d][r] *= a; } } \
    const float mnC = -mn * C; float ps = 0.f; \
    _Pragma("unroll") for (int r = 0; r < 16; ++r) { p0[r] = __builtin_amdgcn_exp2f(fmaf(p0[r], C, mnC)); p1[r] = __builtin_amdgcn_exp2f(fmaf(p1[r], C, mnC)); ps += p0[r] + p1[r]; } \
    { auto rr = __builtin_amdgcn_permlane32_swap(__float_as_uint(ps), __float_as_uint(ps), false, false); \
      ps = __uint_as_float(rr[0]) + __uint_as_float(rr[1]); } \
    l_reg = l_reg * alpha + ps; \
    PK4(p0, 0, pa0); PK4(p0, 8, pa1); PK4(p1, 0, pa2); PK4(p1, 8, pa3); } while (0)

  __syncthreads();
  STAGE(0, 0); STAGE(64, 1);
  __syncthreads();
  f32x16 p0, p1;
  bf16x8 pa0, pa1, pa2, pa3;
  const int wid_s = __builtin_amdgcn_readfirstlane(wid);
  if (wid_s < 4) {
    ATT_QK(0); ATT_MASK0(); ATT_SM();
    int sK = 1, sV = 0, sW = 2;
#pragma unroll 1
    for (int j = 1; j < NT; ++j) {
      if (j + 1 < NT) STAGE((j + 1) * 64, sW);
      pv_all(o, vb0 + sV * SHM_V, pa0, pa1, pa2, pa3);
      ATT_QK(sK);
      ATT_SM();
      sV = sK; sK = sW; sW = (sW == 2) ? 0 : sW + 1;
      __syncthreads();
    }
    pv_all(o, vb0 + sV * SHM_V, pa0, pa1, pa2, pa3);
  } else {
    ATT_QK(0); ATT_MASK0();
    int sK = 1, sV = 0, sW = 2;
#pragma unroll 1
    for (int j = 1; j < NT; ++j) {
      if (j + 1 < NT) STAGE((j + 1) * 64, sW);
      ATT_SM();
      pv_all(o, vb0 + sV * SHM_V, pa0, pa1, pa2, pa3);
      ATT_QK(sK);
      sV = sK; sK = sW; sW = (sW == 2) ? 0 : sW + 1;
      __syncthreads();
    }
    ATT_SM();
    pv_all(o, vb0 + sV * SHM_V, pa0, pa1, pa2, pa3);
  }
#undef ATT_QK
#undef KFLOAD
#undef ATT_MASK0
#undef PK4
#undef ATT_SM
#undef STAGE
#undef GLDS16
  if (hi == 0) li_l[r32] = l_reg;
  asm volatile("s_waitcnt lgkmcnt(0)" ::: "memory");
#pragma unroll
  for (int r = 0; r < 16; ++r) {
    const int orow = q0 + wid * 32 + crow(r, hi);
    const float rl = 1.f / li_l[crow(r, hi)];
    if (orow < TP) {
#pragma unroll
      for (int d0 = 0; d0 < 4; ++d0) {
        const long off = (long)orow * 2048 + d0 * 32 + r32;
        Yb[off - 64 * 2048] = f2bf(o[d0][r] * rl * silu(bf2f(Zb[off])));
      }
    }
  }
}

DI void phase_attn(const Params& p, char* lds) {
  const u16* QM = (const u16*)(p.ws + OFF_QM); const u16* KM = (const u16*)(p.ws + OFF_KM); const u16* VM = (const u16*)(p.ws + OFF_VM);
  u16* Y = (u16*)(p.ws + OFF_Y); const u16* Z = (const u16*)(p.ws + OFF_Z);
  const int b = blockIdx.x, vb = vbid(lds), x = vb >> 5, lb = vb & 31;
  if (gridDim.x == 256) {
    for (int it = 0; it < 4; ++it) {
      const int pair = x + 8 * (2 * it + (lb >> 4)), qb = lb & 15;
      const int seq = pair >> 4, head = pair & 15;
      attn_item(QM + (long)pair * TP * 192, KM + (long)pair * TP * 192, VM + (long)pair * TP * 128, 64 + qb * 256,
                Y + (long)seq * SEQ * 2048 + head * 128, Z + (long)seq * TP * 2048 + head * 128, lds);
    }
  } else {
    for (int item = b; item < 64 * 16; item += gridDim.x) {
      const int pair = item >> 4, qb = item & 15; const int seq = pair >> 4, head = pair & 15;
      attn_item(QM + (long)pair * TP * 192, KM + (long)pair * TP * 192, VM + (long)pair * TP * 128, 64 + qb * 256,
                Y + (long)seq * SEQ * 2048 + head * 128, Z + (long)seq * TP * 2048 + head * 128, lds);
    }
  }
}

#define XB_TMO      128
#define XB_XCNT(j)  (256  + 64 * (j))
#define XB_XSUB(j)  (1280 + 64 * (j))
#define XB_XGEN(j)  (2304 + 64 * (j))
#define XB_TOP      3328
#define XB_TOPGEN   3392
#define XCD_BAR_WORDS 3456
#define XB_SPIN_CAP (1u << 18)
#define LAS __attribute__((address_space(3)))
DI unsigned xb_ld(unsigned* p)              { return __hip_atomic_load(p, __ATOMIC_RELAXED, __HIP_MEMORY_SCOPE_AGENT); }
DI unsigned xb_add(unsigned* p, unsigned v) { return __hip_atomic_fetch_add(p, v, __ATOMIC_RELAXED, __HIP_MEMORY_SCOPE_AGENT); }
DI unsigned xb_xcc_id() { return (unsigned)__builtin_amdgcn_s_getreg((3 << 11) | 20) & 0xFu; }
#define XB_SPIN(cond, bar) do { unsigned _sp = 0; while (cond) { \
    if ((++_sp & 255u) == 0u) { if (xb_ld(&(bar)[XB_TMO])) break; if (_sp > XB_SPIN_CAP) { atomicAdd(&(bar)[XB_TMO], 1u); break; } } } } while (0)
struct XcdBarrier { unsigned* bar; unsigned x; volatile LAS unsigned* st; };
DI XcdBarrier xcd_barrier_post(unsigned* bar, volatile LAS unsigned* st) {
  XcdBarrier b; b.bar = bar; b.x = xb_xcc_id(); b.st = st;
  if (__builtin_amdgcn_workitem_id_x() == 0) (void)xb_add(&bar[XB_XCNT(b.x)], 1u);
  return b;
}
DI void xcd_barrier_complete(unsigned* bar, unsigned x, unsigned& nloc, unsigned& nx) {
  const unsigned G = gridDim.x * gridDim.y * gridDim.z;
  unsigned sum, cnt, mine, sp = 0u;
  for (;;) {
    sum = 0u; cnt = 0u; mine = 0u;
#pragma unroll
    for (unsigned j = 0; j < 16; ++j) { const unsigned c = xb_ld(&bar[XB_XCNT(j)]); sum += c; cnt += (c > 0u) ? 1u : 0u; mine = (j == x) ? c : mine; }
    if (sum == G) break;
    __builtin_amdgcn_s_sleep(1);
    if ((++sp & 255u) == 0u) { if (xb_ld(&bar[XB_TMO])) break; if (sp > XB_SPIN_CAP) { atomicAdd(&bar[XB_TMO], 1u); break; } }
  }
  nloc = mine > 0u ? mine : 1u; nx = cnt > 0u ? cnt : 1u;
}
DI void xcd_barrier(const XcdBarrier& b) {
  asm volatile("s_waitcnt vmcnt(0)" ::: "memory");
  __syncthreads();
  if (__builtin_amdgcn_workitem_id_x() == 0) {
    unsigned* bar = b.bar;
    __builtin_amdgcn_s_waitcnt(0);
    unsigned nloc = b.st[0], nx = b.st[1];
    if (nloc == 0u) { xcd_barrier_complete(bar, b.x, nloc, nx); b.st[0] = nloc; b.st[1] = nx; }
    const unsigned old = xb_add(&bar[XB_XSUB(b.x)], 1u);
    const unsigned gen = old / nloc;
    if (old + 1u == (gen + 1u) * nloc) {
      __builtin_amdgcn_fence(__ATOMIC_RELEASE, "agent");
      asm volatile("s_waitcnt vmcnt(0)" ::: "memory");
      const unsigned og = xb_add(&bar[XB_TOP], 1u);
      const unsigned tg = og / nx;
      if (og + 1u == (tg + 1u) * nx) xb_add(&bar[XB_TOPGEN], 1u);
      else XB_SPIN(xb_ld(&bar[XB_TOPGEN]) == tg, bar);
      __builtin_amdgcn_fence(__ATOMIC_ACQUIRE, "agent");
      xb_add(&bar[XB_XGEN(b.x)], 1u);
      asm volatile("s_waitcnt vmcnt(0)" ::: "memory");
    } else {
      XB_SPIN(xb_ld(&bar[XB_XGEN(b.x)]) == gen, bar);
      __builtin_amdgcn_fence(__ATOMIC_ACQUIRE, "agent");
      asm volatile("s_waitcnt vmcnt(0)" ::: "memory");
    }
  }
  __syncthreads();
}

__global__ void __launch_bounds__(512) fwd_mega(Params p) {
  extern __shared__ __attribute__((aligned(16))) char lds[];
  cg::grid_group grid = cg::this_grid();
  char* ws = p.ws;
  unsigned* barw = (unsigned*)(ws + OFF_BAR);
  if (blockIdx.x == 0) for (int i = otid(); i < XCD_BAR_WORDS + 256; i += 512) barw[i] = 0u;
  volatile LAS unsigned* xst = (volatile LAS unsigned*)(lds + LDS_BYTES - 16);
  if (otid() == 0) { xst[0] = 0u; xst[1] = 0u; }
  grid.sync();
  const XcdBarrier xb = xcd_barrier_post(barw, xst);
  if (otid() == 0) { const unsigned xc = xb_xcc_id(); xst[2] = xb_add(&barw[XCD_BAR_WORDS + 16 * xc], 1u); xst[3] = blockIdx.x; }
  phase_prep(p, lds);
  for (int g = 0; g < NGRP; ++g) {
    if (g == 0) { phase_hn(p, 0, 0); xcd_barrier(xb); }
    if (g == 0) {
      if (otid() == 0) { const unsigned xc = xb_xcc_id(); unsigned base = 0;
        for (unsigned j = 0; j < 16; ++j) { const unsigned c = xb_ld(&barw[XCD_BAR_WORDS + 16 * j]); base += (j < xc) ? c : 0u; }
        xst[3] = base + xst[2]; }
      __syncthreads();
    }
    { pg8::StaticOrder so; so.init(GR, 6400, (int)gridDim.x, (gridDim.x == 256) ? ((vbid(lds) & 31) * 8 + (vbid(lds) >> 5)) : (int)blockIdx.x);
      pg8::EpiGinT e{(u16*)(ws + OFF_P), (u16*)(ws + OFF_HALO), (u16*)(ws + OFF_Z), (float*)(ws + OFF_BA)};
      pg8::gemm_phase<pg8::EpiGinT, pg8::StaticOrder, false>((PG8_LAS unsigned char*)lds, pg8::Gemm{(const u16*)(ws + OFF_HN), (const u16*)(ws + OFF_WGIN), GR, 6400, 1024}, so, e, nullptr); }
    xcd_barrier(xb);
    phase_chunk(p, lds);
    xcd_barrier(xb);
    for (int rep = 0; rep < REP_SCAN; ++rep) phase_scan(p, lds);
    xcd_barrier(xb);
    phase_gate(p);
    xcd_barrier(xb);
    { pg8::StaticOrder so; so.init(GR, 1024, (int)gridDim.x, (gridDim.x == 256) ? ((vbid(lds) & 31) * 8 + (vbid(lds) >> 5)) : (int)blockIdx.x);
      pg8::EpiGoutT e{p, g, (float*)(ws + OFF_H1M)};
      pg8::gemm_phase<pg8::EpiGoutT, pg8::StaticOrder, false>((PG8_LAS unsigned char*)lds, pg8::Gemm{(const u16*)(ws + OFF_OF), (const u16*)(ws + OFF_WGOUT), GR, 1024, 2048}, so, e, nullptr); }
    xcd_barrier(xb);
    phase_hn(p, g, 1);
    xcd_barrier(xb);
    { pg8::StaticOrder so; so.init(GR, 3072, (int)gridDim.x, (gridDim.x == 256) ? ((vbid(lds) & 31) * 8 + (vbid(lds) >> 5)) : (int)blockIdx.x);
      pg8::EpiMinT e{(u16*)(ws + OFF_CQ), (u16*)(ws + OFF_CKV), (u16*)(ws + OFF_Z), (float*)(ws + OFF_KPE)};
      pg8::gemm_phase<pg8::EpiMinT, pg8::StaticOrder, false>((PG8_LAS unsigned char*)lds, pg8::Gemm{(const u16*)(ws + OFF_HN), (const u16*)(ws + OFF_WMIN), GR, 3072, 1024}, so, e, nullptr); }
    xcd_barrier(xb);
    phase_rowstats(p);
    xcd_barrier(xb);
    { EpiQ e{(const float*)(ws + OFF_ROWST), p.m_qg, (const float*)(ws + OFF_ROPE), (u16*)(ws + OFF_QM)};
      for (int rep = 0; rep < REP_GEMM; ++rep) gemm_phase<8, 1, 1, 6>((const u16*)(ws + OFF_CQ), 512, (const u16*)(ws + OFF_WUQ), 512, 512, 3072, lds, e); }
    { EpiKV e{(const float*)(ws + OFF_ROWST), p.m_kg, (const float*)(ws + OFF_KPER), (u16*)(ws + OFF_KM), (u16*)(ws + OFF_VM)};
      for (int rep = 0; rep < REP_GEMM; ++rep) gemm_phase<8, 1, 1, 4>((const u16*)(ws + OFF_CKV), 256, (const u16*)(ws + OFF_WUKV), 256, 256, 4096, lds, e); }
    xcd_barrier(xb);
    for (int rep = 0; rep < REP_ATTN; ++rep) phase_attn(p, lds);
    xcd_barrier(xb);
    { pg8::StaticOrder so; so.init(GS * SEQ, 1024, (int)gridDim.x, (gridDim.x == 256) ? ((vbid(lds) & 31) * 8 + (vbid(lds) >> 5)) : (int)blockIdx.x);
      pg8::EpiMoutT e{p.out, g};
      pg8::gemm_phase<pg8::EpiMoutT, pg8::StaticOrder, false>((PG8_LAS unsigned char*)lds, pg8::Gemm{(const u16*)(ws + OFF_Y), (const u16*)(ws + OFF_WMOUT), GS * SEQ, 1024, 2048}, so, e, nullptr); }
    if (g + 1 < NGRP) phase_hn(p, g + 1, 0);
    xcd_barrier(xb);
  }
}

extern "C" void kernel_launch(void* const* d_in, const int* in_sizes, int n_in,
                              void* d_out, int out_size, void* d_ws, size_t ws_size,
                              hipStream_t stream) {
  static int grid_blocks = 0;
  if (!grid_blocks) {
    int dev = 0, cus = 0, per_cu = 0;
    (void)hipGetDevice(&dev);
    (void)hipDeviceGetAttribute(&cus, hipDeviceAttributeMultiprocessorCount, dev);
    (void)hipFuncSetAttribute((const void*)fwd_mega, hipFuncAttributeMaxDynamicSharedMemorySize, LDS_BYTES);
    (void)hipOccupancyMaxActiveBlocksPerMultiprocessor(&per_cu, fwd_mega, 512, LDS_BYTES);
    if (per_cu < 1) { fprintf(stderr, "occupancy query returned %d\n", per_cu); per_cu = 1; }
    if (per_cu > 1) per_cu = 1;
    grid_blocks = cus * per_cu;
  }
  if (ws_size < WS_NEED) { fprintf(stderr, "workspace too small: %zu < %zu\n", ws_size, (size_t)WS_NEED); return; }
  Params p{};
  p.xp = (const float*)d_in[0]; p.xs = (const float*)d_in[1]; p.meta = (const float*)d_in[2]; p.ln_g = (const float*)d_in[3];
  p.g_win = (const float*)d_in[4]; p.g_conv = (const float*)d_in[5]; p.g_alog = (const float*)d_in[6]; p.g_dtb = (const float*)d_in[7];
  p.g_onorm = (const float*)d_in[8]; p.g_wout = (const float*)d_in[9]; p.m_win = (const float*)d_in[10]; p.m_qn = (const float*)d_in[11];
  p.m_kvn = (const float*)d_in[12]; p.m_wuq = (const float*)d_in[13]; p.m_wukv = (const float*)d_in[14]; p.m_qg = (const float*)d_in[15];
  p.m_kg = (const float*)d_in[16]; p.m_wout = (const float*)d_in[17]; p.out = (float*)d_out; p.ws = (char*)d_ws;
  void* args[] = {&p};
  hipError_t e = hipLaunchCooperativeKernel((void*)fwd_mega, dim3(grid_blocks), dim3(512), args, LDS_BYTES, stream);
  if (e != hipSuccess) fprintf(stderr, "cooperative launch failed: %s (grid %d)\n", hipGetErrorString(e), grid_blocks);
}
```

```cpp
#include <hip/hip_runtime.h>
#include <hip/hip_cooperative_groups.h>
#include <cstdio>
#include <cstdint>
namespace cg = cooperative_groups;

typedef unsigned short u16;
typedef __bf16 bf2_t __attribute__((ext_vector_type(2)));
typedef float f2_t __attribute__((ext_vector_type(2)));
using bf16x8 = __attribute__((ext_vector_type(8))) short;
using s16x4  = __attribute__((ext_vector_type(4))) short;
using f32x16 = __attribute__((ext_vector_type(16))) float;
using f32x4  = __attribute__((ext_vector_type(4))) float;
using u32x4  = __attribute__((ext_vector_type(4))) unsigned;
using u32x2  = __attribute__((ext_vector_type(2))) unsigned;
#define DI __device__ __forceinline__
#define SBAR() __builtin_amdgcn_sched_barrier(0)

DI unsigned pk2(float a, float b) { f2_t v = {a, b}; bf2_t r = __builtin_convertvector(v, bf2_t); return __builtin_bit_cast(unsigned, r); }
DI u16 f2bf(float a) { return (u16)(pk2(a, 0.f) & 0xffffu); }
DI float bf2f(u16 v) { return __uint_as_float(((unsigned)v) << 16); }
DI float bflo(unsigned v) { return __uint_as_float(v << 16); }
DI float bfhi(unsigned v) { return __uint_as_float(v & 0xffff0000u); }
DI int otid() { int t = __builtin_amdgcn_workitem_id_x(); asm volatile("" : "+v"(t)); return t; }
DI int crow(int r, int hi) { return (r & 3) + 8 * (r >> 2) + 4 * hi; }
#define DPP_ADD(v, ctrl, rm) ((v) + __builtin_bit_cast(float, __builtin_amdgcn_update_dpp(0, __builtin_bit_cast(int, (v)), (ctrl), (rm), 0xF, false)))
DI float wave_sum(float v) {
  v = DPP_ADD(v, 0xB1, 0xF);
  v = DPP_ADD(v, 0x4E, 0xF);
  v = DPP_ADD(v, 0x141, 0xF);
  v = DPP_ADD(v, 0x140, 0xF);
  v = DPP_ADD(v, 0x142, 0xA);
  v = DPP_ADD(v, 0x143, 0xC);
  return __builtin_bit_cast(float, __builtin_amdgcn_readlane(__builtin_bit_cast(int, v), 63));
}
DI float silu(float x) { return x * __builtin_amdgcn_rcpf(1.f + __expf(-x)); }

constexpr int D = 1024, TP = 4160, GS = 4, GR = GS * TP, NGRP = 3, PADR = 48, SEQ = 4096;
constexpr int GIN = 6176, GINP = 6400, MIN_ = 2880, MINP = 3072;
constexpr float EPS = 1e-6f;
constexpr int NCHUNK = 65;

constexpr size_t al256(size_t x) { return (x + 255) / 256 * 256; }
constexpr size_t OFF_WGIN  = 0;
constexpr size_t OFF_WGOUT = OFF_WGIN  + al256((size_t)GINP * 1024 * 2);
constexpr size_t OFF_WMIN  = OFF_WGOUT + al256((size_t)1024 * 2048 * 2);
constexpr size_t OFF_WUQ   = OFF_WMIN  + al256((size_t)MINP * 1024 * 2);
constexpr size_t OFF_WUKV  = OFF_WUQ   + al256((size_t)3072 * 512 * 2);
constexpr size_t OFF_WMOUT = OFF_WUKV  + al256((size_t)4096 * 256 * 2);
constexpr size_t OFF_ROPE  = OFF_WMOUT + al256((size_t)1024 * 2048 * 2);
constexpr size_t OFF_H1M   = OFF_ROPE  + al256((size_t)4112 * 64 * 4);
constexpr size_t OFF_HN    = OFF_H1M   + al256((size_t)12 * 16 * 1024 * 4);
constexpr size_t OFF_Z     = OFF_HN    + al256((size_t)GR * 1024 * 2);
constexpr size_t OFF_R     = OFF_Z     + al256((size_t)GR * 2048 * 2);
constexpr size_t OFF_P     = OFF_R;
constexpr size_t OFF_HALO  = OFF_P     + al256((size_t)GR * 4096 * 2);
constexpr size_t OFF_BA    = OFF_HALO  + al256((size_t)(GR / 64) * 4 * 4096 * 2);
constexpr size_t OFF_SC    = OFF_BA    + al256((size_t)GR * 32 * 4);
constexpr size_t OFF_TQ    = OFF_SC    + al256((size_t)GS * 8 * 2 * TP * 16);
constexpr size_t OFF_KT    = OFF_TQ    + al256((size_t)GS * 8 * 2 * NCHUNK * 16384);
constexpr size_t OFF_OF    = OFF_KT    + al256((size_t)GS * 8 * NCHUNK * 16384);
constexpr size_t OFF_OB    = OFF_OF    + al256((size_t)GR * 2048 * 2);
constexpr size_t END_GDN   = OFF_OB    + al256((size_t)GR * 2048 * 2);
constexpr size_t OFF_CQ    = OFF_R;
constexpr size_t OFF_CKV   = OFF_CQ    + al256((size_t)GR * 512 * 2);
constexpr size_t OFF_KPE   = OFF_CKV   + al256((size_t)GR * 256 * 2);
constexpr size_t OFF_ROWST = OFF_KPE   + al256((size_t)GR * 64 * 4);
constexpr size_t OFF_KPER  = OFF_ROWST + al256((size_t)GR * 4 * 4);
constexpr size_t OFF_QM    = OFF_KPER  + al256((size_t)GR * 64 * 4);
constexpr size_t OFF_KM    = OFF_QM    + al256((size_t)GR * 16 * 192 * 2);
constexpr size_t OFF_VM    = OFF_KM    + al256((size_t)GR * 16 * 192 * 2);
constexpr size_t OFF_Y     = OFF_VM    + al256((size_t)GR * 16 * 128 * 2);
constexpr size_t END_MLA   = OFF_Y     + al256((size_t)GR * 2048 * 2);
constexpr size_t OFF_BAR   = END_MLA > END_GDN ? END_MLA : END_GDN;
constexpr size_t WS_NEED   = OFF_BAR + 16384;

constexpr int LDS_BYTES = 160 * 1024;
#ifndef REP_ATTN
#define REP_ATTN 1
#endif
#ifndef REP_SCAN
#define REP_SCAN 1
#endif
#ifndef REP_GEMM
#define REP_GEMM 1
#endif

struct Params {
  const float *xp, *xs, *meta, *ln_g, *g_win, *g_conv, *g_alog, *g_dtb, *g_onorm, *g_wout;
  const float *m_win, *m_qn, *m_kvn, *m_wuq, *m_wukv, *m_qg, *m_kg, *m_wout;
  float* out; char* ws;
};

DI const float* h0_row(const Params& p, int sg, int pos) {
  return pos < 16 ? p.meta + (long)pos * D
                  : (sg < 4 ? p.xp + ((long)sg * SEQ + pos - 16) * D : p.xs + ((long)(sg - 4) * SEQ + pos - 16) * D);
}

#define LASP __attribute__((address_space(3)))
DI int vbid(const char* lds) { return __builtin_amdgcn_readfirstlane((int)*(const volatile LASP unsigned*)(lds + LDS_BYTES - 4)); }

DI void transpose_cvt(const float* __restrict__ src, u16* __restrict__ dst, int K, int N, int Npad,
                      const float* __restrict__ gain, int gmod, float* lds) {
  const int tid = otid();
  const int tK = K / 64, tN = Npad / 64;
  for (int tile = blockIdx.x; tile < tK * tN; tile += gridDim.x) {
    const int tk = tile % tK, tn = tile / tK;
#pragma unroll
    for (int i = 0; i < 2; ++i) {
      int kk = (tid >> 4) + 32 * i, nn = (tid & 15) * 4;
      int k = tk * 64 + kk, n = tn * 64 + nn;
      float4 v = make_float4(0.f, 0.f, 0.f, 0.f);
      if (n < N) v = *(const float4*)(src + (long)k * N + n);
      float gsc = gain ? gain[k % gmod] : 1.f;
      lds[kk * 65 + nn + 0] = v.x * gsc; lds[kk * 65 + nn + 1] = v.y * gsc;
      lds[kk * 65 + nn + 2] = v.z * gsc; lds[kk * 65 + nn + 3] = v.w * gsc;
    }
    __syncthreads();
    {
      int n = tid >> 3, k8 = (tid & 7) * 8;
      float f[8];
#pragma unroll
      for (int j = 0; j < 8; ++j) f[j] = lds[(k8 + j) * 65 + n];
      u32x4 w = {pk2(f[0], f[1]), pk2(f[2], f[3]), pk2(f[4], f[5]), pk2(f[6], f[7])};
      *(u32x4*)(dst + (long)(tn * 64 + n) * K + tk * 64 + k8) = w;
    }
    __syncthreads();
  }
}

DI void phase_prep(const Params& p, char* lds) {
  float* l = (float*)lds;
  transpose_cvt(p.g_win, (u16*)(p.ws + OFF_WGIN), 1024, GIN, GINP, p.ln_g, 1024, l);
  transpose_cvt(p.g_wout, (u16*)(p.ws + OFF_WGOUT), 2048, 1024, 1024, p.g_onorm, 256, l);
  transpose_cvt(p.m_win, (u16*)(p.ws + OFF_WMIN), 1024, MIN_, MINP, p.ln_g + 1024, 1024, l);
  transpose_cvt(p.m_wuq, (u16*)(p.ws + OFF_WUQ), 512, 3072, 3072, p.m_qn, 512, l);
  transpose_cvt(p.m_wukv, (u16*)(p.ws + OFF_WUKV), 256, 4096, 4096, p.m_kvn, 256, l);
  transpose_cvt(p.m_wout, (u16*)(p.ws + OFF_WMOUT), 2048, 1024, 1024, nullptr, 1, l);
  float* rope = (float*)(p.ws + OFF_ROPE);
  for (int i = blockIdx.x * 512 + otid(); i < 4112 * 32; i += gridDim.x * 512) {
    int pos = i >> 5, j = i & 31;
    float inv = __builtin_amdgcn_exp2f(-(float)j * (13.287712379549449f / 32.f));
    float ang = (float)pos * inv;
    float n = rintf(ang * 0.15915494309189535f);
    float rr = fmaf(-n, 6.28318548202514648f, ang); rr = fmaf(-n, -1.7484555e-7f, rr);
    float s = __sinf(rr), c = __cosf(rr);
    rope[pos * 64 + j] = c; rope[pos * 64 + 32 + j] = s;
  }
}

DI void phase_hn(const Params& p, int g, int layer) {
  const int lane = otid() & 63, wv = otid() >> 6;
  u16* HN = (u16*)(p.ws + OFF_HN);
  const float* h1m = (const float*)(p.ws + OFF_H1M);
  for (int row = blockIdx.x * 8 + wv; row < GR; row += gridDim.x * 8) {
    int seq = row / TP, r = row % TP, pos = r - PADR, sg = g * GS + seq;
    u16* dst = HN + (long)row * D;
    if (pos < 0) {
      u32x2 z = {0u, 0u};
#pragma unroll
      for (int i = 0; i < 4; ++i) *(u32x2*)(dst + i * 256 + lane * 4) = z;
      continue;
    }
    const float* src;
    if (layer == 0) src = h0_row(p, sg, pos);
    else src = pos < 16 ? h1m + ((long)sg * 16 + pos) * D : p.out + ((long)sg * SEQ + pos - 16) * D;
    float4 v[4]; float ss = 0.f;
#pragma unroll
    for (int i = 0; i < 4; ++i) { v[i] = *(const float4*)(src + i * 256 + lane * 4); ss += v[i].x * v[i].x + v[i].y * v[i].y + v[i].z * v[i].z + v[i].w * v[i].w; }
    ss = wave_sum(ss);
    float rs = rsqrtf(ss * (1.f / 1024.f) + EPS);
#pragma unroll
    for (int i = 0; i < 4; ++i) { u32x2 w = {pk2(v[i].x * rs, v[i].y * rs), pk2(v[i].z * rs, v[i].w * rs)}; *(u32x2*)(dst + i * 256 + lane * 4) = w; }
  }
}

template <int WM, int WN, int MT, int NT, class Epi>
DI void gemm_tile(const u16* __restrict__ A, int lda, const u16* __restrict__ Bt, int ldb, int K, int m0, int n0, char* lds, const Epi& epi) {
  constexpr int BM = WM * MT * 32, BN = WN * NT * 32, NA = BM * 8 / 512, NB = BN * 8 / 512;
  static_assert(WM * WN == 8, "8 waves");
  const int tid = otid(), lane = tid & 63, wid = tid >> 6, r32 = lane & 31, hi = lane >> 5;
  const int wm = wid / WN, wn = wid % WN;
  char* As = lds; char* Bs = lds + 2 * BM * 128;
  f32x16 acc[MT][NT];
#pragma unroll
  for (int a = 0; a < MT; ++a)
#pragma unroll
    for (int b = 0; b < NT; ++b)
#pragma unroll
      for (int r = 0; r < 16; ++r) acc[a][b][r] = 0.f;
  u32x4 ra[NA], rb[NB];
  const int nk = K / 64;
#define GLOAD(kt) do { _Pragma("unroll") for (int i = 0; i < NA; ++i) { int q = tid + 512 * i; int row = q >> 3, c = q & 7; \
      ra[i] = *(const u32x4*)(A + (long)(m0 + row) * lda + (kt) * 64 + c * 8); } \
    _Pragma("unroll") for (int i = 0; i < NB; ++i) { int q = tid + 512 * i; int row = q >> 3, c = q & 7; \
      rb[i] = *(const u32x4*)(Bt + (long)(n0 + row) * ldb + (kt) * 64 + c * 8); } } while (0)
#define SWRITE(buf) do { _Pragma("unroll") for (int i = 0; i < NA; ++i) { int q = tid + 512 * i; int row = q >> 3, c = q & 7; \
      *(u32x4*)(As + (buf) * BM * 128 + row * 128 + ((c ^ (row & 7)) << 4)) = ra[i]; } \
    _Pragma("unroll") for (int i = 0; i < NB; ++i) { int q = tid + 512 * i; int row = q >> 3, c = q & 7; \
      *(u32x4*)(Bs + (buf) * BN * 128 + row * 128 + ((c ^ (row & 7)) << 4)) = rb[i]; } } while (0)
  GLOAD(0); SWRITE(0); if (nk > 1) GLOAD(1);
  __syncthreads();
  for (int kt = 0; kt < nk; ++kt) {
    const int cur = kt & 1;
#pragma unroll
    for (int ks = 0; ks < 4; ++ks) {
      bf16x8 af[MT], bfr[NT];
      const int c = ks * 2 + hi;
#pragma unroll
      for (int a = 0; a < MT; ++a) { int row = (wm * MT + a) * 32 + r32; af[a] = *(const bf16x8*)(As + cur * BM * 128 + row * 128 + ((c ^ (row & 7)) << 4)); }
#pragma unroll
      for (int b = 0; b < NT; ++b) { int row = (wn * NT + b) * 32 + r32; bfr[b] = *(const bf16x8*)(Bs + cur * BN * 128 + row * 128 + ((c ^ (row & 7)) << 4)); }
#pragma unroll
      for (int a = 0; a < MT; ++a)
#pragma unroll
        for (int b = 0; b < NT; ++b) acc[a][b] = __builtin_amdgcn_mfma_f32_32x32x16_bf16(af[a], bfr[b], acc[a][b], 0, 0, 0);
    }
    if (kt + 1 < nk) { SWRITE(cur ^ 1); if (kt + 2 < nk) GLOAD(kt + 2); }
    __syncthreads();
  }
#undef GLOAD
#undef SWRITE
  epi(acc, m0 + wm * MT * 32, n0 + wn * NT * 32, lane);
}

template <int NT> struct EpiGin { u16 *P, *HALO, *Z; float* BA;
  DI void operator()(f32x16 (&acc)[2][NT], int m0, int n0, int lane) const {
    const int r32 = lane & 31, hi = lane >> 5;
#pragma unroll
    for (int a = 0; a < 2; ++a)
#pragma unroll
      for (int b = 0; b < NT; ++b) {
        const int col = n0 + b * 32 + r32;
#pragma unroll
        for (int r = 0; r < 16; ++r) {
          const int row = m0 + a * 32 + crow(r, hi); const float v = acc[a][b][r];
          if (col < 4096) { u16 bv = f2bf(v); P[(long)row * 4096 + col] = bv; int rm = row & 63;
            if (rm < 2 || rm >= 62) HALO[((long)(row >> 6) * 4 + (rm < 2 ? rm : rm - 60)) * 4096 + col] = bv; }
          else if (col < 6144) Z[(long)row * 2048 + col - 4096] = f2bf(v);
          else if (col < GIN) BA[(long)row * 32 + col - 6144] = v;
        }
      }
  } };

struct EpiGout { Params p; int g; float* h1m;
  DI void operator()(f32x16 (&acc)[2][2], int m0, int n0, int lane) const {
    const int r32 = lane & 31, hi = lane >> 5;
#pragma unroll
    for (int a = 0; a < 2; ++a)
#pragma unroll
      for (int r = 0; r < 16; ++r) {
        const int row = m0 + a * 32 + crow(r, hi);
        const int seq = row / TP, rr = row % TP, pos = rr - PADR, sg = g * GS + seq;
        if (pos < 0) continue;
        const float* h0 = h0_row(p, sg, pos);
        float* dst = pos < 16 ? h1m + ((long)sg * 16 + pos) * D : p.out + ((long)sg * SEQ + pos - 16) * D;
#pragma unroll
        for (int b = 0; b < 2; ++b) { const int col = n0 + b * 32 + r32; dst[col] = h0[col] + acc[a][b][r]; }
      }
  } };

struct EpiMin { u16 *CQ, *CKV, *Z; float* KPE;
  DI void operator()(f32x16 (&acc)[2][2], int m0, int n0, int lane) const {
    const int r32 = lane & 31, hi = lane >> 5;
#pragma unroll
    for (int a = 0; a < 2; ++a)
#pragma unroll
      for (int b = 0; b < 2; ++b) {
        const int col = n0 + b * 32 + r32;
#pragma unroll
        for (int r = 0; r < 16; ++r) {
          const int row = m0 + a * 32 + crow(r, hi); const float v = acc[a][b][r];
          if (col < 512) CQ[(long)row * 512 + col] = f2bf(v);
          else if (col < 768) CKV[(long)row * 256 + col - 512] = f2bf(v);
          else if (col < 832) KPE[(long)row * 64 + col - 768] = v;
          else if (col < MIN_) Z[(long)row * 2048 + col - 832] = f2bf(v);
        }
      }
  } };

struct EpiQ { const float *rowst, *gq, *rope; u16* Q;
  DI void operator()(f32x16 (&acc)[1][6], int m0, int n0, int lane) const {
    const int r32 = lane & 31, hi = lane >> 5, head = n0 / 192;
    float ss[16];
#pragma unroll
    for (int r = 0; r < 16; ++r) {
      const int row = m0 + crow(r, hi); const float rq = rowst[row * 4 + 0]; float s = 0.f;
#pragma unroll
      for (int b = 0; b < 6; ++b) { acc[0][b][r] *= rq; s += acc[0][b][r] * acc[0][b][r]; }
      ss[r] = s;
    }
#pragma unroll
    for (int r = 0; r < 16; ++r) {
      float v = ss[r];
      v = DPP_ADD(v, 0xB1, 0xF); v = DPP_ADD(v, 0x4E, 0xF); v = DPP_ADD(v, 0x141, 0xF); v = DPP_ADD(v, 0x140, 0xF);
      ss[r] = v + __shfl_xor(v, 16, 64);
    }
    float gc[6];
#pragma unroll
    for (int b = 0; b < 6; ++b) gc[b] = gq[b * 32 + r32];
#pragma unroll
    for (int r = 0; r < 16; ++r) {
      const int row = m0 + crow(r, hi); const int seq = row / TP, rr = row % TP; int pos = rr - PADR; pos = pos < 0 ? 0 : pos;
      const float rs = rsqrtf(ss[r] * (1.f / 192.f) + EPS);
      const float c = rope[pos * 64 + r32], s = rope[pos * 64 + 32 + r32];
      float x[6];
#pragma unroll
      for (int b = 0; b < 6; ++b) x[b] = acc[0][b][r] * rs * gc[b];
      const float x1 = x[4] * c - x[5] * s, x2 = x[5] * c + x[4] * s; x[4] = x1; x[5] = x2;
      u16* dst = Q + ((long)(seq * 16 + head) * TP + rr) * 192;
#pragma unroll
      for (int b = 0; b < 6; ++b) dst[b * 32 + r32] = f2bf(x[b]);
    }
  } };

struct EpiKV { const float *rowst, *gk, *kper; u16 *Kd, *Vd;
  DI void operator()(f32x16 (&acc)[1][4], int m0, int n0, int lane) const {
    const int r32 = lane & 31, hi = lane >> 5, head = n0 >> 8, isv = (n0 >> 7) & 1;
    if (isv) {
#pragma unroll
      for (int r = 0; r < 16; ++r) {
        const int row = m0 + crow(r, hi); const int seq = row / TP, rr = row % TP; const float rk = rowst[row * 4 + 1];
        u16* vd = Vd + ((long)(seq * 16 + head) * TP + rr) * 128;
#pragma unroll
        for (int b = 0; b < 4; ++b) vd[b * 32 + r32] = f2bf(acc[0][b][r] * rk);
      }
      return;
    }
    float ss[16];
#pragma unroll
    for (int r = 0; r < 16; ++r) {
      const int row = m0 + crow(r, hi); const float rk = rowst[row * 4 + 1]; float s = 0.f;
#pragma unroll
      for (int b = 0; b < 4; ++b) { acc[0][b][r] *= rk; s += acc[0][b][r] * acc[0][b][r]; }
      ss[r] = s;
    }
#pragma unroll
    for (int r = 0; r < 16; ++r) {
      float v = ss[r];
      v = DPP_ADD(v, 0xB1, 0xF); v = DPP_ADD(v, 0x4E, 0xF); v = DPP_ADD(v, 0x141, 0xF); v = DPP_ADD(v, 0x140, 0xF);
      ss[r] = v + __shfl_xor(v, 16, 64);
    }
    float gc[4];
#pragma unroll
    for (int b = 0; b < 4; ++b) gc[b] = gk[b * 32 + r32];
#pragma unroll
    for (int r = 0; r < 16; ++r) {
      const int row = m0 + crow(r, hi); const int seq = row / TP, rr = row % TP;
      const float rs = rsqrtf((ss[r] + rowst[row * 4 + 2]) * (1.f / 192.f) + EPS);
      u16* kd = Kd + ((long)(seq * 16 + head) * TP + rr) * 192;
#pragma unroll
      for (int b = 0; b < 4; ++b) kd[b * 32 + r32] = f2bf(acc[0][b][r] * rs * gc[b]);
      kd[128 + r32] = f2bf(kper[(long)row * 64 + r32] * rs);
      kd[160 + r32] = f2bf(kper[(long)row * 64 + 32 + r32] * rs);
    }
  } };

struct EpiMout { float* out; int g;
  DI void operator()(f32x16 (&acc)[2][2], int m0, int n0, int lane) const {
    const int r32 = lane & 31, hi = lane >> 5;
#pragma unroll
    for (int a = 0; a < 2; ++a)
#pragma unroll
      for (int r = 0; r < 16; ++r) {
        const int row = m0 + a * 32 + crow(r, hi);
        const int seq = row / TP, rr = row % TP, pos = rr - PADR, sg = g * GS + seq;
        if (pos < 16) continue;
        float* dst = out + ((long)sg * SEQ + pos - 16) * D;
#pragma unroll
        for (int b = 0; b < 2; ++b) { const int col = n0 + b * 32 + r32; dst[col] += acc[a][b][r]; }
      }
  } };

template <int WM, int WN, int MT, int NT, class Epi>
DI void gemm_phase(const u16* A, int lda, const u16* Bt, int ldb, int K, int Npad, char* lds, const Epi& epi) {
  constexpr int BM = WM * MT * 32, BN = WN * NT * 32;
  constexpr int nM = GR / BM;
  const int nN = Npad / BN, total = nM * nN;
  if (gridDim.x == 256 && nM == 65) {
    const int vb = vbid(lds), x = vb >> 5, lb = vb & 31, full = 64 * nN;
    for (int i = 0;; ++i) {
      const int L = (i * 8 + x) * 32 + lb;
      if (L >= total) break;
      int tm, tn;
      if (L < full) { const int panel = L / (4 * nN), w = L % (4 * nN); tn = w >> 2; tm = panel * 4 + (w & 3); }
      else { tm = 64; tn = L - full; }
      gemm_tile<WM, WN, MT, NT, Epi>(A, lda, Bt, ldb, K, tm * BM, tn * BN, lds, epi);
    }
  } else {
    for (int t = blockIdx.x; t < total; t += gridDim.x) {
      const int tm = t % nM, tn = t / nM;
      gemm_tile<WM, WN, MT, NT, Epi>(A, lda, Bt, ldb, K, tm * BM, tn * BN, lds, epi);
    }
  }
}

#include <hip/hip_runtime.h>
namespace pg8 {
#define PG8_LAS __attribute__((address_space(3)))
typedef unsigned short bf16_t;
typedef short bf16x8 __attribute__((ext_vector_type(8)));
typedef float f32x4 __attribute__((ext_vector_type(4)));
typedef unsigned u32x4 __attribute__((ext_vector_type(4)));
constexpr int BM = 256, BK = 64, HALF = 128, HTB = HALF * BK * 2  , STAGE_BYTES = 8 * HTB, NXCD = 8, WGM = 8;

__host__ __device__ __forceinline__ int lds_byte(int r, int c) { const int st = (r >> 4) * 2 + (c >> 5), rr = r & 15, cc = c & 31, ob = rr * 64 + cc * 2; return st * 1024 + (ob ^ (((ob >> 9) & 1) << 5)); }
__host__ __device__ __forceinline__ void stage_rc(int b, int& R, int& C) { const int st = b / 1024, sb = b % 1024, swz = sb ^ (((sb >> 9) & 1) << 5); R = (st >> 1) * 16 + swz / 64; C = (st & 1) * 32 + (swz % 64) / 2; }
__host__ __device__ __forceinline__ int perm32(int rho) { const int n = rho >> 4, i = rho & 15; return 8 * (i >> 2) + 4 * n + (i & 3); }

struct Unit { int pm, pn; };
struct Gemm { const bf16_t* A; const bf16_t* Bt; int M, N, K; };

struct StaticOrder {
    int nM, nN, nwg, G, c;
    __host__ __device__ void init(int M, int N, int G_, int c_) { nM = M / BM; nN = N / BM; nwg = nM * nN; G = G_; c = c_; }
    __host__ __device__ bool next(int i, Unit& u) const {
        const long L = (long)i * G + c; if (L >= nwg) return false;
        int wgid = (int)L; { const int q = nwg / NXCD, r = nwg % NXCD, xcd = wgid % NXCD, off = wgid / NXCD; wgid = (xcd < r ? xcd * (q + 1) : r * (q + 1) + (xcd - r) * q) + off; }
        const int nig = WGM * nN, gid = wgid / nig, fm = gid * WGM, gsz = (nM - fm) < WGM ? (nM - fm) : WGM;
        u.pm = fm + ((wgid % nig) % gsz); u.pn = (wgid % nig) / gsz; return true;
    }
    __device__ __forceinline__ void a_ready(const Unit&) const {}
    __device__ __forceinline__ void done(const Unit&) const {}
};

struct EpiGinT { static constexpr bool PERM = true, AFTER_DRAIN = false; u16 *P, *HALO, *Z; float* BA;
  DI void operator()(const f32x4 (&acc)[2][2][4][2], const Unit& u, int wr, int wc, int fr, int fq) const {
#pragma unroll
    for (int ai = 0; ai < 2; ++ai)
#pragma unroll
      for (int m = 0; m < 4; ++m) { const int row = u.pm * 256 + ai * 128 + wr * 64 + m * 16 + fr; const int rm = row & 63;
#pragma unroll
        for (int bj = 0; bj < 2; ++bj) { const int col = u.pn * 256 + bj * 128 + wc * 32 + 8 * fq; const f32x4 v0 = acc[ai][bj][m][0], v1 = acc[ai][bj][m][1];
          if (col < 6144) { ::u32x4 w = {pk2(v0[0], v0[1]), pk2(v0[2], v0[3]), pk2(v1[0], v1[1]), pk2(v1[2], v1[3])};
            if (col < 4096) { *(::u32x4*)(P + (long)row * 4096 + col) = w;
              if (rm < 2 || rm >= 62) *(::u32x4*)(HALO + ((long)(row >> 6) * 4 + (rm < 2 ? rm : rm - 60)) * 4096 + col) = w; }
            else *(::u32x4*)(Z + (long)row * 2048 + col - 4096) = w; }
          else if (col < GIN) { float* d = BA + (long)row * 32 + col - 6144; *(f32x4*)d = v0; *(f32x4*)(d + 4) = v1; } } }
  } };
struct EpiMinT { static constexpr bool PERM = true, AFTER_DRAIN = false; u16 *CQ, *CKV, *Z; float* KPE;
  DI void operator()(const f32x4 (&acc)[2][2][4][2], const Unit& u, int wr, int wc, int fr, int fq) const {
#pragma unroll
    for (int ai = 0; ai < 2; ++ai)
#pragma unroll
      for (int m = 0; m < 4; ++m) { const int row = u.pm * 256 + ai * 128 + wr * 64 + m * 16 + fr;
#pragma unroll
        for (int bj = 0; bj < 2; ++bj) { const int col = u.pn * 256 + bj * 128 + wc * 32 + 8 * fq; const f32x4 v0 = acc[ai][bj][m][0], v1 = acc[ai][bj][m][1];
          ::u32x4 w = {pk2(v0[0], v0[1]), pk2(v0[2], v0[3]), pk2(v1[0], v1[1]), pk2(v1[2], v1[3])};
          if (col < 512) *(::u32x4*)(CQ + (long)row * 512 + col) = w;
          else if (col < 768) *(::u32x4*)(CKV + (long)row * 256 + col - 512) = w;
          else if (col < 832) { float* d = KPE + (long)row * 64 + col - 768; *(f32x4*)d = v0; *(f32x4*)(d + 4) = v1; }
          else if (col < MIN_) *(::u32x4*)(Z + (long)row * 2048 + col - 832) = w; } }
  } };
struct EpiGoutT { static constexpr bool PERM = false, AFTER_DRAIN = false; Params p; int g; float* h1m;
  DI void operator()(const f32x4 (&acc)[2][2][4][2], const Unit& u, int wr, int wc, int fr, int fq) const {
#pragma unroll
    for (int ai = 0; ai < 2; ++ai)
#pragma unroll
      for (int m = 0; m < 4; ++m) { const int row = u.pm * 256 + ai * 128 + wr * 64 + m * 16 + fr;
        const int seq = row / TP, rr = row % TP, pos = rr - PADR, sg = g * GS + seq;
        if (pos < 0) continue;
        const float* h0 = h0_row(p, sg, pos);
        float* dst = pos < 16 ? h1m + ((long)sg * 16 + pos) * D : p.out + ((long)sg * SEQ + pos - 16) * D;
#pragma unroll
        for (int bj = 0; bj < 2; ++bj)
#pragma unroll
          for (int n = 0; n < 2; ++n) { const int col = u.pn * 256 + bj * 128 + wc * 32 + 16 * n + 4 * fq;
            *(f32x4*)(dst + col) = *(const f32x4*)(h0 + col) + acc[ai][bj][m][n]; } }
  } };
struct EpiMoutT { static constexpr bool PERM = false, AFTER_DRAIN = false; float* out; int g;
  DI void operator()(const f32x4 (&acc)[2][2][4][2], const Unit& u, int wr, int wc, int fr, int fq) const {
#pragma unroll
    for (int ai = 0; ai < 2; ++ai)
#pragma unroll
      for (int m = 0; m < 4; ++m) { const int row = u.pm * 256 + ai * 128 + wr * 64 + m * 16 + fr;
        float* dst = out + ((long)(g * GS) * SEQ + row) * D;
#pragma unroll
        for (int bj = 0; bj < 2; ++bj)
#pragma unroll
          for (int n = 0; n < 2; ++n) { const int col = u.pn * 256 + bj * 128 + wc * 32 + 16 * n + 4 * fq;
            *(f32x4*)(dst + col) = *(const f32x4*)(dst + col) + acc[ai][bj][m][n]; } }
  } };

template <class Epi, class Sched, bool STAMP = false>
__device__ __forceinline__ void gemm_phase(PG8_LAS unsigned char* lds, const Gemm g, const Sched& S, const Epi& E, unsigned long long* stamps) {
    const int tid = otid(), wid = __builtin_amdgcn_readfirstlane(tid >> 6), lane = tid & 63, wr = wid >> 2, wc = wid & 3, fr = lane & 15, fq = lane >> 4;
    const int K = g.K, nt = K / BK;
    int ts_lo = 0, ts_hi = 0, nts = 0; const unsigned long long rt_entry = STAMP ? (unsigned long long)wall_clock64() : 0ull;
#define PG8_STAMP() do { if (STAMP && wid == 0 && nts < 64) { const unsigned long long _c = (unsigned long long)clock64(); \
        ts_lo = (lane == nts) ? (int)(unsigned)_c : ts_lo; ts_hi = (lane == nts) ? (int)(unsigned)(_c >> 32) : ts_hi; ++nts; } } while (0)
    PG8_STAMP();
    unsigned voffA[2], voffB[2];
#pragma unroll
    for (int i = 0; i < 2; ++i) { int R, C; stage_rc(tid * 16 + i * 8192, R, C); const int Rb = Epi::PERM ? ((R & ~31) + perm32(R & 31)) : R;
        voffA[i] = (unsigned)(R * K + C) * 2u; voffB[i] = (unsigned)(Rb * K + C) * 2u; }
    const size_t kstep = (size_t)(BK * 2);
    const size_t hstep = (size_t)HALF * K * 2;
    const size_t tstep = 2 * hstep;
    const unsigned ldsw = (unsigned)wid * 1024u;
    const int aoff = lds_byte(wr * 64 + fr, fq * 8), boff = lds_byte(wc * 32 + fr, fq * 8);
#define PG8_SA(b, h) (((b) * 2 + (h)) * HTB)
#define PG8_SB(b, h) ((4 + (b) * 2 + (h)) * HTB)
#define PG8_STAGE(bufoff, gbase, voff) do { _Pragma("unroll") for (int _i = 0; _i < 2; ++_i) \
        __builtin_amdgcn_global_load_lds((const unsigned*)((const char*)(gbase) + (voff)[_i]), (PG8_LAS unsigned*)(lds + (bufoff) + ldsw + _i * 8192), 16, 0, 0); } while (0)
#define PG8_LDA(dst, b, h) do { _Pragma("unroll") for (int m = 0; m < 4; ++m) _Pragma("unroll") for (int k = 0; k < 2; ++k) dst[m][k] = *(const PG8_LAS bf16x8*)(lds + PG8_SA(b, h) + aoff + m * 2048 + k * 1024); } while (0)
#define PG8_LDB(dst, b, h) do { _Pragma("unroll") for (int n = 0; n < 2; ++n) _Pragma("unroll") for (int k = 0; k < 2; ++k) dst[n][k] = *(const PG8_LAS bf16x8*)(lds + PG8_SB(b, h) + boff + n * 2048 + k * 1024); } while (0)
#define PG8_MMA(ai, bj, At, Bt) do { __builtin_amdgcn_s_setprio(1); _Pragma("unroll") for (int m = 0; m < 4; ++m) _Pragma("unroll") for (int n = 0; n < 2; ++n) _Pragma("unroll") for (int k = 0; k < 2; ++k) \
        acc[ai][bj][m][n] = __builtin_amdgcn_mfma_f32_16x16x32_bf16(Bt[n][k], At[m][k], acc[ai][bj][m][n], 0, 0, 0); __builtin_amdgcn_s_setprio(0); } while (0)
#define PG8_WAIT_V(n) asm volatile("s_waitcnt vmcnt(" #n ")" ::: "memory")
#define PG8_WAIT_L(n) asm volatile("s_waitcnt lgkmcnt(" #n ")" ::: "memory")
#define PG8_BAR __builtin_amdgcn_s_barrier()
#define PG8_SCHED __builtin_amdgcn_sched_barrier(0)
    Unit cur, nxt; int ui = 0;
    if (!S.next(0, cur)) return;
    f32x4 acc[2][2][4][2];
#pragma unroll
    for (int a = 0; a < 2; ++a)
#pragma unroll
        for (int b = 0; b < 2; ++b)
#pragma unroll
            for (int m = 0; m < 4; ++m)
#pragma unroll
                for (int n = 0; n < 2; ++n) acc[a][b][m][n] = (f32x4){0.f, 0.f, 0.f, 0.f};
    bf16x8 At[4][2], B0[2][2], B1[2][2];
    const char* cA = (const char*)g.A + (size_t)cur.pm * tstep; const char* cB = (const char*)g.Bt + (size_t)cur.pn * tstep;
    S.a_ready(cur);
    PG8_STAGE(PG8_SB(0, 0), cB, voffB); PG8_STAGE(PG8_SA(0, 0), cA, voffA); PG8_STAGE(PG8_SB(0, 1), cB + hstep, voffB); PG8_STAGE(PG8_SA(0, 1), cA + hstep, voffA);
    if (wr == 1) PG8_BAR;
    PG8_WAIT_V(4); PG8_BAR;
    PG8_STAGE(PG8_SB(1, 0), cB + kstep, voffB); PG8_STAGE(PG8_SA(1, 0), cA + kstep, voffA); PG8_STAGE(PG8_SB(1, 1), cB + hstep + kstep, voffB);
    PG8_WAIT_V(6); PG8_BAR;
    PG8_STAMP();
    for (;;) {
        const bool has_next = S.next(ui + 1, nxt);
        const char* nA = has_next ? (const char*)g.A + (size_t)nxt.pm * tstep : cA; const char* nB = has_next ? (const char*)g.Bt + (size_t)nxt.pn * tstep : cB;
        for (int t = 0; t < nt; t += 2) {
            const bool last = (t == nt - 2);
            const char* a1 = cA + (size_t)(t + 1) * kstep;
            const char* a2 = last ? nA : cA + (size_t)(t + 2) * kstep; const char* b2 = last ? nB : cB + (size_t)(t + 2) * kstep;
            const char* a3 = a2 + kstep; const char* b3 = b2 + kstep;
            if (last && has_next) S.a_ready(nxt);
            PG8_LDB(B0, 0, 0); PG8_SCHED; PG8_LDA(At, 0, 0); PG8_STAGE(PG8_SA(1, 1), a1 + hstep, voffA);
            PG8_WAIT_L(8); PG8_BAR; PG8_WAIT_L(0); PG8_MMA(0, 0, At, B0); PG8_BAR; PG8_SCHED;
            PG8_LDB(B1, 0, 1); PG8_STAGE(PG8_SB(0, 0), b2, voffB);
            PG8_BAR; PG8_WAIT_L(0); PG8_MMA(0, 1, At, B1); PG8_BAR;
            PG8_LDA(At, 0, 1); PG8_STAGE(PG8_SA(0, 0), a2, voffA);
            PG8_BAR; PG8_WAIT_L(0); PG8_MMA(1, 0, At, B0); PG8_BAR; PG8_SCHED;
            PG8_STAGE(PG8_SB(0, 1), b2 + hstep, voffB);
            PG8_WAIT_V(6); PG8_BAR; PG8_MMA(1, 1, At, B1); PG8_BAR;
            PG8_LDB(B0, 1, 0); PG8_SCHED; PG8_LDA(At, 1, 0); PG8_STAGE(PG8_SA(0, 1), a2 + hstep, voffA);
            PG8_WAIT_L(8); PG8_BAR; PG8_WAIT_L(0); PG8_MMA(0, 0, At, B0); PG8_BAR; PG8_SCHED;
            PG8_LDB(B1, 1, 1); PG8_STAGE(PG8_SB(1, 0), b3, voffB);
            PG8_BAR; PG8_WAIT_L(0); PG8_MMA(0, 1, At, B1); PG8_BAR;
            PG8_LDA(At, 1, 1); PG8_STAGE(PG8_SA(1, 0), a3, voffA);
            PG8_BAR; PG8_WAIT_L(0); PG8_MMA(1, 0, At, B0); PG8_BAR; PG8_SCHED;
            PG8_STAGE(PG8_SB(1, 1), b3 + hstep, voffB);
            PG8_WAIT_V(6); PG8_BAR; PG8_MMA(1, 1, At, B1); PG8_BAR;
        }
        PG8_STAMP();
        if constexpr (!Epi::AFTER_DRAIN) { E(acc, cur, wr, wc, fr, fq); S.done(cur); }
        PG8_STAMP();
        if (!has_next) break;
#pragma unroll
        for (int a = 0; a < 2; ++a)
#pragma unroll
            for (int b = 0; b < 2; ++b)
#pragma unroll
                for (int m = 0; m < 4; ++m)
#pragma unroll
                    for (int n = 0; n < 2; ++n) acc[a][b][m][n] = (f32x4){0.f, 0.f, 0.f, 0.f};
        cur = nxt; cA = nA; cB = nB; ++ui;
    }
    PG8_WAIT_V(0);
    if (wr == 0) PG8_BAR;
    PG8_BAR;
    if constexpr (Epi::AFTER_DRAIN) { E.fused(acc, cur, wr, wc, fr, fq, lds, wid, lane); S.done(cur); }
    PG8_STAMP();
    if (STAMP && wid == 0) { stamps[lane] = lane < nts ? (((unsigned long long)(unsigned)ts_hi << 32) | (unsigned)ts_lo) : 0ull;
        if (lane == 62) stamps[62] = rt_entry; if (lane == 63) stamps[63] = (unsigned long long)wall_clock64(); }
#undef PG8_STAMP
#undef PG8_SA
#undef PG8_SB
#undef PG8_STAGE
#undef PG8_LDA
#undef PG8_LDB
#undef PG8_MMA
#undef PG8_WAIT_V
#undef PG8_WAIT_L
#undef PG8_BAR
#undef PG8_SCHED
}
}

#define LDM4(X, ROW0, B) do { \
    asm volatile("ds_read_b128 %0, %1 offset:%2" : "=v"(X##0) : "v"(mbase), "n"(((ROW0) + 0) * 256 + (B) * 4) : "memory"); \
    asm volatile("ds_read_b128 %0, %1 offset:%2" : "=v"(X##1) : "v"(mbase), "n"(((ROW0) + 1) * 256 + (B) * 4) : "memory"); \
    asm volatile("ds_read_b128 %0, %1 offset:%2" : "=v"(X##2) : "v"(mbase), "n"(((ROW0) + 2) * 256 + (B) * 4) : "memory"); \
    asm volatile("ds_read_b128 %0, %1 offset:%2" : "=v"(X##3) : "v"(mbase), "n"(((ROW0) + 3) * 256 + (B) * 4) : "memory"); } while (0)
#define WAITM(N, X) asm volatile("s_waitcnt lgkmcnt(" #N ")" : "+v"(X##0), "+v"(X##1), "+v"(X##2), "+v"(X##3) :: "memory")
#define FMA4(X, B) do { \
    c0 = fmaf(-X##0[0], t[(B)], c0); c1 = fmaf(-X##1[0], t[(B)], c1); c2 = fmaf(-X##2[0], t[(B)], c2); c3 = fmaf(-X##3[0], t[(B)], c3); \
    c0 = fmaf(-X##0[1], t[(B) + 1], c0); c1 = fmaf(-X##1[1], t[(B) + 1], c1); c2 = fmaf(-X##2[1], t[(B) + 1], c2); c3 = fmaf(-X##3[1], t[(B) + 1], c3); \
    c0 = fmaf(-X##0[2], t[(B) + 2], c0); c1 = fmaf(-X##1[2], t[(B) + 2], c1); c2 = fmaf(-X##2[2], t[(B) + 2], c2); c3 = fmaf(-X##3[2], t[(B) + 2], c3); \
    c0 = fmaf(-X##0[3], t[(B) + 3], c0); c1 = fmaf(-X##1[3], t[(B) + 3], c1); c2 = fmaf(-X##2[3], t[(B) + 3], c2); c3 = fmaf(-X##3[3], t[(B) + 3], c3); } while (0)
template <int KB, int JB> struct SolveStep {
  static DI void run(float (&t)[64], int mbase, float& c0, float& c1, float& c2, float& c3, f32x4& A0, f32x4& A1, f32x4& A2, f32x4& A3, f32x4& B0, f32x4& B1, f32x4& B2, f32x4& B3) {
    if constexpr (JB < KB) {
      if constexpr (JB + 1 < KB) { LDM4(B, KB * 4, (JB + 1) * 4); WAITM(4, A); } else { WAITM(0, A); }
      FMA4(A, JB * 4);
      SolveStep<KB, JB + 1>::run(t, mbase, c0, c1, c2, c3, B0, B1, B2, B3, A0, A1, A2, A3);
    }
  }
};
template <int KB> DI void solve_block_r(float (&t)[64], int mbase, int lane) {
  constexpr int a0 = KB * 4;
  float c0 = (a0 + 0 == lane) ? 1.f : 0.f, c1 = (a0 + 1 == lane) ? 1.f : 0.f, c2 = (a0 + 2 == lane) ? 1.f : 0.f, c3 = (a0 + 3 == lane) ? 1.f : 0.f;
  f32x4 D0, D1, D2, D3, A0, A1, A2, A3, B0, B1, B2, B3;
  LDM4(D, a0, a0);
  if constexpr (KB > 0) { LDM4(A, a0, 0); }
  SolveStep<KB, 0>::run(t, mbase, c0, c1, c2, c3, A0, A1, A2, A3, B0, B1, B2, B3);
  WAITM(0, D);
  c1 = fmaf(-D1[0], c0, c1);
  c2 = fmaf(-D2[0], c0, c2); c2 = fmaf(-D2[1], c1, c2);
  c3 = fmaf(-D3[0], c0, c3); c3 = fmaf(-D3[1], c1, c3); c3 = fmaf(-D3[2], c2, c3);
  t[a0] = c0; t[a0 + 1] = c1; t[a0 + 2] = c2; t[a0 + 3] = c3;
}

DI void phase_chunk(const Params& p, char* lds) {
  u16* P = (u16*)(p.ws + OFF_P); const u16* HALO = (const u16*)(p.ws + OFF_HALO);
  const float* BA = (const float*)(p.ws + OFF_BA); float* SCg = (float*)(p.ws + OFF_SC);
  u16* TQg = (u16*)(p.ws + OFF_TQ); u16* KTg = (u16*)(p.ws + OFF_KT);
  char* Qs = lds; char* Ks = lds + 16384; float* M0 = (float*)(lds + 32768);
  float* sbeta = (float*)(lds + 98304); float* sg = sbeta + 128; float* sgc = sg + 128;
  const int tid0 = otid();
  for (int item = blockIdx.x; item < GS * 8 * NCHUNK; item += gridDim.x) {
    int tid = tid0; asm volatile("" : "+v"(tid));
    const int lane = tid & 63, wid = tid >> 6, cp = tid & 255, rh = tid >> 8, part = (tid >> 6) & 3;
    const int ch = cp * 2;
    const int chunk = item % NCHUNK, h = (item / NCHUNK) % 8, seq = item / (NCHUNK * 8);
    const int col = ch < 128 ? h * 128 + ch : (ch < 256 ? 1024 + h * 128 + (ch - 128) : 2048 + h * 256 + (ch - 256));
    const int R0 = seq * TP + chunk * 64, cg_ = seq * NCHUNK + chunk;
    unsigned outv[32];
    {
      float w0[5], w1[5];
#pragma unroll
      for (int j = 0; j < 5; ++j) { w0[j] = p.g_conv[j * 4096 + col]; w1[j] = p.g_conv[j * 4096 + col + 1]; }
      unsigned x[36];
#pragma unroll
      for (int i = 0; i < 36; ++i) {
        const int rr = rh * 32 + i - 2;
        unsigned v = 0u;
        if (rr >= 0 && rr < 64) v = *(const unsigned*)(P + (long)(R0 + rr) * 4096 + col);
        else if (rr < 0) { if (cg_ > 0) v = *(const unsigned*)(HALO + ((long)(cg_ - 1) * 4 + 2 + (rr + 2)) * 4096 + col); }
        else { if (cg_ + 1 < GS * NCHUNK) v = *(const unsigned*)(HALO + ((long)(cg_ + 1) * 4 + (rr - 64)) * 4096 + col); }
        x[i] = v;
      }
#pragma unroll
      for (int o = 0; o < 32; ++o) {
        float a0 = 0.f, a1 = 0.f;
#pragma unroll
        for (int j = 0; j < 5; ++j) { a0 += w0[j] * bflo(x[o + j]); a1 += w1[j] * bfhi(x[o + j]); }
        a0 = silu(a0); a1 = silu(a1);
        if (part < 2) {
          float ss = wave_sum(a0 * a0 + a1 * a1);
          float sc = rsqrtf(ss + EPS) * (part == 0 ? 0.08838834764831845f : 1.f);
          a0 *= sc; a1 *= sc;
        }
        const int row = rh * 32 + o;
        if (chunk == 0 && row < PADR) { a0 = 0.f; a1 = 0.f; }
        outv[o] = pk2(a0, a1);
        if ((o & 3) == 3) SBAR();
      }
    }
    __syncthreads();
#pragma unroll
    for (int o = 0; o < 32; ++o) *(unsigned*)(P + (long)(R0 + rh * 32 + o) * 4096 + col) = outv[o];
    if (part < 2) {
      char* dstT = part == 0 ? Qs : Ks; const int chl = ch - part * 128;
#pragma unroll
      for (int o = 0; o < 32; ++o) { const int row = rh * 32 + o;
        *(unsigned*)(dstT + row * 256 + ((((chl >> 3) ^ (row & 7))) << 4) + (chl & 7) * 2) = outv[o]; }
      if (part == 1) {
        u16* kt = KTg + ((long)(seq * 8 + h) * NCHUNK + chunk) * 8192 + (long)chl * 64 + rh * 32;
#pragma unroll
        for (int q4 = 0; q4 < 4; ++q4) {
          u32x4 lo, hi4;
#pragma unroll
          for (int e = 0; e < 4; ++e) { const unsigned a = outv[q4 * 8 + 2 * e], b = outv[q4 * 8 + 2 * e + 1];
            lo[e] = (a & 0xffffu) | (b << 16); hi4[e] = (a >> 16) | (b & 0xffff0000u); }
          *(u32x4*)(kt + q4 * 8) = lo; *(u32x4*)(kt + 64 + q4 * 8) = hi4;
          SBAR();
        }
      }
    }
    if (tid < 128) {
      const int r = tid & 63, dir = tid >> 6; const long row = R0 + r;
      const float b = BA[row * 32 + dir * 8 + h], a = BA[row * 32 + 16 + dir * 8 + h];
      float beta = 1.f / (1.f + __expf(-b));
      float xx = a + p.g_dtb[dir * 8 + h];
      float sp = xx > 20.f ? xx : __logf(1.f + __expf(xx));
      float gg = -__expf(p.g_alog[dir * 8 + h]) * sp;
      if (chunk == 0 && r < PADR) { beta = 0.f; gg = 0.f; }
      float gc = gg;
#pragma unroll
      for (int off = 1; off < 64; off <<= 1) {
        const float up = __shfl_up(gc, off, 64), dn = __shfl_down(gc, off, 64);
        if (dir == 0) { if (r >= off) gc += up; } else { if (r + off < 64) gc += dn; }
      }
      const float gl = __shfl(gc, dir == 0 ? 63 : 0, 64);
      sbeta[dir * 64 + r] = beta; sgc[dir * 64 + r] = gc;
      f32x4 st = {beta, __expf(gc), __expf(gl - gc), __expf(gl)};
      *(f32x4*)(SCg + ((long)((seq * 8 + h) * 2 + dir) * TP + chunk * 64 + r) * 4) = st;
    }
    __syncthreads();
    {
      const int kind = wid >> 2, qi = (wid >> 1) & 1, qj = wid & 1;
      int r32 = lane & 31, hi = lane >> 5;
      asm volatile("" : "+v"(r32), "+v"(hi));
      const char* At = kind ? Qs : Ks;
      f32x16 acc;
#pragma unroll
      for (int r = 0; r < 16; ++r) acc[r] = 0.f;
#pragma unroll
      for (int ks = 0; ks < 8; ++ks) {
        const int c = ks * 2 + hi; const int ra = qi * 32 + r32, rb = qj * 32 + r32;
        bf16x8 af = *(const bf16x8*)(At + ra * 256 + ((c ^ (ra & 7)) << 4));
        bf16x8 bfr = *(const bf16x8*)(Ks + rb * 256 + ((c ^ (rb & 7)) << 4));
        acc = __builtin_amdgcn_mfma_f32_32x32x16_bf16(af, bfr, acc, 0, 0, 0);
        if (ks & 1) SBAR();
      }
      const int j = qj * 32 + r32;
      u16* Ag0 = TQg + ((long)((seq * 8 + h) * 2 + 0) * NCHUNK + chunk) * 8192 + 4096;
      u16* Ag1 = TQg + ((long)((seq * 8 + h) * 2 + 1) * NCHUNK + chunk) * 8192 + 4096;
      const float gj0 = sgc[j], gj1 = sgc[64 + j];
#pragma unroll
      for (int r = 0; r < 16; ++r) {
        const int i = qi * 32 + crow(r, hi);
        const float e0 = __expf(fminf(sgc[i] - gj0, 0.f)), e1 = __expf(fminf(sgc[64 + i] - gj1, 0.f));
        if (kind == 0) {
          M0[i * 64 + j] = j < i ? sbeta[i] * acc[r] * e0 : 0.f;
          M0[4096 + (63 - i) * 64 + (63 - j)] = j > i ? sbeta[64 + i] * acc[r] * e1 : 0.f;
        } else {
          Ag0[i * 64 + j] = f2bf(j <= i ? acc[r] * e0 : 0.f);
          Ag1[i * 64 + j] = f2bf(j >= i ? acc[r] * e1 : 0.f);
        }
        SBAR();
      }
    }
    __syncthreads();
    if (wid < 2) {
      const int d = wid; const float* M = M0 + d * 4096; float* Tl = M0 + 8192 + d * 4096;
      float t[64];
      const int mbase = (int)(uintptr_t)M;
      solve_block_r<0>(t, mbase, lane); solve_block_r<1>(t, mbase, lane); solve_block_r<2>(t, mbase, lane); solve_block_r<3>(t, mbase, lane);
      solve_block_r<4>(t, mbase, lane); solve_block_r<5>(t, mbase, lane); solve_block_r<6>(t, mbase, lane); solve_block_r<7>(t, mbase, lane);
      solve_block_r<8>(t, mbase, lane); solve_block_r<9>(t, mbase, lane); solve_block_r<10>(t, mbase, lane); solve_block_r<11>(t, mbase, lane);
      solve_block_r<12>(t, mbase, lane); solve_block_r<13>(t, mbase, lane); solve_block_r<14>(t, mbase, lane); solve_block_r<15>(t, mbase, lane);
      u16* Tg = TQg + ((long)((seq * 8 + h) * 2 + d) * NCHUNK + chunk) * 8192;
      const int tbase = d ? 63 * 64 + 63 - lane : lane, tstride = d ? -64 : 64;
#pragma unroll
      for (int a = 0; a < 64; ++a) Tg[tbase + a * tstride] = f2bf(t[a]);
    }
  }
}

DI bf16x8 pack8(f32x4 a, f32x4 b) { u32x4 w = {pk2(a[0], a[1]), pk2(a[2], a[3]), pk2(b[0], b[1]), pk2(b[2], b[3])}; return __builtin_bit_cast(bf16x8, w); }
DI bf16x8 ld_frag(const char* ptr) { u32x2 lo = *(const u32x2*)ptr; u32x2 hi = *(const u32x2*)(ptr + 32); u32x4 w = {lo[0], lo[1], hi[0], hi[1]}; return __builtin_bit_cast(bf16x8, w); }
#define MFMA16(a, b, c) __builtin_amdgcn_mfma_f32_16x16x32_bf16((a), (b), (c), 0, 0, 0)
constexpr int SB_Q = 0, SB_K = 17408, SB_KT = 34816, SB_T = 53248, SB_A = 62464, SB_V = 71680, SB_SC = 79872, SB_SIZE = 80896;

struct ScanRegs { u32x4 rq[4], rk[4], rkt[4], rt[2], ra[2], rv[2]; f32x4 rs; };
DI void scan_issue(const Params& p, int seq, int h, int dir, int dvq, int cc, int lt, ScanRegs& R) {
  const u16* P = (const u16*)(p.ws + OFF_P);
  const long R0 = (long)seq * TP + cc * 64;
  const u16* Pq = P + R0 * 4096 + h * 128; const u16* Pk = Pq + 1024; const u16* Pv = P + R0 * 4096 + 2048 + h * 256 + dvq * 64;
  const u16* KTg = (const u16*)(p.ws + OFF_KT) + ((long)(seq * 8 + h) * NCHUNK + cc) * 8192;
  const u16* Tg = (const u16*)(p.ws + OFF_TQ) + ((long)((seq * 8 + h) * 2 + dir) * NCHUNK + cc) * 8192;
  const float* SCg = (const float*)(p.ws + OFF_SC) + ((long)((seq * 8 + h) * 2 + dir) * TP + cc * 64) * 4;
#pragma unroll
  for (int i = 0; i < 4; ++i) { const int e = lt + 256 * i, row = e >> 4, c = e & 15;
    R.rq[i] = *(const u32x4*)(Pq + (long)row * 4096 + c * 8); R.rk[i] = *(const u32x4*)(Pk + (long)row * 4096 + c * 8); }
#pragma unroll
  for (int i = 0; i < 4; ++i) { const int e = lt + 256 * i, row = e >> 3, c = e & 7; R.rkt[i] = *(const u32x4*)(KTg + row * 64 + c * 8); }
#pragma unroll
  for (int i = 0; i < 2; ++i) { const int e = lt + 256 * i, row = e >> 3, c = e & 7;
    R.rt[i] = *(const u32x4*)(Tg + row * 64 + c * 8); R.ra[i] = *(const u32x4*)(Tg + 4096 + row * 64 + c * 8);
    R.rv[i] = *(const u32x4*)(Pv + (long)row * 4096 + c * 8); }
  R.rs = (f32x4){0.f, 0.f, 0.f, 0.f};
  if (lt < 64) R.rs = *(const f32x4*)(SCg + lt * 4);
}
DI void scan_commit(char* B, int lt, const ScanRegs& R) {
#pragma unroll
  for (int i = 0; i < 4; ++i) { const int e = lt + 256 * i, row = e >> 4, c = e & 15;
    *(u32x4*)(B + SB_Q + row * 272 + c * 16) = R.rq[i]; *(u32x4*)(B + SB_K + row * 272 + c * 16) = R.rk[i]; }
#pragma unroll
  for (int i = 0; i < 4; ++i) { const int e = lt + 256 * i, row = e >> 3, c = e & 7; *(u32x4*)(B + SB_KT + row * 144 + c * 16) = R.rkt[i]; }
#pragma unroll
  for (int i = 0; i < 2; ++i) { const int e = lt + 256 * i, row = e >> 3, c = e & 7;
    *(u32x4*)(B + SB_T + row * 144 + c * 16) = R.rt[i]; *(u32x4*)(B + SB_A + row * 144 + c * 16) = R.ra[i];
    *(u32x4*)(B + SB_V + row * 128 + c * 16) = R.rv[i]; }
  if (lt < 64) *(f32x4*)(B + SB_SC + lt * 16) = R.rs;
}

DI void scan_compute(f32x4 (&S)[8], const char* B, u16* __restrict__ Orow, int wid, int n, int quad) {
  const char* bK = B + SB_K + n * 272 + 8 * quad; const char* bQ = B + SB_Q + n * 272 + 8 * quad;
  const char* bT = B + SB_T + n * 144 + 8 * quad; const char* bA = B + SB_A + n * 144 + 8 * quad; const char* bKT = B + SB_KT + n * 144 + 8 * quad;
  bf16x8 fa[8], fb[8];
#define LD_KQ(F, mt) do { _Pragma("unroll") for (int ks = 0; ks < 4; ++ks) { F[ks] = ld_frag(bK + (mt) * 16 * 272 + 64 * ks); F[4 + ks] = ld_frag(bQ + (mt) * 16 * 272 + 64 * ks); } } while (0)
#define LD_64(F, base) do { _Pragma("unroll") for (int mt = 0; mt < 4; ++mt) { F[2 * mt] = ld_frag(base + mt * 16 * 144); F[2 * mt + 1] = ld_frag(base + mt * 16 * 144 + 64); } } while (0)
#define GRP() do { __builtin_amdgcn_sched_group_barrier(0x100, 8, 0); __builtin_amdgcn_sched_group_barrier(0x008, 8, 0); SBAR(); } while (0)
  bf16x8 Sb[4];
#pragma unroll
  for (int ks = 0; ks < 4; ++ks) Sb[ks] = pack8(S[2 * ks], S[2 * ks + 1]);
  f32x4 KS[4], QS[4];
#pragma unroll
  for (int mt = 0; mt < 4; ++mt) { KS[mt] = (f32x4){0.f, 0.f, 0.f, 0.f}; QS[mt] = (f32x4){0.f, 0.f, 0.f, 0.f}; }
#define MM_KQ(F, mt) do { _Pragma("unroll") for (int ks = 0; ks < 4; ++ks) { KS[mt] = MFMA16(F[ks], Sb[ks], KS[mt]); QS[mt] = MFMA16(F[4 + ks], Sb[ks], QS[mt]); } } while (0)
  LD_KQ(fa, 0); SBAR();
  LD_KQ(fb, 1); MM_KQ(fa, 0); GRP();
  LD_KQ(fa, 2); MM_KQ(fb, 1); GRP();
  LD_KQ(fb, 3); MM_KQ(fa, 2); GRP();
  LD_64(fa, bT); MM_KQ(fb, 3); GRP();
  f32x4 rhs[4], o[4]; float egl = 1.f;
#pragma unroll
  for (int mt = 0; mt < 4; ++mt)
#pragma unroll
    for (int i = 0; i < 4; ++i) {
      const int row = 16 * mt + 4 * quad + i;
      const f32x4 sc = *(const f32x4*)(B + SB_SC + row * 16);
      const float v = bf2f(*(const u16*)(B + SB_V + row * 128 + (wid * 16 + n) * 2));
      egl = sc[3];
      rhs[mt][i] = sc[0] * (v - sc[1] * KS[mt][i]);
      o[mt][i] = QS[mt][i] * sc[1];
    }
  bf16x8 Rb[2];
#pragma unroll
  for (int k2 = 0; k2 < 2; ++k2) Rb[k2] = pack8(rhs[2 * k2], rhs[2 * k2 + 1]);
  SBAR();
  f32x4 VN[4];
  LD_64(fb, bA);
#pragma unroll
  for (int mt = 0; mt < 4; ++mt) { VN[mt] = (f32x4){0.f, 0.f, 0.f, 0.f}; VN[mt] = MFMA16(fa[2 * mt], Rb[0], VN[mt]); VN[mt] = MFMA16(fa[2 * mt + 1], Rb[1], VN[mt]); }
  GRP();
  bf16x8 Vb[2], Vd[2];
#pragma unroll
  for (int k2 = 0; k2 < 2; ++k2) {
    Vb[k2] = pack8(VN[2 * k2], VN[2 * k2 + 1]);
    f32x4 e0, e1;
#pragma unroll
    for (int i = 0; i < 4; ++i) { e0[i] = *(const float*)(B + SB_SC + (32 * k2 + 4 * quad + i) * 16 + 8); e1[i] = *(const float*)(B + SB_SC + (32 * k2 + 16 + 4 * quad + i) * 16 + 8); }
    Vd[k2] = pack8(VN[2 * k2] * e0, VN[2 * k2 + 1] * e1);
  }
  SBAR();
  LD_64(fa, bKT);
#pragma unroll
  for (int mt = 0; mt < 4; ++mt) { o[mt] = MFMA16(fb[2 * mt], Vb[0], o[mt]); o[mt] = MFMA16(fb[2 * mt + 1], Vb[1], o[mt]); }
  GRP();
  LD_64(fb, bKT + 64 * 144);
#pragma unroll
  for (int t = 0; t < 4; ++t) { S[t] = S[t] * egl; S[t] = MFMA16(fa[2 * t], Vd[0], S[t]); S[t] = MFMA16(fa[2 * t + 1], Vd[1], S[t]); }
  GRP();
#pragma unroll
  for (int t = 0; t < 4; ++t) { S[4 + t] = S[4 + t] * egl; S[4 + t] = MFMA16(fb[2 * t], Vd[0], S[4 + t]); S[4 + t] = MFMA16(fb[2 * t + 1], Vd[1], S[4 + t]); }
#pragma unroll
  for (int mt = 0; mt < 4; ++mt)
#pragma unroll
    for (int i = 0; i < 4; ++i) *(u16*)((char*)B + SB_V + (16 * mt + 4 * quad + i) * 128 + (wid * 16 + n) * 2) = f2bf(o[mt][i]);
#undef LD_KQ
#undef LD_64
#undef GRP
#undef MM_KQ
}

DI void phase_scan(const Params& p, char* lds) {
  for (int item = blockIdx.x; item < GS * 8 * 2 * 4; item += gridDim.x) {
    const int tid = otid(), wid = tid >> 6, lane = tid & 63, n = lane & 15, quad = lane >> 4, lt = tid - 256;
    int dvq = item & 3, tri = item >> 2;
    if (gridDim.x == 256) { const int vb = vbid(lds), x = vb >> 5, lb = vb & 31; dvq = lb & 3; tri = x + 8 * (lb >> 2); }
    const int dir = tri & 1, h = (tri >> 1) & 7, seq = tri >> 4;
    u16* O = (u16*)(p.ws + (dir ? OFF_OB : OFF_OF)) + (long)seq * TP * 2048 + h * 256 + dvq * 64 + (wid & 3) * 16 + n;
    const int wid_s = __builtin_amdgcn_readfirstlane(wid);
#define CHK(c) (dir ? NCHUNK - 1 - (c) : (c))
    if (wid_s >= 4) {
      ScanRegs LA;
      __syncthreads();
      scan_issue(p, seq, h, dir, dvq, CHK(0), lt, LA); scan_commit(lds, lt, LA); scan_issue(p, seq, h, dir, dvq, CHK(1), lt, LA);
      __syncthreads();
      u16* Og = (u16*)(p.ws + (dir ? OFF_OB : OFF_OF)) + (long)seq * TP * 2048 + h * 256 + dvq * 64;
#define OFLUSH(Bp, cc) do { _Pragma("unroll") for (int i = 0; i < 2; ++i) { const int e = lt + 256 * i, row = e >> 3, c16 = e & 7; \
          *(u32x4*)(Og + ((long)(cc) * 64 + row) * 2048 + c16 * 8) = *(const u32x4*)((Bp) + SB_V + row * 128 + c16 * 16); } } while (0)
#pragma unroll 1
      for (int c = 0; c < NCHUNK; ++c) {
        if (c > 0) OFLUSH(lds + ((c + 1) & 1) * SB_SIZE, CHK(c - 1));
        if (c + 1 < NCHUNK) scan_commit(lds + ((c + 1) & 1) * SB_SIZE, lt, LA);
        if (c + 2 < NCHUNK) scan_issue(p, seq, h, dir, dvq, CHK(c + 2), lt, LA);
        __syncthreads();
      }
      OFLUSH(lds + ((NCHUNK - 1) & 1) * SB_SIZE, CHK(NCHUNK - 1));
#undef OFLUSH
    } else {
      f32x4 S[8];
#pragma unroll
      for (int t = 0; t < 8; ++t) S[t] = (f32x4){0.f, 0.f, 0.f, 0.f};
      __builtin_amdgcn_s_setprio(2);
      __syncthreads();
      __syncthreads();
#pragma unroll 1
      for (int c = 0; c < NCHUNK; ++c) {
        scan_compute(S, lds + (c & 1) * SB_SIZE, O + (long)CHK(c) * 64 * 2048, wid, n, quad);
        __syncthreads();
      }
      __builtin_amdgcn_s_setprio(0);
    }
#undef CHK
  }
}

DI void phase_gate(const Params& p) {
  u16* OFp = (u16*)(p.ws + OFF_OF); const u16* OBp = (const u16*)(p.ws + OFF_OB); const u16* Z = (const u16*)(p.ws + OFF_Z);
  const int lane = otid() & 63, wv = otid() >> 6;
  constexpr int UN = 4;
  for (int it0 = (blockIdx.x * 8 + wv) * UN; it0 < GR * 8; it0 += gridDim.x * 8 * UN) {
    u32x2 a[UN], b[UN], z[UN];
#pragma unroll
    for (int u = 0; u < UN; ++u) { const long off = (long)(it0 + u) * 256 + lane * 4;
      a[u] = *(const u32x2*)(OFp + off); b[u] = *(const u32x2*)(OBp + off); z[u] = *(const u32x2*)(Z + off); }
#pragma unroll
    for (int u = 0; u < UN; ++u) { const long off = (long)(it0 + u) * 256 + lane * 4;
      float o0 = bflo(a[u][0]) + bflo(b[u][0]), o1 = bfhi(a[u][0]) + bfhi(b[u][0]), o2 = bflo(a[u][1]) + bflo(b[u][1]), o3 = bfhi(a[u][1]) + bfhi(b[u][1]);
      float ss = wave_sum(o0 * o0 + o1 * o1 + o2 * o2 + o3 * o3);
      float rs = rsqrtf(ss * (1.f / 256.f) + EPS);
      u32x2 w = {pk2(o0 * rs * silu(bflo(z[u][0])), o1 * rs * silu(bfhi(z[u][0]))), pk2(o2 * rs * silu(bflo(z[u][1])), o3 * rs * silu(bfhi(z[u][1])))};
      *(u32x2*)(OFp + off) = w; }
  }
}

DI void phase_rowstats(const Params& p) {
  const u16* CQ = (const u16*)(p.ws + OFF_CQ); const u16* CKV = (const u16*)(p.ws + OFF_CKV); const float* KPE = (const float*)(p.ws + OFF_KPE);
  float* rowst = (float*)(p.ws + OFF_ROWST); float* kper = (float*)(p.ws + OFF_KPER); const float* rope = (const float*)(p.ws + OFF_ROPE);
  const int lane = otid() & 63, wv = otid() >> 6;
  for (int row = blockIdx.x * 8 + wv; row < GR; row += gridDim.x * 8) {
    u32x4 q = *(const u32x4*)(CQ + (long)row * 512 + lane * 8);
    float sq = 0.f;
#pragma unroll
    for (int j = 0; j < 4; ++j) { float a = bflo(q[j]), b = bfhi(q[j]); sq += a * a + b * b; }
    u32x2 kv = *(const u32x2*)(CKV + (long)row * 256 + lane * 4);
    float sk = 0.f;
#pragma unroll
    for (int j = 0; j < 2; ++j) { float a = bflo(kv[j]), b = bfhi(kv[j]); sk += a * a + b * b; }
    const float kp = KPE[(long)row * 64 + lane];
    sq = wave_sum(sq); sk = wave_sum(sk); const float sp = wave_sum(kp * kp);
    const float val = kp * p.m_kg[128 + lane];
    const float oth = __shfl_xor(val, 32, 64);
    int pos = row % TP - PADR; pos = pos < 0 ? 0 : pos;
    const int i = lane & 31; const float c = rope[pos * 64 + i], s = rope[pos * 64 + 32 + i];
    kper[(long)row * 64 + lane] = lane < 32 ? val * c - oth * s : val * c + oth * s;
    if (lane == 0) { f32x4 st = {rsqrtf(sq * (1.f / 512.f) + EPS), rsqrtf(sk * (1.f / 256.f) + EPS), sp, 0.f}; *(f32x4*)(rowst + (long)row * 4) = st; }
  }
}

constexpr float ATT_SCALE = 0.07216878364870322f;
constexpr float ATT_THR = 8.f;
constexpr int SHM_V = 64 * 128 * 2, SHM_K = 64 * 192 * 2;
DI int v_st(int k, int c) { const int kk = (k & ~0xC) | ((k & 4) << 1) | ((k & 8) >> 1); return ((kk >> 3) * 4 + (c >> 5)) * 512 + ((kk & 7) * 32 + (c & 31)) * 2; }
DI int v_rd_base(int lane) { return ((lane & 3) << 3) | (((lane >> 2) & 3) << 6) | (((lane >> 4) & 1) << 5) | (((lane >> 5) & 1) << 8); }
constexpr int v_rd_off(int d0, int ks, int half) { return d0 * 512 + ks * 4096 + half * 2048; }
template <int OFF> DI s16x4 tr_read(int vb) {
  s16x4 r; asm volatile("ds_read_b64_tr_b16 %0, %1 offset:%2" : "=&v"(r) : "v"(vb), "i"(OFF) : "memory"); return r;
}
#define RD8(D0, X) do { X##0 = tr_read<v_rd_off(D0, 0, 0)>(vb); X##1 = tr_read<v_rd_off(D0, 0, 1)>(vb); X##2 = tr_read<v_rd_off(D0, 1, 0)>(vb); X##3 = tr_read<v_rd_off(D0, 1, 1)>(vb); \
    X##4 = tr_read<v_rd_off(D0, 2, 0)>(vb); X##5 = tr_read<v_rd_off(D0, 2, 1)>(vb); X##6 = tr_read<v_rd_off(D0, 3, 0)>(vb); X##7 = tr_read<v_rd_off(D0, 3, 1)>(vb); } while (0)
#define PKV(L, H) (bf16x8){L[0], L[1], L[2], L[3], H[0], H[1], H[2], H[3]}
#define MM4(OD, X) do { OD = __builtin_amdgcn_mfma_f32_32x32x16_bf16(pa0, PKV(X##0, X##1), OD, 0, 0, 0); OD = __builtin_amdgcn_mfma_f32_32x32x16_bf16(pa1, PKV(X##2, X##3), OD, 0, 0, 0); \
    OD = __builtin_amdgcn_mfma_f32_32x32x16_bf16(pa2, PKV(X##4, X##5), OD, 0, 0, 0); OD = __builtin_amdgcn_mfma_f32_32x32x16_bf16(pa3, PKV(X##6, X##7), OD, 0, 0, 0); } while (0)
DI void pv_all(f32x16* o, int vb, bf16x8 pa0, bf16x8 pa1, bf16x8 pa2, bf16x8 pa3) {
  s16x4 a0, a1, a2, a3, a4, a5, a6, a7;
  RD8(0, a); asm volatile("s_waitcnt lgkmcnt(0)" ::: "memory"); SBAR(); MM4(o[0], a); SBAR();
  RD8(1, a); asm volatile("s_waitcnt lgkmcnt(0)" ::: "memory"); SBAR(); MM4(o[1], a); SBAR();
  RD8(2, a); asm volatile("s_waitcnt lgkmcnt(0)" ::: "memory"); SBAR(); MM4(o[2], a); SBAR();
  RD8(3, a); asm volatile("s_waitcnt lgkmcnt(0)" ::: "memory"); SBAR(); MM4(o[3], a); SBAR();
}
#undef RD8
#undef MM4
#undef PKV

DI void attn_item(const u16* __restrict__ Qb, const u16* __restrict__ Kh, const u16* __restrict__ Vh, int q0,
                  u16* __restrict__ Yb, const u16* __restrict__ Zb, char* lds) {
  const int tid = otid(), wid = tid >> 6, lane = tid & 63, r32 = lane & 31, hi = lane >> 5;
  char* V_lds = lds; char* K_lds = lds + 3 * SHM_V;
  float* wsf = (float*)(lds + 3 * SHM_V + 3 * SHM_K) + wid * 64; float* li_l = wsf; float* al_l = wsf + 32;
  constexpr float C = ATT_SCALE * 1.4426950408889634f;
  float m_reg = -1e30f, l_reg = 0.f;
  f32x16 o[4];
#pragma unroll
  for (int d = 0; d < 4; ++d)
#pragma unroll
    for (int r = 0; r < 16; ++r) o[d][r] = 0.f;
  bf16x8 qr[12];
  const int qrow = q0 + wid * 32 + r32;
#pragma unroll
  for (int d0 = 0; d0 < 12; ++d0) {
    bf16x8 z = {0, 0, 0, 0, 0, 0, 0, 0};
    qr[d0] = qrow < TP ? *(const bf16x8*)(Qb + (long)qrow * 192 + d0 * 16 + hi * 8) : z;
  }
  const int vb0 = (int)(uintptr_t)V_lds + v_rd_base(lane);
  int koff[3], voff[2];
#pragma unroll
  for (int i = 0; i < 3; ++i) { const int P = (wid * 3 + i) * 1024 + lane * 16, row = P / 384, b = P % 384; koff[i] = row * 192 + ((b ^ ((row & 7) << 4)) >> 1); }
#pragma unroll
  for (int i = 0; i < 2; ++i) { const int P = (wid * 2 + i) * 1024 + lane * 16, sub = P >> 9, within = P & 511;
    const int kk = (sub >> 2) * 8 + (within >> 6), k = (kk & ~0xC) | ((kk & 4) << 1) | ((kk & 8) >> 1), c = (sub & 3) * 32 + ((within & 63) >> 1);
    voff[i] = k * 128 + c; }
#define GLDS16(gp, lp) __builtin_amdgcn_global_load_lds((const unsigned*)(gp), (__attribute__((address_space(3))) unsigned*)(lp), 16, 0, 0)
#define STAGE(k0, slot) do { \
    _Pragma("unroll") for (int i = 0; i < 3; ++i) GLDS16(Kh + (long)(k0) * 192 + koff[i], K_lds + (slot) * SHM_K + (wid * 3 + i) * 1024 + lane * 16); \
    _Pragma("unroll") for (int i = 0; i < 2; ++i) GLDS16(Vh + (long)(k0) * 128 + voff[i], V_lds + (slot) * SHM_V + (wid * 2 + i) * 1024 + lane * 16); } while (0)
  constexpr int NT = TP / 64;
#define ATT_QK(slot) do { \
    _Pragma("unroll") for (int r = 0; r < 16; ++r) { p0[r] = 0.f; p1[r] = 0.f; } \
    const char* Kc = K_lds + (slot) * SHM_K; const int swz = (r32 & 7) << 4; \
    const char* Kr0 = Kc + r32 * 384; const char* Kr1 = Kc + (32 + r32) * 384; \
    _Pragma("unroll") for (int d0 = 0; d0 < 12; ++d0) { const int cb = (d0 * 16 + hi * 8) * 2; \
      bf16x8 b0 = *(const bf16x8*)(Kr0 + (cb ^ swz)); bf16x8 b1 = *(const bf16x8*)(Kr1 + (cb ^ swz)); \
      p0 = __builtin_amdgcn_mfma_f32_32x32x16_bf16(b0, qr[d0], p0, 0, 0, 0); \
      p1 = __builtin_amdgcn_mfma_f32_32x32x16_bf16(b1, qr[d0], p1, 0, 0, 0); \
      if ((d0 & 1) == 1) SBAR(); } } while (0)
#define KFLOAD(G, S)
#define ATT_MASK0() do { _Pragma("unroll") for (int r = 0; r < 16; ++r) p0[r] = -1e30f; _Pragma("unroll") for (int r = 0; r < 8; ++r) p1[r] = -1e30f; } while (0)
#define PK4(PP, BASE, OUT) do { unsigned a0 = pk2(PP[BASE + 0], PP[BASE + 1]), a1 = pk2(PP[BASE + 2], PP[BASE + 3]); \
    unsigned b0 = pk2(PP[BASE + 4], PP[BASE + 5]), b1 = pk2(PP[BASE + 6], PP[BASE + 7]); \
    auto r0 = __builtin_amdgcn_permlane32_swap(a0, b0, false, false); auto r1 = __builtin_amdgcn_permlane32_swap(a1, b1, false, false); \
    u32x4 w = {r0[0], r1[0], r0[1], r1[1]}; OUT = __builtin_bit_cast(bf16x8, w); } while (0)
#define ATT_SM() do { \
    float pmax = p0[0]; \
    _Pragma("unroll") for (int r = 1; r < 16; ++r) pmax = fmaxf(pmax, p0[r]); \
    _Pragma("unroll") for (int r = 0; r < 16; ++r) pmax = fmaxf(pmax, p1[r]); \
    { auto rr = __builtin_amdgcn_permlane32_swap(__float_as_uint(pmax), __float_as_uint(pmax), false, false); \
      pmax = fmaxf(__uint_as_float(rr[0]), __uint_as_float(rr[1])); } \
    float mn, alpha; \
    if (__all(pmax - m_reg <= ATT_THR / ATT_SCALE)) { mn = m_reg; alpha = 1.f; } \
    else { mn = fmaxf(m_reg, pmax); alpha = __builtin_amdgcn_exp2f((m_reg - mn) * C); m_reg = mn; } \
    if (__any(alpha < 1.f)) { \
      if (hi == 0) al_l[r32] = alpha; \
      asm volatile("s_waitcnt lgkmcnt(0)" ::: "memory"); \
      _Pragma("unroll") for (int r = 0; r < 16; ++r) { const float a = al_l[crow(r, hi)]; \
        _Pragma("unroll") for (int d = 0; d < 4; ++d) o[d][r] *= a; } } \
    const float mnC = -mn * C; float ps = 0.f; \
    _Pragma("unroll") for (int r = 0; r < 16; ++r) { p0[r] = __builtin_amdgcn_exp2f(fmaf(p0[r], C, mnC)); p1[r] = __builtin_amdgcn_exp2f(fmaf(p1[r], C, mnC)); ps += p0[r] + p1[r]; } \
    { auto rr = __builtin_amdgcn_permlane32_swap(__float_as_uint(ps), __float_as_uint(ps), false, false); \
      ps = __uint_as_float(rr[0]) + __uint_as_float(rr[1]); } \
    l_reg = l_reg * alpha + ps; \
    PK4(p0, 0, pa0); PK4(p0, 8, pa1); PK4(p1, 0, pa2); PK4(p1, 8, pa3); } while (0)

  __syncthreads();
  STAGE(0, 0); STAGE(64, 1);
  __syncthreads();
  f32x16 p0, p1;
  bf16x8 pa0, pa1, pa2, pa3;
  const int wid_s = __builtin_amdgcn_readfirstlane(wid);
  if (wid_s < 4) {
    ATT_QK(0); ATT_MASK0(); ATT_SM();
    int sK = 1, sV = 0, sW = 2;
#pragma unroll 1
    for (int j = 1; j < NT; ++j) {
      if (j + 1 < NT) STAGE((j + 1) * 64, sW);
      pv_all(o, vb0 + sV * SHM_V, pa0, pa1, pa2, pa3);
      ATT_QK(sK);
      ATT_SM();
      sV = sK; sK = sW; sW = (sW == 2) ? 0 : sW + 1;
      __syncthreads();
    }
    pv_all(o, vb0 + sV * SHM_V, pa0, pa1, pa2, pa3);
  } else {
    __builtin_amdgcn_s_setprio(1);
    ATT_QK(0); ATT_MASK0();
    int sK = 1, sV = 0, sW = 2;
#pragma unroll 1
    for (int j = 1; j < NT; ++j) {
      if (j + 1 < NT) STAGE((j + 1) * 64, sW);
      ATT_SM();
      pv_all(o, vb0 + sV * SHM_V, pa0, pa1, pa2, pa3);
      ATT_QK(sK);
      sV = sK; sK = sW; sW = (sW == 2) ? 0 : sW + 1;
      __syncthreads();
    }
    ATT_SM();
    pv_all(o, vb0 + sV * SHM_V, pa0, pa1, pa2, pa3);
    __builtin_amdgcn_s_setprio(0);
  }
#undef ATT_QK
#undef KFLOAD
#undef ATT_MASK0
#undef PK4
#undef ATT_SM
#undef STAGE
#undef GLDS16
  if (hi == 0) li_l[r32] = l_reg;
  asm volatile("s_waitcnt lgkmcnt(0)" ::: "memory");
#pragma unroll
  for (int r = 0; r < 16; ++r) {
    const int orow = q0 + wid * 32 + crow(r, hi);
    const float rl = 1.f / li_l[crow(r, hi)];
    if (orow < TP) {
#pragma unroll
      for (int d0 = 0; d0 < 4; ++d0) {
        const long off = (long)orow * 2048 + d0 * 32 + r32;
        Yb[off - 64 * 2048] = f2bf(o[d0][r] * rl * silu(bf2f(Zb[off])));
      }
    }
  }
}

DI void phase_attn(const Params& p, char* lds) {
  const u16* QM = (const u16*)(p.ws + OFF_QM); const u16* KM = (const u16*)(p.ws + OFF_KM); const u16* VM = (const u16*)(p.ws + OFF_VM);
  u16* Y = (u16*)(p.ws + OFF_Y); const u16* Z = (const u16*)(p.ws + OFF_Z);
  const int b = blockIdx.x, vb = vbid(lds), x = vb >> 5, lb = vb & 31;
  if (gridDim.x == 256) {
    for (int it = 0; it < 4; ++it) {
      const int pair = x + 8 * (2 * it + (lb >> 4)), qb = lb & 15;
      const int seq = pair >> 4, head = pair & 15;
      attn_item(QM + (long)pair * TP * 192, KM + (long)pair * TP * 192, VM + (long)pair * TP * 128, 64 + qb * 256,
                Y + (long)seq * SEQ * 2048 + head * 128, Z + (long)seq * TP * 2048 + head * 128, lds);
    }
  } else {
    for (int item = b; item < 64 * 16; item += gridDim.x) {
      const int pair = item >> 4, qb = item & 15; const int seq = pair >> 4, head = pair & 15;
      attn_item(QM + (long)pair * TP * 192, KM + (long)pair * TP * 192, VM + (long)pair * TP * 128, 64 + qb * 256,
                Y + (long)seq * SEQ * 2048 + head * 128, Z + (long)seq * TP * 2048 + head * 128, lds);
    }
  }
}

#define XB_TMO      128
#define XB_XCNT(j)  (256  + 64 * (j))
#define XB_XSUB(j)  (1280 + 64 * (j))
#define XB_XGEN(j)  (2304 + 64 * (j))
#define XB_TOP      3328
#define XB_TOPGEN   3392
#define XCD_BAR_WORDS 3456
#define XB_SPIN_CAP (1u << 18)
#define LAS __attribute__((address_space(3)))
DI unsigned xb_ld(unsigned* p)              { return __hip_atomic_load(p, __ATOMIC_RELAXED, __HIP_MEMORY_SCOPE_AGENT); }
DI unsigned xb_add(unsigned* p, unsigned v) { return __hip_atomic_fetch_add(p, v, __ATOMIC_RELAXED, __HIP_MEMORY_SCOPE_AGENT); }
DI unsigned xb_xcc_id() { return (unsigned)__builtin_amdgcn_s_getreg((3 << 11) | 20) & 0xFu; }
#define XB_SPIN(cond, bar) do { unsigned _sp = 0; while (cond) { __builtin_amdgcn_s_sleep(1); \
    if ((++_sp & 255u) == 0u) { if (xb_ld(&(bar)[XB_TMO])) break; if (_sp > XB_SPIN_CAP) { atomicAdd(&(bar)[XB_TMO], 1u); break; } } } } while (0)
struct XcdBarrier { unsigned* bar; unsigned x; volatile LAS unsigned* st; };
DI XcdBarrier xcd_barrier_post(unsigned* bar, volatile LAS unsigned* st) {
  XcdBarrier b; b.bar = bar; b.x = xb_xcc_id(); b.st = st;
  if (__builtin_amdgcn_workitem_id_x() == 0) (void)xb_add(&bar[XB_XCNT(b.x)], 1u);
  return b;
}
DI void xcd_barrier_complete(unsigned* bar, unsigned x, unsigned& nloc, unsigned& nx) {
  const unsigned G = gridDim.x * gridDim.y * gridDim.z;
  unsigned sum, cnt, mine, sp = 0u;
  for (;;) {
    sum = 0u; cnt = 0u; mine = 0u;
#pragma unroll
    for (unsigned j = 0; j < 16; ++j) { const unsigned c = xb_ld(&bar[XB_XCNT(j)]); sum += c; cnt += (c > 0u) ? 1u : 0u; mine = (j == x) ? c : mine; }
    if (sum == G) break;
    __builtin_amdgcn_s_sleep(1);
    if ((++sp & 255u) == 0u) { if (xb_ld(&bar[XB_TMO])) break; if (sp > XB_SPIN_CAP) { atomicAdd(&bar[XB_TMO], 1u); break; } }
  }
  nloc = mine > 0u ? mine : 1u; nx = cnt > 0u ? cnt : 1u;
}
DI void xcd_barrier(const XcdBarrier& b) {
  asm volatile("s_waitcnt vmcnt(0)" ::: "memory");
  __syncthreads();
  if (__builtin_amdgcn_workitem_id_x() == 0) {
    unsigned* bar = b.bar;
    __builtin_amdgcn_s_waitcnt(0);
    unsigned nloc = b.st[0], nx = b.st[1];
    if (nloc == 0u) { xcd_barrier_complete(bar, b.x, nloc, nx); b.st[0] = nloc; b.st[1] = nx; }
    const unsigned old = xb_add(&bar[XB_XSUB(b.x)], 1u);
    const unsigned gen = old / nloc;
    if (old + 1u == (gen + 1u) * nloc) {
      __builtin_amdgcn_fence(__ATOMIC_RELEASE, "agent");
      asm volatile("s_waitcnt vmcnt(0)" ::: "memory");
      const unsigned og = xb_add(&bar[XB_TOP], 1u);
      const unsigned tg = og / nx;
      if (og + 1u == (tg + 1u) * nx) xb_add(&bar[XB_TOPGEN], 1u);
      else XB_SPIN(xb_ld(&bar[XB_TOPGEN]) == tg, bar);
      __builtin_amdgcn_fence(__ATOMIC_ACQUIRE, "agent");
      xb_add(&bar[XB_XGEN(b.x)], 1u);
      asm volatile("s_waitcnt vmcnt(0)" ::: "memory");
    } else {
      XB_SPIN(xb_ld(&bar[XB_XGEN(b.x)]) == gen, bar);
      __builtin_amdgcn_fence(__ATOMIC_ACQUIRE, "agent");
      asm volatile("s_waitcnt vmcnt(0)" ::: "memory");
    }
  }
  __syncthreads();
}

__global__ void __launch_bounds__(512) fwd_mega(Params p) {
  extern __shared__ __attribute__((aligned(16))) char lds[];
  cg::grid_group grid = cg::this_grid();
  char* ws = p.ws;
  unsigned* barw = (unsigned*)(ws + OFF_BAR);
  if (blockIdx.x == 0) for (int i = otid(); i < XCD_BAR_WORDS + 256; i += 512) barw[i] = 0u;
  volatile LAS unsigned* xst = (volatile LAS unsigned*)(lds + LDS_BYTES - 16);
  if (otid() == 0) { xst[0] = 0u; xst[1] = 0u; }
  grid.sync();
  const XcdBarrier xb = xcd_barrier_post(barw, xst);
  if (otid() == 0) { const unsigned xc = xb_xcc_id(); xst[2] = xb_add(&barw[XCD_BAR_WORDS + 16 * xc], 1u); xst[3] = blockIdx.x; }
  phase_prep(p, lds);
  for (int g = 0; g < NGRP; ++g) {
    if (g == 0) { phase_hn(p, 0, 0); xcd_barrier(xb); }
    if (g == 0) {
      if (otid() == 0) { const unsigned xc = xb_xcc_id(); unsigned base = 0;
        for (unsigned j = 0; j < 16; ++j) { const unsigned c = xb_ld(&barw[XCD_BAR_WORDS + 16 * j]); base += (j < xc) ? c : 0u; }
        xst[3] = base + xst[2]; }
      __syncthreads();
    }
    { pg8::StaticOrder so; so.init(GR, 6400, (int)gridDim.x, (gridDim.x == 256) ? ((vbid(lds) & 31) * 8 + (vbid(lds) >> 5)) : (int)blockIdx.x);
      pg8::EpiGinT e{(u16*)(ws + OFF_P), (u16*)(ws + OFF_HALO), (u16*)(ws + OFF_Z), (float*)(ws + OFF_BA)};
      pg8::gemm_phase<pg8::EpiGinT, pg8::StaticOrder, false>((PG8_LAS unsigned char*)lds, pg8::Gemm{(const u16*)(ws + OFF_HN), (const u16*)(ws + OFF_WGIN), GR, 6400, 1024}, so, e, nullptr); }
    xcd_barrier(xb);
    phase_chunk(p, lds);
    xcd_barrier(xb);
    for (int rep = 0; rep < REP_SCAN; ++rep) phase_scan(p, lds);
    xcd_barrier(xb);
    phase_gate(p);
    xcd_barrier(xb);
    { pg8::StaticOrder so; so.init(GR, 1024, (int)gridDim.x, (gridDim.x == 256) ? ((vbid(lds) & 31) * 8 + (vbid(lds) >> 5)) : (int)blockIdx.x);
      pg8::EpiGoutT e{p, g, (float*)(ws + OFF_H1M)};
      pg8::gemm_phase<pg8::EpiGoutT, pg8::StaticOrder, false>((PG8_LAS unsigned char*)lds, pg8::Gemm{(const u16*)(ws + OFF_OF), (const u16*)(ws + OFF_WGOUT), GR, 1024, 2048}, so, e, nullptr); }
    xcd_barrier(xb);
    phase_hn(p, g, 1);
    xcd_barrier(xb);
    { pg8::StaticOrder so; so.init(GR, 3072, (int)gridDim.x, (gridDim.x == 256) ? ((vbid(lds) & 31) * 8 + (vbid(lds) >> 5)) : (int)blockIdx.x);
      pg8::EpiMinT e{(u16*)(ws + OFF_CQ), (u16*)(ws + OFF_CKV), (u16*)(ws + OFF_Z), (float*)(ws + OFF_KPE)};
      pg8::gemm_phase<pg8::EpiMinT, pg8::StaticOrder, false>((PG8_LAS unsigned char*)lds, pg8::Gemm{(const u16*)(ws + OFF_HN), (const u16*)(ws + OFF_WMIN), GR, 3072, 1024}, so, e, nullptr); }
    xcd_barrier(xb);
    phase_rowstats(p);
    xcd_barrier(xb);
    { EpiQ e{(const float*)(ws + OFF_ROWST), p.m_qg, (const float*)(ws + OFF_ROPE), (u16*)(ws + OFF_QM)};
      for (int rep = 0; rep < REP_GEMM; ++rep) gemm_phase<8, 1, 1, 6>((const u16*)(ws + OFF_CQ), 512, (const u16*)(ws + OFF_WUQ), 512, 512, 3072, lds, e); }
    { EpiKV e{(const float*)(ws + OFF_ROWST), p.m_kg, (const float*)(ws + OFF_KPER), (u16*)(ws + OFF_KM), (u16*)(ws + OFF_VM)};
      for (int rep = 0; rep < REP_GEMM; ++rep) gemm_phase<8, 1, 1, 4>((const u16*)(ws + OFF_CKV), 256, (const u16*)(ws + OFF_WUKV), 256, 256, 4096, lds, e); }
    xcd_barrier(xb);
    for (int rep = 0; rep < REP_ATTN; ++rep) phase_attn(p, lds);
    xcd_barrier(xb);
    { pg8::StaticOrder so; so.init(GS * SEQ, 1024, (int)gridDim.x, (gridDim.x == 256) ? ((vbid(lds) & 31) * 8 + (vbid(lds) >> 5)) : (int)blockIdx.x);
      pg8::EpiMoutT e{p.out, g};
      pg8::gemm_phase<pg8::EpiMoutT, pg8::StaticOrder, false>((PG8_LAS unsigned char*)lds, pg8::Gemm{(const u16*)(ws + OFF_Y), (const u16*)(ws + OFF_WMOUT), GS * SEQ, 1024, 2048}, so, e, nullptr); }
    if (g + 1 < NGRP) phase_hn(p, g + 1, 0);
    xcd_barrier(xb);
  }
}

extern "C" void kernel_launch(void* const* d_in, const int* in_sizes, int n_in,
                              void* d_out, int out_size, void* d_ws, size_t ws_size,
                              hipStream_t stream) {
  static int grid_blocks = 0;
  if (!grid_blocks) {
    int dev = 0, cus = 0, per_cu = 0;
    (void)hipGetDevice(&dev);
    (void)hipDeviceGetAttribute(&cus, hipDeviceAttributeMultiprocessorCount, dev);
    (void)hipFuncSetAttribute((const void*)fwd_mega, hipFuncAttributeMaxDynamicSharedMemorySize, LDS_BYTES);
    (void)hipOccupancyMaxActiveBlocksPerMultiprocessor(&per_cu, fwd_mega, 512, LDS_BYTES);
    if (per_cu < 1) { fprintf(stderr, "occupancy query returned %d\n", per_cu); per_cu = 1; }
    if (per_cu > 1) per_cu = 1;
    grid_blocks = cus * per_cu;
  }
  if (ws_size < WS_NEED) { fprintf(stderr, "workspace too small: %zu < %zu\n", ws_size, (size_t)WS_NEED); return; }
  Params p{};
  p.xp = (const float*)d_in[0]; p.xs = (const float*)d_in[1]; p.meta = (const float*)d_in[2]; p.ln_g = (const float*)d_in[3];
  p.g_win = (const float*)d_in[4]; p.g_conv = (const float*)d_in[5]; p.g_alog = (const float*)d_in[6]; p.g_dtb = (const float*)d_in[7];
  p.g_onorm = (const float*)d_in[8]; p.g_wout = (const float*)d_in[9]; p.m_win = (const float*)d_in[10]; p.m_qn = (const float*)d_in[11];
  p.m_kvn = (const float*)d_in[12]; p.m_wuq = (const float*)d_in[13]; p.m_wukv = (const float*)d_in[14]; p.m_qg = (const float*)d_in[15];
  p.m_kg = (const float*)d_in[16]; p.m_wout = (const float*)d_in[17]; p.out = (float*)d_out; p.ws = (char*)d_ws;
  void* args[] = {&p};
  hipError_t e = hipLaunchCooperativeKernel((void*)fwd_mega, dim3(grid_blocks), dim3(512), args, LDS_BYTES, stream);
  if (e != hipSuccess) fprintf(stderr, "cooperative launch failed: %s (grid %d)\n", hipGetErrorString(e), grid_blocks);
}
```

```cpp
#include <hip/hip_runtime.h>
#include <hip/hip_cooperative_groups.h>
#include <cstdio>
#include <cstdint>
namespace cg = cooperative_groups;

typedef unsigned short u16;
typedef __bf16 bf2_t __attribute__((ext_vector_type(2)));
typedef float f2_t __attribute__((ext_vector_type(2)));
using bf16x8 = __attribute__((ext_vector_type(8))) short;
using s16x4  = __attribute__((ext_vector_type(4))) short;
using f32x16 = __attribute__((ext_vector_type(16))) float;
using f32x4  = __attribute__((ext_vector_type(4))) float;
using u32x4  = __attribute__((ext_vector_type(4))) unsigned;
using u32x2  = __attribute__((ext_vector_type(2))) unsigned;
#define DI __device__ __forceinline__
#define SBAR() __builtin_amdgcn_sched_barrier(0)

DI unsigned pk2(float a, float b) { f2_t v = {a, b}; bf2_t r = __builtin_convertvector(v, bf2_t); return __builtin_bit_cast(unsigned, r); }
DI u16 f2bf(float a) { return (u16)(pk2(a, 0.f) & 0xffffu); }
DI float bf2f(u16 v) { return __uint_as_float(((unsigned)v) << 16); }
DI float bflo(unsigned v) { return __uint_as_float(v << 16); }
DI float bfhi(unsigned v) { return __uint_as_float(v & 0xffff0000u); }
DI int otid() { int t = __builtin_amdgcn_workitem_id_x(); asm volatile("" : "+v"(t)); return t; }
DI int crow(int r, int hi) { return (r & 3) + 8 * (r >> 2) + 4 * hi; }
#define DPP_ADD(v, ctrl, rm) ((v) + __builtin_bit_cast(float, __builtin_amdgcn_update_dpp(0, __builtin_bit_cast(int, (v)), (ctrl), (rm), 0xF, false)))
DI float wave_sum(float v) {
  v = DPP_ADD(v, 0xB1, 0xF);
  v = DPP_ADD(v, 0x4E, 0xF);
  v = DPP_ADD(v, 0x141, 0xF);
  v = DPP_ADD(v, 0x140, 0xF);
  v = DPP_ADD(v, 0x142, 0xA);
  v = DPP_ADD(v, 0x143, 0xC);
  return __builtin_bit_cast(float, __builtin_amdgcn_readlane(__builtin_bit_cast(int, v), 63));
}
DI float silu(float x) { return x * __builtin_amdgcn_rcpf(1.f + __expf(-x)); }

constexpr int D = 1024, TP = 4160, GS = 4, GR = GS * TP, NGRP = 3, PADR = 48, SEQ = 4096;
constexpr int GIN = 6176, GINP = 6400, MIN_ = 2880, MINP = 3072;
constexpr float EPS = 1e-6f;
constexpr int NCHUNK = 65;

constexpr size_t al256(size_t x) { return (x + 255) / 256 * 256; }
constexpr size_t OFF_WGIN  = 0;
constexpr size_t OFF_WGOUT = OFF_WGIN  + al256((size_t)GINP * 1024 * 2);
constexpr size_t OFF_WMIN  = OFF_WGOUT + al256((size_t)1024 * 2048 * 2);
constexpr size_t OFF_WUQ   = OFF_WMIN  + al256((size_t)MINP * 1024 * 2);
constexpr size_t OFF_WUKV  = OFF_WUQ   + al256((size_t)3072 * 512 * 2);
constexpr size_t OFF_WMOUT = OFF_WUKV  + al256((size_t)4096 * 256 * 2);
constexpr size_t OFF_ROPE  = OFF_WMOUT + al256((size_t)1024 * 2048 * 2);
constexpr size_t OFF_H1M   = OFF_ROPE  + al256((size_t)4112 * 64 * 4);
constexpr size_t OFF_HN    = OFF_H1M   + al256((size_t)12 * 16 * 1024 * 4);
constexpr size_t OFF_Z     = OFF_HN    + al256((size_t)GR * 1024 * 2);
constexpr size_t OFF_R     = OFF_Z     + al256((size_t)GR * 2048 * 2);
constexpr size_t OFF_P     = OFF_R;
constexpr size_t OFF_HALO  = OFF_P     + al256((size_t)GR * 4096 * 2);
constexpr size_t OFF_BA    = OFF_HALO  + al256((size_t)(GR / 64) * 4 * 4096 * 2);
constexpr size_t OFF_SC    = OFF_BA    + al256((size_t)GR * 32 * 4);
constexpr size_t OFF_TQ    = OFF_SC    + al256((size_t)GS * 8 * 2 * TP * 16);
constexpr size_t OFF_KT    = OFF_TQ    + al256((size_t)GS * 8 * 2 * NCHUNK * 16384);
constexpr size_t OFF_OF    = OFF_KT    + al256((size_t)GS * 8 * NCHUNK * 16384);
constexpr size_t OFF_OB    = OFF_OF    + al256((size_t)GR * 2048 * 2);
constexpr size_t END_GDN   = OFF_OB    + al256((size_t)GR * 2048 * 2);
constexpr size_t OFF_CQ    = OFF_R;
constexpr size_t OFF_CKV   = OFF_CQ    + al256((size_t)GR * 512 * 2);
constexpr size_t OFF_KPE   = OFF_CKV   + al256((size_t)GR * 256 * 2);
constexpr size_t OFF_ROWST = OFF_KPE   + al256((size_t)GR * 64 * 4);
constexpr size_t OFF_KPER  = OFF_ROWST + al256((size_t)GR * 4 * 4);
constexpr size_t OFF_QM    = OFF_KPER  + al256((size_t)GR * 64 * 4);
constexpr size_t OFF_KM    = OFF_QM    + al256((size_t)GR * 16 * 192 * 2);
constexpr size_t OFF_VM    = OFF_KM    + al256((size_t)GR * 16 * 192 * 2);
constexpr size_t OFF_Y     = OFF_VM    + al256((size_t)GR * 16 * 128 * 2);
constexpr size_t END_MLA   = OFF_Y     + al256((size_t)GR * 2048 * 2);
constexpr size_t OFF_BAR   = END_MLA > END_GDN ? END_MLA : END_GDN;
constexpr size_t WS_NEED   = OFF_BAR + 16384;

constexpr int LDS_BYTES = 160 * 1024;
#ifndef REP_ATTN
#define REP_ATTN 1
#endif
#ifndef REP_SCAN
#define REP_SCAN 1
#endif
#ifndef REP_GEMM
#define REP_GEMM 1
#endif

struct Params {
  const float *xp, *xs, *meta, *ln_g, *g_win, *g_conv, *g_alog, *g_dtb, *g_onorm, *g_wout;
  const float *m_win, *m_qn, *m_kvn, *m_wuq, *m_wukv, *m_qg, *m_kg, *m_wout;
  float* out; char* ws;
};

DI const float* h0_row(const Params& p, int sg, int pos) {
  return pos < 16 ? p.meta + (long)pos * D
                  : (sg < 4 ? p.xp + ((long)sg * SEQ + pos - 16) * D : p.xs + ((long)(sg - 4) * SEQ + pos - 16) * D);
}

#define LASP __attribute__((address_space(3)))
DI int vbid(const char* lds) { return __builtin_amdgcn_readfirstlane((int)*(const volatile LASP unsigned*)(lds + LDS_BYTES - 4)); }

DI void transpose_cvt(const float* __restrict__ src, u16* __restrict__ dst, int K, int N, int Npad,
                      const float* __restrict__ gain, int gmod, float* lds) {
  const int tid = otid();
  const int tK = K / 64, tN = Npad / 64;
  for (int tile = blockIdx.x; tile < tK * tN; tile += gridDim.x) {
    const int tk = tile % tK, tn = tile / tK;
#pragma unroll
    for (int i = 0; i < 2; ++i) {
      int kk = (tid >> 4) + 32 * i, nn = (tid & 15) * 4;
      int k = tk * 64 + kk, n = tn * 64 + nn;
      float4 v = make_float4(0.f, 0.f, 0.f, 0.f);
      if (n < N) v = *(const float4*)(src + (long)k * N + n);
      float gsc = gain ? gain[k % gmod] : 1.f;
      lds[kk * 65 + nn + 0] = v.x * gsc; lds[kk * 65 + nn + 1] = v.y * gsc;
      lds[kk * 65 + nn + 2] = v.z * gsc; lds[kk * 65 + nn + 3] = v.w * gsc;
    }
    __syncthreads();
    {
      int n = tid >> 3, k8 = (tid & 7) * 8;
      float f[8];
#pragma unroll
      for (int j = 0; j < 8; ++j) f[j] = lds[(k8 + j) * 65 + n];
      u32x4 w = {pk2(f[0], f[1]), pk2(f[2], f[3]), pk2(f[4], f[5]), pk2(f[6], f[7])};
      *(u32x4*)(dst + (long)(tn * 64 + n) * K + tk * 64 + k8) = w;
    }
    __syncthreads();
  }
}

DI void phase_prep(const Params& p, char* lds) {
  float* l = (float*)lds;
  transpose_cvt(p.g_win, (u16*)(p.ws + OFF_WGIN), 1024, GIN, GINP, p.ln_g, 1024, l);
  transpose_cvt(p.g_wout, (u16*)(p.ws + OFF_WGOUT), 2048, 1024, 1024, p.g_onorm, 256, l);
  transpose_cvt(p.m_win, (u16*)(p.ws + OFF_WMIN), 1024, MIN_, MINP, p.ln_g + 1024, 1024, l);
  transpose_cvt(p.m_wuq, (u16*)(p.ws + OFF_WUQ), 512, 3072, 3072, p.m_qn, 512, l);
  transpose_cvt(p.m_wukv, (u16*)(p.ws + OFF_WUKV), 256, 4096, 4096, p.m_kvn, 256, l);
  transpose_cvt(p.m_wout, (u16*)(p.ws + OFF_WMOUT), 2048, 1024, 1024, nullptr, 1, l);
  float* rope = (float*)(p.ws + OFF_ROPE);
  for (int i = blockIdx.x * 512 + otid(); i < 4112 * 32; i += gridDim.x * 512) {
    int pos = i >> 5, j = i & 31;
    float inv = __builtin_amdgcn_exp2f(-(float)j * (13.287712379549449f / 32.f));
    float ang = (float)pos * inv;
    float n = rintf(ang * 0.15915494309189535f);
    float rr = fmaf(-n, 6.28318548202514648f, ang); rr = fmaf(-n, -1.7484555e-7f, rr);
    float s = __sinf(rr), c = __cosf(rr);
    rope[pos * 64 + j] = c; rope[pos * 64 + 32 + j] = s;
  }
}

DI void phase_hn(const Params& p, int g, int layer) {
  const int lane = otid() & 63, wv = otid() >> 6;
  u16* HN = (u16*)(p.ws + OFF_HN);
  const float* h1m = (const float*)(p.ws + OFF_H1M);
  for (int row = blockIdx.x * 8 + wv; row < GR; row += gridDim.x * 8) {
    int seq = row / TP, r = row % TP, pos = r - PADR, sg = g * GS + seq;
    u16* dst = HN + (long)row * D;
    if (pos < 0) {
      u32x2 z = {0u, 0u};
#pragma unroll
      for (int i = 0; i < 4; ++i) *(u32x2*)(dst + i * 256 + lane * 4) = z;
      continue;
    }
    const float* src;
    if (layer == 0) src = h0_row(p, sg, pos);
    else src = pos < 16 ? h1m + ((long)sg * 16 + pos) * D : p.out + ((long)sg * SEQ + pos - 16) * D;
    float4 v[4]; float ss = 0.f;
#pragma unroll
    for (int i = 0; i < 4; ++i) { const f32x4 t4 = __builtin_nontemporal_load((const f32x4*)(src + i * 256 + lane * 4)); v[i] = make_float4(t4[0], t4[1], t4[2], t4[3]); ss += v[i].x * v[i].x + v[i].y * v[i].y + v[i].z * v[i].z + v[i].w * v[i].w; }
    ss = wave_sum(ss);
    float rs = rsqrtf(ss * (1.f / 1024.f) + EPS);
#pragma unroll
    for (int i = 0; i < 4; ++i) { u32x2 w = {pk2(v[i].x * rs, v[i].y * rs), pk2(v[i].z * rs, v[i].w * rs)}; *(u32x2*)(dst + i * 256 + lane * 4) = w; }
  }
}

template <int WM, int WN, int MT, int NT, class Epi>
DI void gemm_tile(const u16* __restrict__ A, int lda, const u16* __restrict__ Bt, int ldb, int K, int m0, int n0, char* lds, const Epi& epi) {
  constexpr int BM = WM * MT * 32, BN = WN * NT * 32, NA = BM * 8 / 512, NB = BN * 8 / 512;
  static_assert(WM * WN == 8, "8 waves");
  const int tid = otid(), lane = tid & 63, wid = tid >> 6, r32 = lane & 31, hi = lane >> 5;
  const int wm = wid / WN, wn = wid % WN;
  char* As = lds; char* Bs = lds + 2 * BM * 128;
  f32x16 acc[MT][NT];
#pragma unroll
  for (int a = 0; a < MT; ++a)
#pragma unroll
    for (int b = 0; b < NT; ++b)
#pragma unroll
      for (int r = 0; r < 16; ++r) acc[a][b][r] = 0.f;
  u32x4 ra[NA], rb[NB];
  const int nk = K / 64;
#define GLOAD(kt) do { _Pragma("unroll") for (int i = 0; i < NA; ++i) { int q = tid + 512 * i; int row = q >> 3, c = q & 7; \
      ra[i] = *(const u32x4*)(A + (long)(m0 + row) * lda + (kt) * 64 + c * 8); } \
    _Pragma("unroll") for (int i = 0; i < NB; ++i) { int q = tid + 512 * i; int row = q >> 3, c = q & 7; \
      rb[i] = *(const u32x4*)(Bt + (long)(n0 + row) * ldb + (kt) * 64 + c * 8); } } while (0)
#define SWRITE(buf) do { _Pragma("unroll") for (int i = 0; i < NA; ++i) { int q = tid + 512 * i; int row = q >> 3, c = q & 7; \
      *(u32x4*)(As + (buf) * BM * 128 + row * 128 + ((c ^ (row & 7)) << 4)) = ra[i]; } \
    _Pragma("unroll") for (int i = 0; i < NB; ++i) { int q = tid + 512 * i; int row = q >> 3, c = q & 7; \
      *(u32x4*)(Bs + (buf) * BN * 128 + row * 128 + ((c ^ (row & 7)) << 4)) = rb[i]; } } while (0)
  GLOAD(0); SWRITE(0); if (nk > 1) GLOAD(1);
  __syncthreads();
  for (int kt = 0; kt < nk; ++kt) {
    const int cur = kt & 1;
#pragma unroll
    for (int ks = 0; ks < 4; ++ks) {
      bf16x8 af[MT], bfr[NT];
      const int c = ks * 2 + hi;
#pragma unroll
      for (int a = 0; a < MT; ++a) { int row = (wm * MT + a) * 32 + r32; af[a] = *(const bf16x8*)(As + cur * BM * 128 + row * 128 + ((c ^ (row & 7)) << 4)); }
#pragma unroll
      for (int b = 0; b < NT; ++b) { int row = (wn * NT + b) * 32 + r32; bfr[b] = *(const bf16x8*)(Bs + cur * BN * 128 + row * 128 + ((c ^ (row & 7)) << 4)); }
#pragma unroll
      for (int a = 0; a < MT; ++a)
#pragma unroll
        for (int b = 0; b < NT; ++b) acc[a][b] = __builtin_amdgcn_mfma_f32_32x32x16_bf16(af[a], bfr[b], acc[a][b], 0, 0, 0);
    }
    if (kt + 1 < nk) { SWRITE(cur ^ 1); if (kt + 2 < nk) GLOAD(kt + 2); }
    __syncthreads();
  }
#undef GLOAD
#undef SWRITE
  epi(acc, m0 + wm * MT * 32, n0 + wn * NT * 32, lane);
}

template <int NT> struct EpiGin { u16 *P, *HALO, *Z; float* BA;
  DI void operator()(f32x16 (&acc)[2][NT], int m0, int n0, int lane) const {
    const int r32 = lane & 31, hi = lane >> 5;
#pragma unroll
    for (int a = 0; a < 2; ++a)
#pragma unroll
      for (int b = 0; b < NT; ++b) {
        const int col = n0 + b * 32 + r32;
#pragma unroll
        for (int r = 0; r < 16; ++r) {
          const int row = m0 + a * 32 + crow(r, hi); const float v = acc[a][b][r];
          if (col < 4096) { u16 bv = f2bf(v); P[(long)row * 4096 + col] = bv; int rm = row & 63;
            if (rm < 2 || rm >= 62) HALO[((long)(row >> 6) * 4 + (rm < 2 ? rm : rm - 60)) * 4096 + col] = bv; }
          else if (col < 6144) Z[(long)row * 2048 + col - 4096] = f2bf(v);
          else if (col < GIN) BA[(long)row * 32 + col - 6144] = v;
        }
      }
  } };

struct EpiGout { Params p; int g; float* h1m;
  DI void operator()(f32x16 (&acc)[2][2], int m0, int n0, int lane) const {
    const int r32 = lane & 31, hi = lane >> 5;
#pragma unroll
    for (int a = 0; a < 2; ++a)
#pragma unroll
      for (int r = 0; r < 16; ++r) {
        const int row = m0 + a * 32 + crow(r, hi);
        const int seq = row / TP, rr = row % TP, pos = rr - PADR, sg = g * GS + seq;
        if (pos < 0) continue;
        const float* h0 = h0_row(p, sg, pos);
        float* dst = pos < 16 ? h1m + ((long)sg * 16 + pos) * D : p.out + ((long)sg * SEQ + pos - 16) * D;
#pragma unroll
        for (int b = 0; b < 2; ++b) { const int col = n0 + b * 32 + r32; dst[col] = h0[col] + acc[a][b][r]; }
      }
  } };

struct EpiMin { u16 *CQ, *CKV, *Z; float* KPE;
  DI void operator()(f32x16 (&acc)[2][2], int m0, int n0, int lane) const {
    const int r32 = lane & 31, hi = lane >> 5;
#pragma unroll
    for (int a = 0; a < 2; ++a)
#pragma unroll
      for (int b = 0; b < 2; ++b) {
        const int col = n0 + b * 32 + r32;
#pragma unroll
        for (int r = 0; r < 16; ++r) {
          const int row = m0 + a * 32 + crow(r, hi); const float v = acc[a][b][r];
          if (col < 512) CQ[(long)row * 512 + col] = f2bf(v);
          else if (col < 768) CKV[(long)row * 256 + col - 512] = f2bf(v);
          else if (col < 832) KPE[(long)row * 64 + col - 768] = v;
          else if (col < MIN_) Z[(long)row * 2048 + col - 832] = f2bf(v);
        }
      }
  } };

struct EpiQ { const float *rowst, *gq, *rope; u16* Q;
  DI void operator()(f32x16 (&acc)[1][6], int m0, int n0, int lane) const {
    const int r32 = lane & 31, hi = lane >> 5, head = n0 / 192;
    float ss[16];
#pragma unroll
    for (int r = 0; r < 16; ++r) {
      const int row = m0 + crow(r, hi); const float rq = rowst[row * 4 + 0]; float s = 0.f;
#pragma unroll
      for (int b = 0; b < 6; ++b) { acc[0][b][r] *= rq; s += acc[0][b][r] * acc[0][b][r]; }
      ss[r] = s;
    }
#pragma unroll
    for (int r = 0; r < 16; ++r) {
      float v = ss[r];
      v = DPP_ADD(v, 0xB1, 0xF); v = DPP_ADD(v, 0x4E, 0xF); v = DPP_ADD(v, 0x141, 0xF); v = DPP_ADD(v, 0x140, 0xF);
      ss[r] = v + __shfl_xor(v, 16, 64);
    }
    float gc[6];
#pragma unroll
    for (int b = 0; b < 6; ++b) gc[b] = gq[b * 32 + r32];
#pragma unroll
    for (int r = 0; r < 16; ++r) {
      const int row = m0 + crow(r, hi); const int seq = row / TP, rr = row % TP; int pos = rr - PADR; pos = pos < 0 ? 0 : pos;
      const float rs = rsqrtf(ss[r] * (1.f / 192.f) + EPS);
      const float c = rope[pos * 64 + r32], s = rope[pos * 64 + 32 + r32];
      float x[6];
#pragma unroll
      for (int b = 0; b < 6; ++b) x[b] = acc[0][b][r] * rs * gc[b];
      const float x1 = x[4] * c - x[5] * s, x2 = x[5] * c + x[4] * s; x[4] = x1; x[5] = x2;
      u16* dst = Q + ((long)(seq * 16 + head) * TP + rr) * 192;
#pragma unroll
      for (int b = 0; b < 6; ++b) dst[b * 32 + r32] = f2bf(x[b]);
    }
  } };

struct EpiKV { const float *rowst, *gk, *kper; u16 *Kd, *Vd;
  DI void operator()(f32x16 (&acc)[1][4], int m0, int n0, int lane) const {
    const int r32 = lane & 31, hi = lane >> 5, head = n0 >> 8, isv = (n0 >> 7) & 1;
    if (isv) {
#pragma unroll
      for (int r = 0; r < 16; ++r) {
        const int row = m0 + crow(r, hi); const int seq = row / TP, rr = row % TP; const float rk = rowst[row * 4 + 1];
        u16* vd = Vd + ((long)(seq * 16 + head) * TP + rr) * 128;
#pragma unroll
        for (int b = 0; b < 4; ++b) vd[b * 32 + r32] = f2bf(acc[0][b][r] * rk);
      }
      return;
    }
    float ss[16];
#pragma unroll
    for (int r = 0; r < 16; ++r) {
      const int row = m0 + crow(r, hi); const float rk = rowst[row * 4 + 1]; float s = 0.f;
#pragma unroll
      for (int b = 0; b < 4; ++b) { acc[0][b][r] *= rk; s += acc[0][b][r] * acc[0][b][r]; }
      ss[r] = s;
    }
#pragma unroll
    for (int r = 0; r < 16; ++r) {
      float v = ss[r];
      v = DPP_ADD(v, 0xB1, 0xF); v = DPP_ADD(v, 0x4E, 0xF); v = DPP_ADD(v, 0x141, 0xF); v = DPP_ADD(v, 0x140, 0xF);
      ss[r] = v + __shfl_xor(v, 16, 64);
    }
    float gc[4];
#pragma unroll
    for (int b = 0; b < 4; ++b) gc[b] = gk[b * 32 + r32];
#pragma unroll
    for (int r = 0; r < 16; ++r) {
      const int row = m0 + crow(r, hi); const int seq = row / TP, rr = row % TP;
      const float rs = rsqrtf((ss[r] + rowst[row * 4 + 2]) * (1.f / 192.f) + EPS);
      u16* kd = Kd + ((long)(seq * 16 + head) * TP + rr) * 192;
#pragma unroll
      for (int b = 0; b < 4; ++b) kd[b * 32 + r32] = f2bf(acc[0][b][r] * rs * gc[b]);
      kd[128 + r32] = f2bf(kper[(long)row * 64 + r32] * rs);
      kd[160 + r32] = f2bf(kper[(long)row * 64 + 32 + r32] * rs);
    }
  } };

struct EpiMout { float* out; int g;
  DI void operator()(f32x16 (&acc)[2][2], int m0, int n0, int lane) const {
    const int r32 = lane & 31, hi = lane >> 5;
#pragma unroll
    for (int a = 0; a < 2; ++a)
#pragma unroll
      for (int r = 0; r < 16; ++r) {
        const int row = m0 + a * 32 + crow(r, hi);
        const int seq = row / TP, rr = row % TP, pos = rr - PADR, sg = g * GS + seq;
        if (pos < 16) continue;
        float* dst = out + ((long)sg * SEQ + pos - 16) * D;
#pragma unroll
        for (int b = 0; b < 2; ++b) { const int col = n0 + b * 32 + r32; dst[col] += acc[a][b][r]; }
      }
  } };

template <int WM, int WN, int MT, int NT, class Epi>
DI void gemm_phase(const u16* A, int lda, const u16* Bt, int ldb, int K, int Npad, char* lds, const Epi& epi) {
  constexpr int BM = WM * MT * 32, BN = WN * NT * 32;
  constexpr int nM = GR / BM;
  const int nN = Npad / BN, total = nM * nN;
  if (gridDim.x == 256 && nM == 65) {
    const int vb = vbid(lds), x = vb >> 5, lb = vb & 31, full = 64 * nN;
    for (int i = 0;; ++i) {
      const int L = (i * 8 + x) * 32 + lb;
      if (L >= total) break;
      int tm, tn;
      if (L < full) { const int panel = L / (4 * nN), w = L % (4 * nN); tn = w >> 2; tm = panel * 4 + (w & 3); }
      else { tm = 64; tn = L - full; }
      gemm_tile<WM, WN, MT, NT, Epi>(A, lda, Bt, ldb, K, tm * BM, tn * BN, lds, epi);
    }
  } else {
    for (int t = blockIdx.x; t < total; t += gridDim.x) {
      const int tm = t % nM, tn = t / nM;
      gemm_tile<WM, WN, MT, NT, Epi>(A, lda, Bt, ldb, K, tm * BM, tn * BN, lds, epi);
    }
  }
}

#include <hip/hip_runtime.h>
namespace pg8 {
#define PG8_LAS __attribute__((address_space(3)))
typedef unsigned short bf16_t;
typedef short bf16x8 __attribute__((ext_vector_type(8)));
typedef float f32x4 __attribute__((ext_vector_type(4)));
typedef unsigned u32x4 __attribute__((ext_vector_type(4)));
constexpr int BM = 256, BK = 64, HALF = 128, HTB = HALF * BK * 2  , STAGE_BYTES = 8 * HTB, NXCD = 8, WGM = 8;

__host__ __device__ __forceinline__ int lds_byte(int r, int c) { const int st = (r >> 4) * 2 + (c >> 5), rr = r & 15, cc = c & 31, ob = rr * 64 + cc * 2; return st * 1024 + (ob ^ (((ob >> 9) & 1) << 5)); }
__host__ __device__ __forceinline__ void stage_rc(int b, int& R, int& C) { const int st = b / 1024, sb = b % 1024, swz = sb ^ (((sb >> 9) & 1) << 5); R = (st >> 1) * 16 + swz / 64; C = (st & 1) * 32 + (swz % 64) / 2; }
__host__ __device__ __forceinline__ int perm32(int rho) { const int n = rho >> 4, i = rho & 15; return 8 * (i >> 2) + 4 * n + (i & 3); }

struct Unit { int pm, pn; };
struct Gemm { const bf16_t* A; const bf16_t* Bt; int M, N, K; };

struct StaticOrder {
    int nM, nN, nwg, G, c;
    __host__ __device__ void init(int M, int N, int G_, int c_) { nM = M / BM; nN = N / BM; nwg = nM * nN; G = G_; c = c_; }
    __host__ __device__ bool next(int i, Unit& u) const {
        const long L = (long)i * G + c; if (L >= nwg) return false;
        int wgid = (int)L; { const int q = nwg / NXCD, r = nwg % NXCD, xcd = wgid % NXCD, off = wgid / NXCD; wgid = (xcd < r ? xcd * (q + 1) : r * (q + 1) + (xcd - r) * q) + off; }
        const int nig = WGM * nN, gid = wgid / nig, fm = gid * WGM, gsz = (nM - fm) < WGM ? (nM - fm) : WGM;
        u.pm = fm + ((wgid % nig) % gsz); u.pn = (wgid % nig) / gsz; return true;
    }
    __device__ __forceinline__ void a_ready(const Unit&) const {}
    __device__ __forceinline__ void done(const Unit&) const {}
};

struct EpiGinT { static constexpr bool PERM = true, AFTER_DRAIN = false; u16 *P, *HALO, *Z; float* BA;
  DI void operator()(const f32x4 (&acc)[2][2][4][2], const Unit& u, int wr, int wc, int fr, int fq) const {
#pragma unroll
    for (int ai = 0; ai < 2; ++ai)
#pragma unroll
      for (int m = 0; m < 4; ++m) { const int row = u.pm * 256 + ai * 128 + wr * 64 + m * 16 + fr; const int rm = row & 63;
#pragma unroll
        for (int bj = 0; bj < 2; ++bj) { const int col = u.pn * 256 + bj * 128 + wc * 32 + 8 * fq; const f32x4 v0 = acc[ai][bj][m][0], v1 = acc[ai][bj][m][1];
          if (col < 6144) { ::u32x4 w = {pk2(v0[0], v0[1]), pk2(v0[2], v0[3]), pk2(v1[0], v1[1]), pk2(v1[2], v1[3])};
            if (col < 4096) { *(::u32x4*)(P + (long)row * 4096 + col) = w;
              if (rm < 2 || rm >= 62) *(::u32x4*)(HALO + ((long)(row >> 6) * 4 + (rm < 2 ? rm : rm - 60)) * 4096 + col) = w; }
            else *(::u32x4*)(Z + (long)row * 2048 + col - 4096) = w; }
          else if (col < GIN) { float* d = BA + (long)row * 32 + col - 6144; *(f32x4*)d = v0; *(f32x4*)(d + 4) = v1; } } }
  } };
struct EpiMinT { static constexpr bool PERM = true, AFTER_DRAIN = false; u16 *CQ, *CKV, *Z; float* KPE;
  DI void operator()(const f32x4 (&acc)[2][2][4][2], const Unit& u, int wr, int wc, int fr, int fq) const {
#pragma unroll
    for (int ai = 0; ai < 2; ++ai)
#pragma unroll
      for (int m = 0; m < 4; ++m) { const int row = u.pm * 256 + ai * 128 + wr * 64 + m * 16 + fr;
#pragma unroll
        for (int bj = 0; bj < 2; ++bj) { const int col = u.pn * 256 + bj * 128 + wc * 32 + 8 * fq; const f32x4 v0 = acc[ai][bj][m][0], v1 = acc[ai][bj][m][1];
          ::u32x4 w = {pk2(v0[0], v0[1]), pk2(v0[2], v0[3]), pk2(v1[0], v1[1]), pk2(v1[2], v1[3])};
          if (col < 512) *(::u32x4*)(CQ + (long)row * 512 + col) = w;
          else if (col < 768) *(::u32x4*)(CKV + (long)row * 256 + col - 512) = w;
          else if (col < 832) { float* d = KPE + (long)row * 64 + col - 768; *(f32x4*)d = v0; *(f32x4*)(d + 4) = v1; }
          else if (col < MIN_) *(::u32x4*)(Z + (long)row * 2048 + col - 832) = w; } }
  } };
struct EpiGoutT { static constexpr bool PERM = false, AFTER_DRAIN = false; Params p; int g; float* h1m;
  DI void operator()(const f32x4 (&acc)[2][2][4][2], const Unit& u, int wr, int wc, int fr, int fq) const {
#pragma unroll
    for (int ai = 0; ai < 2; ++ai)
#pragma unroll
      for (int m = 0; m < 4; ++m) { const int row = u.pm * 256 + ai * 128 + wr * 64 + m * 16 + fr;
        const int seq = row / TP, rr = row % TP, pos = rr - PADR, sg = g * GS + seq;
        if (pos < 0) continue;
        const float* h0 = h0_row(p, sg, pos);
        float* dst = pos < 16 ? h1m + ((long)sg * 16 + pos) * D : p.out + ((long)sg * SEQ + pos - 16) * D;
#pragma unroll
        for (int bj = 0; bj < 2; ++bj)
#pragma unroll
          for (int n = 0; n < 2; ++n) { const int col = u.pn * 256 + bj * 128 + wc * 32 + 16 * n + 4 * fq;
            *(f32x4*)(dst + col) = *(const f32x4*)(h0 + col) + acc[ai][bj][m][n]; } }
  } };
struct EpiMoutT { static constexpr bool PERM = false, AFTER_DRAIN = false; float* out; int g;
  DI void operator()(const f32x4 (&acc)[2][2][4][2], const Unit& u, int wr, int wc, int fr, int fq) const {
#pragma unroll
    for (int ai = 0; ai < 2; ++ai)
#pragma unroll
      for (int m = 0; m < 4; ++m) { const int row = u.pm * 256 + ai * 128 + wr * 64 + m * 16 + fr;
        float* dst = out + ((long)(g * GS) * SEQ + row) * D;
#pragma unroll
        for (int bj = 0; bj < 2; ++bj)
#pragma unroll
          for (int n = 0; n < 2; ++n) { const int col = u.pn * 256 + bj * 128 + wc * 32 + 16 * n + 4 * fq;
            *(f32x4*)(dst + col) = *(const f32x4*)(dst + col) + acc[ai][bj][m][n]; } }
  } };

template <class Epi, class Sched, bool STAMP = false>
__device__ __forceinline__ void gemm_phase(PG8_LAS unsigned char* lds, const Gemm g, const Sched& S, const Epi& E, unsigned long long* stamps) {
    const int tid = otid(), wid = __builtin_amdgcn_readfirstlane(tid >> 6), lane = tid & 63, wr = wid >> 2, wc = wid & 3, fr = lane & 15, fq = lane >> 4;
    const int K = g.K, nt = K / BK;
    int ts_lo = 0, ts_hi = 0, nts = 0; const unsigned long long rt_entry = STAMP ? (unsigned long long)wall_clock64() : 0ull;
#define PG8_STAMP() do { if (STAMP && wid == 0 && nts < 64) { const unsigned long long _c = (unsigned long long)clock64(); \
        ts_lo = (lane == nts) ? (int)(unsigned)_c : ts_lo; ts_hi = (lane == nts) ? (int)(unsigned)(_c >> 32) : ts_hi; ++nts; } } while (0)
    PG8_STAMP();
    unsigned voffA[2], voffB[2];
#pragma unroll
    for (int i = 0; i < 2; ++i) { int R, C; stage_rc(tid * 16 + i * 8192, R, C); const int Rb = Epi::PERM ? ((R & ~31) + perm32(R & 31)) : R;
        voffA[i] = (unsigned)(R * K + C) * 2u; voffB[i] = (unsigned)(Rb * K + C) * 2u; }
    const size_t kstep = (size_t)(BK * 2);
    const size_t hstep = (size_t)HALF * K * 2;
    const size_t tstep = 2 * hstep;
    const unsigned ldsw = (unsigned)wid * 1024u;
    const int aoff = lds_byte(wr * 64 + fr, fq * 8), boff = lds_byte(wc * 32 + fr, fq * 8);
#define PG8_SA(b, h) (((b) * 2 + (h)) * HTB)
#define PG8_SB(b, h) ((4 + (b) * 2 + (h)) * HTB)
#define PG8_STAGE(bufoff, gbase, voff) do { _Pragma("unroll") for (int _i = 0; _i < 2; ++_i) \
        __builtin_amdgcn_global_load_lds((const unsigned*)((const char*)(gbase) + (voff)[_i]), (PG8_LAS unsigned*)(lds + (bufoff) + ldsw + _i * 8192), 16, 0, 0); } while (0)
#define PG8_LDA(dst, b, h) do { _Pragma("unroll") for (int m = 0; m < 4; ++m) _Pragma("unroll") for (int k = 0; k < 2; ++k) dst[m][k] = *(const PG8_LAS bf16x8*)(lds + PG8_SA(b, h) + aoff + m * 2048 + k * 1024); } while (0)
#define PG8_LDB(dst, b, h) do { _Pragma("unroll") for (int n = 0; n < 2; ++n) _Pragma("unroll") for (int k = 0; k < 2; ++k) dst[n][k] = *(const PG8_LAS bf16x8*)(lds + PG8_SB(b, h) + boff + n * 2048 + k * 1024); } while (0)
#define PG8_MMA(ai, bj, At, Bt) do { __builtin_amdgcn_s_setprio(1); _Pragma("unroll") for (int m = 0; m < 4; ++m) _Pragma("unroll") for (int n = 0; n < 2; ++n) _Pragma("unroll") for (int k = 0; k < 2; ++k) \
        acc[ai][bj][m][n] = __builtin_amdgcn_mfma_f32_16x16x32_bf16(Bt[n][k], At[m][k], acc[ai][bj][m][n], 0, 0, 0); __builtin_amdgcn_s_setprio(0); } while (0)
#define PG8_WAIT_V(n) asm volatile("s_waitcnt vmcnt(" #n ")" ::: "memory")
#define PG8_WAIT_L(n) asm volatile("s_waitcnt lgkmcnt(" #n ")" ::: "memory")
#define PG8_BAR __builtin_amdgcn_s_barrier()
#define PG8_SCHED __builtin_amdgcn_sched_barrier(0)
    Unit cur, nxt; int ui = 0;
    if (!S.next(0, cur)) return;
    f32x4 acc[2][2][4][2];
#pragma unroll
    for (int a = 0; a < 2; ++a)
#pragma unroll
        for (int b = 0; b < 2; ++b)
#pragma unroll
            for (int m = 0; m < 4; ++m)
#pragma unroll
                for (int n = 0; n < 2; ++n) acc[a][b][m][n] = (f32x4){0.f, 0.f, 0.f, 0.f};
    bf16x8 At[4][2], B0[2][2], B1[2][2];
    const char* cA = (const char*)g.A + (size_t)cur.pm * tstep; const char* cB = (const char*)g.Bt + (size_t)cur.pn * tstep;
    S.a_ready(cur);
    PG8_STAGE(PG8_SB(0, 0), cB, voffB); PG8_STAGE(PG8_SA(0, 0), cA, voffA); PG8_STAGE(PG8_SB(0, 1), cB + hstep, voffB); PG8_STAGE(PG8_SA(0, 1), cA + hstep, voffA);
    if (wr == 1) PG8_BAR;
    PG8_WAIT_V(4); PG8_BAR;
    PG8_STAGE(PG8_SB(1, 0), cB + kstep, voffB); PG8_STAGE(PG8_SA(1, 0), cA + kstep, voffA); PG8_STAGE(PG8_SB(1, 1), cB + hstep + kstep, voffB);
    PG8_WAIT_V(6); PG8_BAR;
    PG8_STAMP();
    for (;;) {
        const bool has_next = S.next(ui + 1, nxt);
        const char* nA = has_next ? (const char*)g.A + (size_t)nxt.pm * tstep : cA; const char* nB = has_next ? (const char*)g.Bt + (size_t)nxt.pn * tstep : cB;
        for (int t = 0; t < nt; t += 2) {
            const bool last = (t == nt - 2);
            const char* a1 = cA + (size_t)(t + 1) * kstep;
            const char* a2 = last ? nA : cA + (size_t)(t + 2) * kstep; const char* b2 = last ? nB : cB + (size_t)(t + 2) * kstep;
            const char* a3 = a2 + kstep; const char* b3 = b2 + kstep;
            if (last && has_next) S.a_ready(nxt);
            PG8_LDB(B0, 0, 0); PG8_SCHED; PG8_LDA(At, 0, 0); PG8_STAGE(PG8_SA(1, 1), a1 + hstep, voffA);
            PG8_WAIT_L(8); PG8_BAR; PG8_WAIT_L(0); PG8_MMA(0, 0, At, B0); PG8_BAR; PG8_SCHED;
            PG8_LDB(B1, 0, 1); PG8_STAGE(PG8_SB(0, 0), b2, voffB);
            PG8_BAR; PG8_WAIT_L(0); PG8_MMA(0, 1, At, B1); PG8_BAR;
            PG8_LDA(At, 0, 1); PG8_STAGE(PG8_SA(0, 0), a2, voffA);
            PG8_BAR; PG8_WAIT_L(0); PG8_MMA(1, 0, At, B0); PG8_BAR; PG8_SCHED;
            PG8_STAGE(PG8_SB(0, 1), b2 + hstep, voffB);
            PG8_WAIT_V(6); PG8_BAR; PG8_MMA(1, 1, At, B1); PG8_BAR;
            PG8_LDB(B0, 1, 0); PG8_SCHED; PG8_LDA(At, 1, 0); PG8_STAGE(PG8_SA(0, 1), a2 + hstep, voffA);
            PG8_WAIT_L(8); PG8_BAR; PG8_WAIT_L(0); PG8_MMA(0, 0, At, B0); PG8_BAR; PG8_SCHED;
            PG8_LDB(B1, 1, 1); PG8_STAGE(PG8_SB(1, 0), b3, voffB);
            PG8_BAR; PG8_WAIT_L(0); PG8_MMA(0, 1, At, B1); PG8_BAR;
            PG8_LDA(At, 1, 1); PG8_STAGE(PG8_SA(1, 0), a3, voffA);
            PG8_BAR; PG8_WAIT_L(0); PG8_MMA(1, 0, At, B0); PG8_BAR; PG8_SCHED;
            PG8_STAGE(PG8_SB(1, 1), b3 + hstep, voffB);
            PG8_WAIT_V(6); PG8_BAR; PG8_MMA(1, 1, At, B1); PG8_BAR;
        }
        PG8_STAMP();
        if constexpr (!Epi::AFTER_DRAIN) { E(acc, cur, wr, wc, fr, fq); S.done(cur); }
        PG8_STAMP();
        if (!has_next) break;
#pragma unroll
        for (int a = 0; a < 2; ++a)
#pragma unroll
            for (int b = 0; b < 2; ++b)
#pragma unroll
                for (int m = 0; m < 4; ++m)
#pragma unroll
                    for (int n = 0; n < 2; ++n) acc[a][b][m][n] = (f32x4){0.f, 0.f, 0.f, 0.f};
        cur = nxt; cA = nA; cB = nB; ++ui;
    }
    PG8_WAIT_V(0);
    if (wr == 0) PG8_BAR;
    PG8_BAR;
    if constexpr (Epi::AFTER_DRAIN) { E.fused(acc, cur, wr, wc, fr, fq, lds, wid, lane); S.done(cur); }
    PG8_STAMP();
    if (STAMP && wid == 0) { stamps[lane] = lane < nts ? (((unsigned long long)(unsigned)ts_hi << 32) | (unsigned)ts_lo) : 0ull;
        if (lane == 62) stamps[62] = rt_entry; if (lane == 63) stamps[63] = (unsigned long long)wall_clock64(); }
#undef PG8_STAMP
#undef PG8_SA
#undef PG8_SB
#undef PG8_STAGE
#undef PG8_LDA
#undef PG8_LDB
#undef PG8_MMA
#undef PG8_WAIT_V
#undef PG8_WAIT_L
#undef PG8_BAR
#undef PG8_SCHED
}
}

#define LDM4(X, ROW0, B) do { \
    asm volatile("ds_read_b128 %0, %1 offset:%2" : "=v"(X##0) : "v"(mbase), "n"(((ROW0) + 0) * 256 + (B) * 4) : "memory"); \
    asm volatile("ds_read_b128 %0, %1 offset:%2" : "=v"(X##1) : "v"(mbase), "n"(((ROW0) + 1) * 256 + (B) * 4) : "memory"); \
    asm volatile("ds_read_b128 %0, %1 offset:%2" : "=v"(X##2) : "v"(mbase), "n"(((ROW0) + 2) * 256 + (B) * 4) : "memory"); \
    asm volatile("ds_read_b128 %0, %1 offset:%2" : "=v"(X##3) : "v"(mbase), "n"(((ROW0) + 3) * 256 + (B) * 4) : "memory"); } while (0)
#define WAITM(N, X) asm volatile("s_waitcnt lgkmcnt(" #N ")" : "+v"(X##0), "+v"(X##1), "+v"(X##2), "+v"(X##3) :: "memory")
#define FMA4(X, B) do { \
    c0 = fmaf(-X##0[0], t[(B)], c0); c1 = fmaf(-X##1[0], t[(B)], c1); c2 = fmaf(-X##2[0], t[(B)], c2); c3 = fmaf(-X##3[0], t[(B)], c3); \
    c0 = fmaf(-X##0[1], t[(B) + 1], c0); c1 = fmaf(-X##1[1], t[(B) + 1], c1); c2 = fmaf(-X##2[1], t[(B) + 1], c2); c3 = fmaf(-X##3[1], t[(B) + 1], c3); \
    c0 = fmaf(-X##0[2], t[(B) + 2], c0); c1 = fmaf(-X##1[2], t[(B) + 2], c1); c2 = fmaf(-X##2[2], t[(B) + 2], c2); c3 = fmaf(-X##3[2], t[(B) + 2], c3); \
    c0 = fmaf(-X##0[3], t[(B) + 3], c0); c1 = fmaf(-X##1[3], t[(B) + 3], c1); c2 = fmaf(-X##2[3], t[(B) + 3], c2); c3 = fmaf(-X##3[3], t[(B) + 3], c3); } while (0)
template <int KB, int JB> struct SolveStep {
  static DI void run(float (&t)[64], int mbase, float& c0, float& c1, float& c2, float& c3, f32x4& A0, f32x4& A1, f32x4& A2, f32x4& A3, f32x4& B0, f32x4& B1, f32x4& B2, f32x4& B3) {
    if constexpr (JB < KB) {
      if constexpr (JB + 1 < KB) { LDM4(B, KB * 4, (JB + 1) * 4); WAITM(4, A); } else { WAITM(0, A); }
      FMA4(A, JB * 4);
      SolveStep<KB, JB + 1>::run(t, mbase, c0, c1, c2, c3, B0, B1, B2, B3, A0, A1, A2, A3);
    }
  }
};
template <int KB> DI void solve_block_r(float (&t)[64], int mbase, int lane) {
  constexpr int a0 = KB * 4;
  float c0 = (a0 + 0 == lane) ? 1.f : 0.f, c1 = (a0 + 1 == lane) ? 1.f : 0.f, c2 = (a0 + 2 == lane) ? 1.f : 0.f, c3 = (a0 + 3 == lane) ? 1.f : 0.f;
  f32x4 D0, D1, D2, D3, A0, A1, A2, A3, B0, B1, B2, B3;
  LDM4(D, a0, a0);
  if constexpr (KB > 0) { LDM4(A, a0, 0); }
  SolveStep<KB, 0>::run(t, mbase, c0, c1, c2, c3, A0, A1, A2, A3, B0, B1, B2, B3);
  WAITM(0, D);
  c1 = fmaf(-D1[0], c0, c1);
  c2 = fmaf(-D2[0], c0, c2); c2 = fmaf(-D2[1], c1, c2);
  c3 = fmaf(-D3[0], c0, c3); c3 = fmaf(-D3[1], c1, c3); c3 = fmaf(-D3[2], c2, c3);
  t[a0] = c0; t[a0 + 1] = c1; t[a0 + 2] = c2; t[a0 + 3] = c3;
}

DI void phase_chunk(const Params& p, char* lds) {
  u16* P = (u16*)(p.ws + OFF_P); const u16* HALO = (const u16*)(p.ws + OFF_HALO);
  const float* BA = (const float*)(p.ws + OFF_BA); float* SCg = (float*)(p.ws + OFF_SC);
  u16* TQg = (u16*)(p.ws + OFF_TQ); u16* KTg = (u16*)(p.ws + OFF_KT);
  char* Qs = lds; char* Ks = lds + 16384; float* M0 = (float*)(lds + 32768);
  float* sbeta = (float*)(lds + 98304); float* sg = sbeta + 128; float* sgc = sg + 128;
  const int tid0 = otid();
  for (int item = blockIdx.x; item < GS * 8 * NCHUNK; item += gridDim.x) {
    int tid = tid0; asm volatile("" : "+v"(tid));
    const int lane = tid & 63, wid = tid >> 6, cp = tid & 255, rh = tid >> 8, part = (tid >> 6) & 3;
    const int ch = cp * 2;
    const int chunk = item % NCHUNK, h = (item / NCHUNK) % 8, seq = item / (NCHUNK * 8);
    const int col = ch < 128 ? h * 128 + ch : (ch < 256 ? 1024 + h * 128 + (ch - 128) : 2048 + h * 256 + (ch - 256));
    const int R0 = seq * TP + chunk * 64, cg_ = seq * NCHUNK + chunk;
    unsigned outv[32];
    {
      float w0[5], w1[5];
#pragma unroll
      for (int j = 0; j < 5; ++j) { w0[j] = p.g_conv[j * 4096 + col]; w1[j] = p.g_conv[j * 4096 + col + 1]; }
      unsigned x[36];
#pragma unroll
      for (int i = 0; i < 36; ++i) {
        const int rr = rh * 32 + i - 2;
        unsigned v = 0u;
        if (rr >= 0 && rr < 64) v = *(const unsigned*)(P + (long)(R0 + rr) * 4096 + col);
        else if (rr < 0) { if (cg_ > 0) v = *(const unsigned*)(HALO + ((long)(cg_ - 1) * 4 + 2 + (rr + 2)) * 4096 + col); }
        else { if (cg_ + 1 < GS * NCHUNK) v = *(const unsigned*)(HALO + ((long)(cg_ + 1) * 4 + (rr - 64)) * 4096 + col); }
        x[i] = v;
      }
#pragma unroll
      for (int o = 0; o < 32; ++o) {
        float a0 = 0.f, a1 = 0.f;
#pragma unroll
        for (int j = 0; j < 5; ++j) { a0 += w0[j] * bflo(x[o + j]); a1 += w1[j] * bfhi(x[o + j]); }
        a0 = silu(a0); a1 = silu(a1);
        if (part < 2) {
          float ss = wave_sum(a0 * a0 + a1 * a1);
          float sc = rsqrtf(ss + EPS) * (part == 0 ? 0.08838834764831845f : 1.f);
          a0 *= sc; a1 *= sc;
        }
        const int row = rh * 32 + o;
        if (chunk == 0 && row < PADR) { a0 = 0.f; a1 = 0.f; }
        outv[o] = pk2(a0, a1);
        if ((o & 3) == 3) SBAR();
      }
    }
    __syncthreads();
#pragma unroll
    for (int o = 0; o < 32; ++o) *(unsigned*)(P + (long)(R0 + rh * 32 + o) * 4096 + col) = outv[o];
    if (part < 2) {
      char* dstT = part == 0 ? Qs : Ks; const int chl = ch - part * 128;
#pragma unroll
      for (int o = 0; o < 32; ++o) { const int row = rh * 32 + o;
        *(unsigned*)(dstT + row * 256 + ((((chl >> 3) ^ (row & 7))) << 4) + (chl & 7) * 2) = outv[o]; }
      if (part == 1) {
        u16* kt = KTg + ((long)(seq * 8 + h) * NCHUNK + chunk) * 8192 + (long)chl * 64 + rh * 32;
#pragma unroll
        for (int q4 = 0; q4 < 4; ++q4) {
          u32x4 lo, hi4;
#pragma unroll
          for (int e = 0; e < 4; ++e) { const unsigned a = outv[q4 * 8 + 2 * e], b = outv[q4 * 8 + 2 * e + 1];
            lo[e] = (a & 0xffffu) | (b << 16); hi4[e] = (a >> 16) | (b & 0xffff0000u); }
          *(u32x4*)(kt + q4 * 8) = lo; *(u32x4*)(kt + 64 + q4 * 8) = hi4;
          SBAR();
        }
      }
    }
    if (tid < 128) {
      const int r = tid & 63, dir = tid >> 6; const long row = R0 + r;
      const float b = BA[row * 32 + dir * 8 + h], a = BA[row * 32 + 16 + dir * 8 + h];
      float beta = 1.f / (1.f + __expf(-b));
      float xx = a + p.g_dtb[dir * 8 + h];
      float sp = xx > 20.f ? xx : __logf(1.f + __expf(xx));
      float gg = -__expf(p.g_alog[dir * 8 + h]) * sp;
      if (chunk == 0 && r < PADR) { beta = 0.f; gg = 0.f; }
      float gc = gg;
#pragma unroll
      for (int off = 1; off < 64; off <<= 1) {
        const float up = __shfl_up(gc, off, 64), dn = __shfl_down(gc, off, 64);
        if (dir == 0) { if (r >= off) gc += up; } else { if (r + off < 64) gc += dn; }
      }
      const float gl = __shfl(gc, dir == 0 ? 63 : 0, 64);
      sbeta[dir * 64 + r] = beta; sgc[dir * 64 + r] = gc;
      f32x4 st = {beta, __expf(gc), __expf(gl - gc), __expf(gl)};
      *(f32x4*)(SCg + ((long)((seq * 8 + h) * 2 + dir) * TP + chunk * 64 + r) * 4) = st;
    }
    __syncthreads();
    {
      const int kind = wid >> 2, qi = (wid >> 1) & 1, qj = wid & 1;
      int r32 = lane & 31, hi = lane >> 5;
      asm volatile("" : "+v"(r32), "+v"(hi));
      const char* At = kind ? Qs : Ks;
      f32x16 acc;
#pragma unroll
      for (int r = 0; r < 16; ++r) acc[r] = 0.f;
#pragma unroll
      for (int ks = 0; ks < 8; ++ks) {
        const int c = ks * 2 + hi; const int ra = qi * 32 + r32, rb = qj * 32 + r32;
        bf16x8 af = *(const bf16x8*)(At + ra * 256 + ((c ^ (ra & 7)) << 4));
        bf16x8 bfr = *(const bf16x8*)(Ks + rb * 256 + ((c ^ (rb & 7)) << 4));
        acc = __builtin_amdgcn_mfma_f32_32x32x16_bf16(af, bfr, acc, 0, 0, 0);
        if (ks & 1) SBAR();
      }
      const int j = qj * 32 + r32;
      u16* Ag0 = TQg + ((long)((seq * 8 + h) * 2 + 0) * NCHUNK + chunk) * 8192 + 4096;
      u16* Ag1 = TQg + ((long)((seq * 8 + h) * 2 + 1) * NCHUNK + chunk) * 8192 + 4096;
      const float gj0 = sgc[j], gj1 = sgc[64 + j];
#pragma unroll
      for (int r = 0; r < 16; ++r) {
        const int i = qi * 32 + crow(r, hi);
        const float e0 = __expf(fminf(sgc[i] - gj0, 0.f)), e1 = __expf(fminf(sgc[64 + i] - gj1, 0.f));
        if (kind == 0) {
          M0[i * 64 + j] = j < i ? sbeta[i] * acc[r] * e0 : 0.f;
          M0[4096 + (63 - i) * 64 + (63 - j)] = j > i ? sbeta[64 + i] * acc[r] * e1 : 0.f;
        } else {
          Ag0[i * 64 + j] = f2bf(j <= i ? acc[r] * e0 : 0.f);
          Ag1[i * 64 + j] = f2bf(j >= i ? acc[r] * e1 : 0.f);
        }
        SBAR();
      }
    }
    __syncthreads();
    if (wid < 2) {
      const int d = wid; const float* M = M0 + d * 4096; float* Tl = M0 + 8192 + d * 4096;
      float t[64];
      const int mbase = (int)(uintptr_t)M;
      solve_block_r<0>(t, mbase, lane); solve_block_r<1>(t, mbase, lane); solve_block_r<2>(t, mbase, lane); solve_block_r<3>(t, mbase, lane);
      solve_block_r<4>(t, mbase, lane); solve_block_r<5>(t, mbase, lane); solve_block_r<6>(t, mbase, lane); solve_block_r<7>(t, mbase, lane);
      solve_block_r<8>(t, mbase, lane); solve_block_r<9>(t, mbase, lane); solve_block_r<10>(t, mbase, lane); solve_block_r<11>(t, mbase, lane);
      solve_block_r<12>(t, mbase, lane); solve_block_r<13>(t, mbase, lane); solve_block_r<14>(t, mbase, lane); solve_block_r<15>(t, mbase, lane);
      u16* Tg = TQg + ((long)((seq * 8 + h) * 2 + d) * NCHUNK + chunk) * 8192;
      const int tbase = d ? 63 * 64 + 63 - lane : lane, tstride = d ? -64 : 64;
#pragma unroll
      for (int a = 0; a < 64; ++a) Tg[tbase + a * tstride] = f2bf(t[a]);
    }
  }
}

DI bf16x8 pack8(f32x4 a, f32x4 b) { u32x4 w = {pk2(a[0], a[1]), pk2(a[2], a[3]), pk2(b[0], b[1]), pk2(b[2], b[3])}; return __builtin_bit_cast(bf16x8, w); }
DI bf16x8 ld_frag(const char* ptr) { u32x2 lo = *(const u32x2*)ptr; u32x2 hi = *(const u32x2*)(ptr + 32); u32x4 w = {lo[0], lo[1], hi[0], hi[1]}; return __builtin_bit_cast(bf16x8, w); }
#define MFMA16(a, b, c) __builtin_amdgcn_mfma_f32_16x16x32_bf16((a), (b), (c), 0, 0, 0)
constexpr int SB_Q = 0, SB_K = 17408, SB_KT = 34816, SB_T = 53248, SB_A = 62464, SB_V = 71680, SB_SC = 79872, SB_SIZE = 80896;

struct ScanRegs { u32x4 rq[4], rk[4], rkt[4], rt[2], ra[2], rv[2]; f32x4 rs; };
DI void scan_issue(const Params& p, int seq, int h, int dir, int dvq, int cc, int lt, ScanRegs& R) {
  const u16* P = (const u16*)(p.ws + OFF_P);
  const long R0 = (long)seq * TP + cc * 64;
  const u16* Pq = P + R0 * 4096 + h * 128; const u16* Pk = Pq + 1024; const u16* Pv = P + R0 * 4096 + 2048 + h * 256 + dvq * 64;
  const u16* KTg = (const u16*)(p.ws + OFF_KT) + ((long)(seq * 8 + h) * NCHUNK + cc) * 8192;
  const u16* Tg = (const u16*)(p.ws + OFF_TQ) + ((long)((seq * 8 + h) * 2 + dir) * NCHUNK + cc) * 8192;
  const float* SCg = (const float*)(p.ws + OFF_SC) + ((long)((seq * 8 + h) * 2 + dir) * TP + cc * 64) * 4;
#pragma unroll
  for (int i = 0; i < 4; ++i) { const int e = lt + 256 * i, row = e >> 4, c = e & 15;
    R.rq[i] = *(const u32x4*)(Pq + (long)row * 4096 + c * 8); R.rk[i] = *(const u32x4*)(Pk + (long)row * 4096 + c * 8); }
#pragma unroll
  for (int i = 0; i < 4; ++i) { const int e = lt + 256 * i, row = e >> 3, c = e & 7; R.rkt[i] = *(const u32x4*)(KTg + row * 64 + c * 8); }
#pragma unroll
  for (int i = 0; i < 2; ++i) { const int e = lt + 256 * i, row = e >> 3, c = e & 7;
    R.rt[i] = *(const u32x4*)(Tg + row * 64 + c * 8); R.ra[i] = *(const u32x4*)(Tg + 4096 + row * 64 + c * 8);
    R.rv[i] = *(const u32x4*)(Pv + (long)row * 4096 + c * 8); }
  R.rs = (f32x4){0.f, 0.f, 0.f, 0.f};
  if (lt < 64) R.rs = *(const f32x4*)(SCg + lt * 4);
}
DI void scan_commit(char* B, int lt, const ScanRegs& R) {
#pragma unroll
  for (int i = 0; i < 4; ++i) { const int e = lt + 256 * i, row = e >> 4, c = e & 15;
    *(u32x4*)(B + SB_Q + row * 272 + c * 16) = R.rq[i]; *(u32x4*)(B + SB_K + row * 272 + c * 16) = R.rk[i]; }
#pragma unroll
  for (int i = 0; i < 4; ++i) { const int e = lt + 256 * i, row = e >> 3, c = e & 7; *(u32x4*)(B + SB_KT + row * 144 + c * 16) = R.rkt[i]; }
#pragma unroll
  for (int i = 0; i < 2; ++i) { const int e = lt + 256 * i, row = e >> 3, c = e & 7;
    *(u32x4*)(B + SB_T + row * 144 + c * 16) = R.rt[i]; *(u32x4*)(B + SB_A + row * 144 + c * 16) = R.ra[i];
    *(u32x4*)(B + SB_V + row * 128 + c * 16) = R.rv[i]; }
  if (lt < 64) *(f32x4*)(B + SB_SC + lt * 16) = R.rs;
}

DI void scan_compute(f32x4 (&S)[8], const char* B, u16* __restrict__ Orow, int wid, int n, int quad) {
  const char* bK = B + SB_K + n * 272 + 8 * quad; const char* bQ = B + SB_Q + n * 272 + 8 * quad;
  const char* bT = B + SB_T + n * 144 + 8 * quad; const char* bA = B + SB_A + n * 144 + 8 * quad; const char* bKT = B + SB_KT + n * 144 + 8 * quad;
  bf16x8 fa[8], fb[8];
#define LD_KQ(F, mt) do { _Pragma("unroll") for (int ks = 0; ks < 4; ++ks) { F[ks] = ld_frag(bK + (mt) * 16 * 272 + 64 * ks); F[4 + ks] = ld_frag(bQ + (mt) * 16 * 272 + 64 * ks); } } while (0)
#define LD_64(F, base) do { _Pragma("unroll") for (int mt = 0; mt < 4; ++mt) { F[2 * mt] = ld_frag(base + mt * 16 * 144); F[2 * mt + 1] = ld_frag(base + mt * 16 * 144 + 64); } } while (0)
#define GRP() do { __builtin_amdgcn_sched_group_barrier(0x100, 8, 0); __builtin_amdgcn_sched_group_barrier(0x008, 8, 0); SBAR(); } while (0)
  bf16x8 Sb[4];
#pragma unroll
  for (int ks = 0; ks < 4; ++ks) Sb[ks] = pack8(S[2 * ks], S[2 * ks + 1]);
  f32x4 KS[4], QS[4];
#pragma unroll
  for (int mt = 0; mt < 4; ++mt) { KS[mt] = (f32x4){0.f, 0.f, 0.f, 0.f}; QS[mt] = (f32x4){0.f, 0.f, 0.f, 0.f}; }
#define MM_KQ(F, mt) do { _Pragma("unroll") for (int ks = 0; ks < 4; ++ks) { KS[mt] = MFMA16(F[ks], Sb[ks], KS[mt]); QS[mt] = MFMA16(F[4 + ks], Sb[ks], QS[mt]); } } while (0)
  LD_KQ(fa, 0); SBAR();
  LD_KQ(fb, 1); MM_KQ(fa, 0); GRP();
  LD_KQ(fa, 2); MM_KQ(fb, 1); GRP();
  LD_KQ(fb, 3); MM_KQ(fa, 2); GRP();
  LD_64(fa, bT); MM_KQ(fb, 3); GRP();
  f32x4 rhs[4], o[4]; float egl = 1.f;
#pragma unroll
  for (int mt = 0; mt < 4; ++mt)
#pragma unroll
    for (int i = 0; i < 4; ++i) {
      const int row = 16 * mt + 4 * quad + i;
      const f32x4 sc = *(const f32x4*)(B + SB_SC + row * 16);
      const float v = bf2f(*(const u16*)(B + SB_V + row * 128 + (wid * 16 + n) * 2));
      egl = sc[3];
      rhs[mt][i] = sc[0] * (v - sc[1] * KS[mt][i]);
      o[mt][i] = QS[mt][i] * sc[1];
    }
  bf16x8 Rb[2];
#pragma unroll
  for (int k2 = 0; k2 < 2; ++k2) Rb[k2] = pack8(rhs[2 * k2], rhs[2 * k2 + 1]);
  SBAR();
  f32x4 VN[4];
  LD_64(fb, bA);
#pragma unroll
  for (int mt = 0; mt < 4; ++mt) { VN[mt] = (f32x4){0.f, 0.f, 0.f, 0.f}; VN[mt] = MFMA16(fa[2 * mt], Rb[0], VN[mt]); VN[mt] = MFMA16(fa[2 * mt + 1], Rb[1], VN[mt]); }
  GRP();
  bf16x8 Vb[2], Vd[2];
#pragma unroll
  for (int k2 = 0; k2 < 2; ++k2) {
    Vb[k2] = pack8(VN[2 * k2], VN[2 * k2 + 1]);
    f32x4 e0, e1;
#pragma unroll
    for (int i = 0; i < 4; ++i) { e0[i] = *(const float*)(B + SB_SC + (32 * k2 + 4 * quad + i) * 16 + 8); e1[i] = *(const float*)(B + SB_SC + (32 * k2 + 16 + 4 * quad + i) * 16 + 8); }
    Vd[k2] = pack8(VN[2 * k2] * e0, VN[2 * k2 + 1] * e1);
  }
  SBAR();
  LD_64(fa, bKT);
#pragma unroll
  for (int mt = 0; mt < 4; ++mt) { o[mt] = MFMA16(fb[2 * mt], Vb[0], o[mt]); o[mt] = MFMA16(fb[2 * mt + 1], Vb[1], o[mt]); }
  GRP();
  LD_64(fb, bKT + 64 * 144);
#pragma unroll
  for (int t = 0; t < 4; ++t) { S[t] = S[t] * egl; S[t] = MFMA16(fa[2 * t], Vd[0], S[t]); S[t] = MFMA16(fa[2 * t + 1], Vd[1], S[t]); }
  GRP();
#pragma unroll
  for (int t = 0; t < 4; ++t) { S[4 + t] = S[4 + t] * egl; S[4 + t] = MFMA16(fb[2 * t], Vd[0], S[4 + t]); S[4 + t] = MFMA16(fb[2 * t + 1], Vd[1], S[4 + t]); }
#pragma unroll
  for (int mt = 0; mt < 4; ++mt)
#pragma unroll
    for (int i = 0; i < 4; ++i) *(u16*)((char*)B + SB_V + (16 * mt + 4 * quad + i) * 128 + (wid * 16 + n) * 2) = f2bf(o[mt][i]);
#undef LD_KQ
#undef LD_64
#undef GRP
#undef MM_KQ
}

DI void phase_scan(const Params& p, char* lds) {
  for (int item = blockIdx.x; item < GS * 8 * 2 * 4; item += gridDim.x) {
    const int tid = otid(), wid = tid >> 6, lane = tid & 63, n = lane & 15, quad = lane >> 4, lt = tid - 256;
    int dvq = item & 3, tri = item >> 2;
    if (gridDim.x == 256) { const int vb = vbid(lds), x = vb >> 5, lb = vb & 31; dvq = lb & 3; tri = x + 8 * (lb >> 2); }
    const int dir = tri & 1, h = (tri >> 1) & 7, seq = tri >> 4;
    u16* O = (u16*)(p.ws + (dir ? OFF_OB : OFF_OF)) + (long)seq * TP * 2048 + h * 256 + dvq * 64 + (wid & 3) * 16 + n;
    const int wid_s = __builtin_amdgcn_readfirstlane(wid);
#define CHK(c) (dir ? NCHUNK - 1 - (c) : (c))
    if (wid_s >= 4) {
      ScanRegs LA;
      __syncthreads();
      scan_issue(p, seq, h, dir, dvq, CHK(0), lt, LA); scan_commit(lds, lt, LA); scan_issue(p, seq, h, dir, dvq, CHK(1), lt, LA);
      __syncthreads();
      u16* Og = (u16*)(p.ws + (dir ? OFF_OB : OFF_OF)) + (long)seq * TP * 2048 + h * 256 + dvq * 64;
#define OFLUSH(Bp, cc) do { _Pragma("unroll") for (int i = 0; i < 2; ++i) { const int e = lt + 256 * i, row = e >> 3, c16 = e & 7; \
          *(u32x4*)(Og + ((long)(cc) * 64 + row) * 2048 + c16 * 8) = *(const u32x4*)((Bp) + SB_V + row * 128 + c16 * 16); } } while (0)
#pragma unroll 1
      for (int c = 0; c < NCHUNK; ++c) {
        if (c > 0) OFLUSH(lds + ((c + 1) & 1) * SB_SIZE, CHK(c - 1));
        if (c + 1 < NCHUNK) scan_commit(lds + ((c + 1) & 1) * SB_SIZE, lt, LA);
        if (c + 2 < NCHUNK) scan_issue(p, seq, h, dir, dvq, CHK(c + 2), lt, LA);
        __syncthreads();
      }
      OFLUSH(lds + ((NCHUNK - 1) & 1) * SB_SIZE, CHK(NCHUNK - 1));
#undef OFLUSH
    } else {
      f32x4 S[8];
#pragma unroll
      for (int t = 0; t < 8; ++t) S[t] = (f32x4){0.f, 0.f, 0.f, 0.f};
      __builtin_amdgcn_s_setprio(2);
      __syncthreads();
      __syncthreads();
#pragma unroll 1
      for (int c = 0; c < NCHUNK; ++c) {
        scan_compute(S, lds + (c & 1) * SB_SIZE, O + (long)CHK(c) * 64 * 2048, wid, n, quad);
        __syncthreads();
      }
      __builtin_amdgcn_s_setprio(0);
    }
#undef CHK
  }
}

DI void phase_gate(const Params& p) {
  u16* OFp = (u16*)(p.ws + OFF_OF); const u16* OBp = (const u16*)(p.ws + OFF_OB); const u16* Z = (const u16*)(p.ws + OFF_Z);
  const int lane = otid() & 63, wv = otid() >> 6;
  constexpr int UN = 4;
  for (int it0 = (blockIdx.x * 8 + wv) * UN; it0 < GR * 8; it0 += gridDim.x * 8 * UN) {
    u32x2 a[UN], b[UN], z[UN];
#pragma unroll
    for (int u = 0; u < UN; ++u) { const long off = (long)(it0 + u) * 256 + lane * 4;
      a[u] = *(const u32x2*)(OFp + off); b[u] = *(const u32x2*)(OBp + off); z[u] = *(const u32x2*)(Z + off); }
#pragma unroll
    for (int u = 0; u < UN; ++u) { const long off = (long)(it0 + u) * 256 + lane * 4;
      float o0 = bflo(a[u][0]) + bflo(b[u][0]), o1 = bfhi(a[u][0]) + bfhi(b[u][0]), o2 = bflo(a[u][1]) + bflo(b[u][1]), o3 = bfhi(a[u][1]) + bfhi(b[u][1]);
      float ss = wave_sum(o0 * o0 + o1 * o1 + o2 * o2 + o3 * o3);
      float rs = rsqrtf(ss * (1.f / 256.f) + EPS);
      u32x2 w = {pk2(o0 * rs * silu(bflo(z[u][0])), o1 * rs * silu(bfhi(z[u][0]))), pk2(o2 * rs * silu(bflo(z[u][1])), o3 * rs * silu(bfhi(z[u][1])))};
      *(u32x2*)(OFp + off) = w; }
  }
}

DI void phase_rowstats(const Params& p) {
  const u16* CQ = (const u16*)(p.ws + OFF_CQ); const u16* CKV = (const u16*)(p.ws + OFF_CKV); const float* KPE = (const float*)(p.ws + OFF_KPE);
  float* rowst = (float*)(p.ws + OFF_ROWST); float* kper = (float*)(p.ws + OFF_KPER); const float* rope = (const float*)(p.ws + OFF_ROPE);
  const int lane = otid() & 63, wv = otid() >> 6;
  for (int row = blockIdx.x * 8 + wv; row < GR; row += gridDim.x * 8) {
    u32x4 q = *(const u32x4*)(CQ + (long)row * 512 + lane * 8);
    float sq = 0.f;
#pragma unroll
    for (int j = 0; j < 4; ++j) { float a = bflo(q[j]), b = bfhi(q[j]); sq += a * a + b * b; }
    u32x2 kv = *(const u32x2*)(CKV + (long)row * 256 + lane * 4);
    float sk = 0.f;
#pragma unroll
    for (int j = 0; j < 2; ++j) { float a = bflo(kv[j]), b = bfhi(kv[j]); sk += a * a + b * b; }
    const float kp = KPE[(long)row * 64 + lane];
    sq = wave_sum(sq); sk = wave_sum(sk); const float sp = wave_sum(kp * kp);
    const float val = kp * p.m_kg[128 + lane];
    const float oth = __shfl_xor(val, 32, 64);
    int pos = row % TP - PADR; pos = pos < 0 ? 0 : pos;
    const int i = lane & 31; const float c = rope[pos * 64 + i], s = rope[pos * 64 + 32 + i];
    kper[(long)row * 64 + lane] = lane < 32 ? val * c - oth * s : val * c + oth * s;
    if (lane == 0) { f32x4 st = {rsqrtf(sq * (1.f / 512.f) + EPS), rsqrtf(sk * (1.f / 256.f) + EPS), sp, 0.f}; *(f32x4*)(rowst + (long)row * 4) = st; }
  }
}

constexpr float ATT_SCALE = 0.07216878364870322f;
constexpr float ATT_THR = 8.f;
constexpr int SHM_V = 64 * 128 * 2, SHM_K = 64 * 192 * 2;
DI int v_st(int k, int c) { const int kk = (k & ~0xC) | ((k & 4) << 1) | ((k & 8) >> 1); return ((kk >> 3) * 4 + (c >> 5)) * 512 + ((kk & 7) * 32 + (c & 31)) * 2; }
DI int v_rd_base(int lane) { return ((lane & 3) << 3) | (((lane >> 2) & 3) << 6) | (((lane >> 4) & 1) << 5) | (((lane >> 5) & 1) << 8); }
constexpr int v_rd_off(int d0, int ks, int half) { return d0 * 512 + ks * 4096 + half * 2048; }
template <int OFF> DI s16x4 tr_read(int vb) {
  s16x4 r; asm volatile("ds_read_b64_tr_b16 %0, %1 offset:%2" : "=&v"(r) : "v"(vb), "i"(OFF) : "memory"); return r;
}
#define RD8(D0, X) do { X##0 = tr_read<v_rd_off(D0, 0, 0)>(vb); X##1 = tr_read<v_rd_off(D0, 0, 1)>(vb); X##2 = tr_read<v_rd_off(D0, 1, 0)>(vb); X##3 = tr_read<v_rd_off(D0, 1, 1)>(vb); \
    X##4 = tr_read<v_rd_off(D0, 2, 0)>(vb); X##5 = tr_read<v_rd_off(D0, 2, 1)>(vb); X##6 = tr_read<v_rd_off(D0, 3, 0)>(vb); X##7 = tr_read<v_rd_off(D0, 3, 1)>(vb); } while (0)
#define PKV(L, H) (bf16x8){L[0], L[1], L[2], L[3], H[0], H[1], H[2], H[3]}
#define MM4(OD, X) do { OD = __builtin_amdgcn_mfma_f32_32x32x16_bf16(pa0, PKV(X##0, X##1), OD, 0, 0, 0); OD = __builtin_amdgcn_mfma_f32_32x32x16_bf16(pa1, PKV(X##2, X##3), OD, 0, 0, 0); \
    OD = __builtin_amdgcn_mfma_f32_32x32x16_bf16(pa2, PKV(X##4, X##5), OD, 0, 0, 0); OD = __builtin_amdgcn_mfma_f32_32x32x16_bf16(pa3, PKV(X##6, X##7), OD, 0, 0, 0); } while (0)
DI void pv_all(f32x16* o, int vb, bf16x8 pa0, bf16x8 pa1, bf16x8 pa2, bf16x8 pa3) {
  s16x4 a0, a1, a2, a3, a4, a5, a6, a7;
  RD8(0, a); asm volatile("s_waitcnt lgkmcnt(0)" ::: "memory"); SBAR(); MM4(o[0], a); SBAR();
  RD8(1, a); asm volatile("s_waitcnt lgkmcnt(0)" ::: "memory"); SBAR(); MM4(o[1], a); SBAR();
  RD8(2, a); asm volatile("s_waitcnt lgkmcnt(0)" ::: "memory"); SBAR(); MM4(o[2], a); SBAR();
  RD8(3, a); asm volatile("s_waitcnt lgkmcnt(0)" ::: "memory"); SBAR(); MM4(o[3], a); SBAR();
}
#undef RD8
#undef MM4
#undef PKV

DI void attn_item(const u16* __restrict__ Qb, const u16* __restrict__ Kh, const u16* __restrict__ Vh, int q0,
                  u16* __restrict__ Yb, const u16* __restrict__ Zb, char* lds) {
  const int tid = otid(), wid = tid >> 6, lane = tid & 63, r32 = lane & 31, hi = lane >> 5;
  char* V_lds = lds; char* K_lds = lds + 3 * SHM_V;
  float* wsf = (float*)(lds + 3 * SHM_V + 3 * SHM_K) + wid * 64; float* li_l = wsf; float* al_l = wsf + 32;
  constexpr float C = ATT_SCALE * 1.4426950408889634f;
  float m_reg = -1e30f, l_reg = 0.f;
  f32x16 o[4];
#pragma unroll
  for (int d = 0; d < 4; ++d)
#pragma unroll
    for (int r = 0; r < 16; ++r) o[d][r] = 0.f;
  bf16x8 qr[12];
  const int qrow = q0 + wid * 32 + r32;
#pragma unroll
  for (int d0 = 0; d0 < 12; ++d0) {
    bf16x8 z = {0, 0, 0, 0, 0, 0, 0, 0};
    qr[d0] = qrow < TP ? *(const bf16x8*)(Qb + (long)qrow * 192 + d0 * 16 + hi * 8) : z;
  }
  const int vb0 = (int)(uintptr_t)V_lds + v_rd_base(lane);
  int koff[3], voff[2];
#pragma unroll
  for (int i = 0; i < 3; ++i) { const int P = (wid * 3 + i) * 1024 + lane * 16, row = P / 384, b = P % 384; koff[i] = row * 192 + ((b ^ ((row & 7) << 4)) >> 1); }
#pragma unroll
  for (int i = 0; i < 2; ++i) { const int P = (wid * 2 + i) * 1024 + lane * 16, sub = P >> 9, within = P & 511;
    const int kk = (sub >> 2) * 8 + (within >> 6), k = (kk & ~0xC) | ((kk & 4) << 1) | ((kk & 8) >> 1), c = (sub & 3) * 32 + ((within & 63) >> 1);
    voff[i] = k * 128 + c; }
#define GLDS16(gp, lp) __builtin_amdgcn_global_load_lds((const unsigned*)(gp), (__attribute__((address_space(3))) unsigned*)(lp), 16, 0, 0)
#define STAGE(k0, slot) do { \
    _Pragma("unroll") for (int i = 0; i < 3; ++i) GLDS16(Kh + (long)(k0) * 192 + koff[i], K_lds + (slot) * SHM_K + (wid * 3 + i) * 1024 + lane * 16); \
    _Pragma("unroll") for (int i = 0; i < 2; ++i) GLDS16(Vh + (long)(k0) * 128 + voff[i], V_lds + (slot) * SHM_V + (wid * 2 + i) * 1024 + lane * 16); } while (0)
  constexpr int NT = TP / 64;
#define ATT_QK(slot) do { \
    _Pragma("unroll") for (int r = 0; r < 16; ++r) { p0[r] = 0.f; p1[r] = 0.f; } \
    const char* Kc = K_lds + (slot) * SHM_K; const int swz = (r32 & 7) << 4; \
    const char* Kr0 = Kc + r32 * 384; const char* Kr1 = Kc + (32 + r32) * 384; \
    _Pragma("unroll") for (int d0 = 0; d0 < 12; ++d0) { const int cb = (d0 * 16 + hi * 8) * 2; \
      bf16x8 b0 = *(const bf16x8*)(Kr0 + (cb ^ swz)); bf16x8 b1 = *(const bf16x8*)(Kr1 + (cb ^ swz)); \
      p0 = __builtin_amdgcn_mfma_f32_32x32x16_bf16(b0, qr[d0], p0, 0, 0, 0); \
      p1 = __builtin_amdgcn_mfma_f32_32x32x16_bf16(b1, qr[d0], p1, 0, 0, 0); \
      if ((d0 & 1) == 1) SBAR(); } } while (0)
#define KFLOAD(G, S)
#define ATT_MASK0() do { _Pragma("unroll") for (int r = 0; r < 16; ++r) p0[r] = -1e30f; _Pragma("unroll") for (int r = 0; r < 8; ++r) p1[r] = -1e30f; } while (0)
#define PK4(PP, BASE, OUT) do { unsigned a0 = pk2(PP[BASE + 0], PP[BASE + 1]), a1 = pk2(PP[BASE + 2], PP[BASE + 3]); \
    unsigned b0 = pk2(PP[BASE + 4], PP[BASE + 5]), b1 = pk2(PP[BASE + 6], PP[BASE + 7]); \
    auto r0 = __builtin_amdgcn_permlane32_swap(a0, b0, false, false); auto r1 = __builtin_amdgcn_permlane32_swap(a1, b1, false, false); \
    u32x4 w = {r0[0], r1[0], r0[1], r1[1]}; OUT = __builtin_bit_cast(bf16x8, w); } while (0)
#define ATT_SM() do { \
    float pmax = p0[0]; \
    _Pragma("unroll") for (int r = 1; r < 16; ++r) pmax = fmaxf(pmax, p0[r]); \
    _Pragma("unroll") for (int r = 0; r < 16; ++r) pmax = fmaxf(pmax, p1[r]); \
    { auto rr = __builtin_amdgcn_permlane32_swap(__float_as_uint(pmax), __float_as_uint(pmax), false, false); \
      pmax = fmaxf(__uint_as_float(rr[0]), __uint_as_float(rr[1])); } \
    float mn, alpha; \
    if (__all(pmax - m_reg <= ATT_THR / ATT_SCALE)) { mn = m_reg; alpha = 1.f; } \
    else { mn = fmaxf(m_reg, pmax); alpha = __builtin_amdgcn_exp2f((m_reg - mn) * C); m_reg = mn; } \
    if (__any(alpha < 1.f)) { \
      if (hi == 0) al_l[r32] = alpha; \
      asm volatile("s_waitcnt lgkmcnt(0)" ::: "memory"); \
      _Pragma("unroll") for (int r = 0; r < 16; ++r) { const float a = al_l[crow(r, hi)]; \
        _Pragma("unroll") for (int d = 0; d < 4; ++d) o[d][r] *= a; } } \
    const float mnC = -mn * C; float ps = 0.f; \
    _Pragma("unroll") for (int r = 0; r < 16; ++r) { p0[r] = __builtin_amdgcn_exp2f(fmaf(p0[r], C, mnC)); p1[r] = __builtin_amdgcn_exp2f(fmaf(p1[r], C, mnC)); ps += p0[r] + p1[r]; } \
    { auto rr = __builtin_amdgcn_permlane32_swap(__float_as_uint(ps), __float_as_uint(ps), false, false); \
      ps = __uint_as_float(rr[0]) + __uint_as_float(rr[1]); } \
    l_reg = l_reg * alpha + ps; \
    PK4(p0, 0, pa0); PK4(p0, 8, pa1); PK4(p1, 0, pa2); PK4(p1, 8, pa3); } while (0)

  __syncthreads();
  STAGE(0, 0); STAGE(64, 1);
  __syncthreads();
  f32x16 p0, p1;
  bf16x8 pa0, pa1, pa2, pa3;
  const int wid_s = __builtin_amdgcn_readfirstlane(wid);
  if (wid_s < 4) {
    ATT_QK(0); ATT_MASK0(); ATT_SM();
    int sK = 1, sV = 0, sW = 2;
#pragma unroll 1
    for (int j = 1; j < NT; ++j) {
      if (j + 1 < NT) STAGE((j + 1) * 64, sW);
      pv_all(o, vb0 + sV * SHM_V, pa0, pa1, pa2, pa3);
      ATT_QK(sK);
      ATT_SM();
      sV = sK; sK = sW; sW = (sW == 2) ? 0 : sW + 1;
      __syncthreads();
    }
    pv_all(o, vb0 + sV * SHM_V, pa0, pa1, pa2, pa3);
  } else {
    ATT_QK(0); ATT_MASK0();
    int sK = 1, sV = 0, sW = 2;
#pragma unroll 1
    for (int j = 1; j < NT; ++j) {
      if (j + 1 < NT) STAGE((j + 1) * 64, sW);
      ATT_SM();
      pv_all(o, vb0 + sV * SHM_V, pa0, pa1, pa2, pa3);
      ATT_QK(sK);
      sV = sK; sK = sW; sW = (sW == 2) ? 0 : sW + 1;
      __syncthreads();
    }
    ATT_SM();
    pv_all(o, vb0 + sV * SHM_V, pa0, pa1, pa2, pa3);
  }
#undef ATT_QK
#undef KFLOAD
#undef ATT_MASK0
#undef PK4
#undef ATT_SM
#undef STAGE
#undef GLDS16
  if (hi == 0) li_l[r32] = l_reg;
  asm volatile("s_waitcnt lgkmcnt(0)" ::: "memory");
#pragma unroll
  for (int r = 0; r < 16; ++r) {
    const int orow = q0 + wid * 32 + crow(r, hi);
    const float rl = 1.f / li_l[crow(r, hi)];
    if (orow < TP) {
#pragma unroll
      for (int d0 = 0; d0 < 4; ++d0) {
        const long off = (long)orow * 2048 + d0 * 32 + r32;
        Yb[off - 64 * 2048] = f2bf(o[d0][r] * rl * silu(bf2f(Zb[off])));
      }
    }
  }
}

DI void phase_attn(const Params& p, char* lds) {
  const u16* QM = (const u16*)(p.ws + OFF_QM); const u16* KM = (const u16*)(p.ws + OFF_KM); const u16* VM = (const u16*)(p.ws + OFF_VM);
  u16* Y = (u16*)(p.ws + OFF_Y); const u16* Z = (const u16*)(p.ws + OFF_Z);
  const int b = blockIdx.x, vb = vbid(lds), x = vb >> 5, lb = vb & 31;
  if (gridDim.x == 256) {
    for (int it = 0; it < 4; ++it) {
      const int pair = x + 8 * (2 * it + (lb >> 4)), qb = lb & 15;
      const int seq = pair >> 4, head = pair & 15;
      attn_item(QM + (long)pair * TP * 192, KM + (long)pair * TP * 192, VM + (long)pair * TP * 128, 64 + qb * 256,
                Y + (long)seq * SEQ * 2048 + head * 128, Z + (long)seq * TP * 2048 + head * 128, lds);
    }
  } else {
    for (int item = b; item < 64 * 16; item += gridDim.x) {
      const int pair = item >> 4, qb = item & 15; const int seq = pair >> 4, head = pair & 15;
      attn_item(QM + (long)pair * TP * 192, KM + (long)pair * TP * 192, VM + (long)pair * TP * 128, 64 + qb * 256,
                Y + (long)seq * SEQ * 2048 + head * 128, Z + (long)seq * TP * 2048 + head * 128, lds);
    }
  }
}

#define XB_TMO      128
#define XB_XCNT(j)  (256  + 64 * (j))
#define XB_XSUB(j)  (1280 + 64 * (j))
#define XB_XGEN(j)  (2304 + 64 * (j))
#define XB_TOP      3328
#define XB_TOPGEN   3392
#define XCD_BAR_WORDS 3456
#define XB_SPIN_CAP (1u << 18)
#define LAS __attribute__((address_space(3)))
DI unsigned xb_ld(unsigned* p)              { return __hip_atomic_load(p, __ATOMIC_RELAXED, __HIP_MEMORY_SCOPE_AGENT); }
DI unsigned xb_add(unsigned* p, unsigned v) { return __hip_atomic_fetch_add(p, v, __ATOMIC_RELAXED, __HIP_MEMORY_SCOPE_AGENT); }
DI unsigned xb_xcc_id() { return (unsigned)__builtin_amdgcn_s_getreg((3 << 11) | 20) & 0xFu; }
#define XB_SPIN(cond, bar) do { unsigned _sp = 0; while (cond) { __builtin_amdgcn_s_sleep(1); \
    if ((++_sp & 255u) == 0u) { if (xb_ld(&(bar)[XB_TMO])) break; if (_sp > XB_SPIN_CAP) { atomicAdd(&(bar)[XB_TMO], 1u); break; } } } } while (0)
struct XcdBarrier { unsigned* bar; unsigned x; volatile LAS unsigned* st; };
DI XcdBarrier xcd_barrier_post(unsigned* bar, volatile LAS unsigned* st) {
  XcdBarrier b; b.bar = bar; b.x = xb_xcc_id(); b.st = st;
  if (__builtin_amdgcn_workitem_id_x() == 0) (void)xb_add(&bar[XB_XCNT(b.x)], 1u);
  return b;
}
DI void xcd_barrier_complete(unsigned* bar, unsigned x, unsigned& nloc, unsigned& nx) {
  const unsigned G = gridDim.x * gridDim.y * gridDim.z;
  unsigned sum, cnt, mine, sp = 0u;
  for (;;) {
    sum = 0u; cnt = 0u; mine = 0u;
#pragma unroll
    for (unsigned j = 0; j < 16; ++j) { const unsigned c = xb_ld(&bar[XB_XCNT(j)]); sum += c; cnt += (c > 0u) ? 1u : 0u; mine = (j == x) ? c : mine; }
    if (sum == G) break;
    __builtin_amdgcn_s_sleep(1);
    if ((++sp & 255u) == 0u) { if (xb_ld(&bar[XB_TMO])) break; if (sp > XB_SPIN_CAP) { atomicAdd(&bar[XB_TMO], 1u); break; } }
  }
  nloc = mine > 0u ? mine : 1u; nx = cnt > 0u ? cnt : 1u;
}
DI void xcd_barrier(const XcdBarrier& b) {
  asm volatile("s_waitcnt vmcnt(0)" ::: "memory");
  __syncthreads();
  if (__builtin_amdgcn_workitem_id_x() == 0) {
    unsigned* bar = b.bar;
    __builtin_amdgcn_s_waitcnt(0);
    unsigned nloc = b.st[0], nx = b.st[1];
    if (nloc == 0u) { xcd_barrier_complete(bar, b.x, nloc, nx); b.st[0] = nloc; b.st[1] = nx; }
    const unsigned old = xb_add(&bar[XB_XSUB(b.x)], 1u);
    const unsigned gen = old / nloc;
    if (old + 1u == (gen + 1u) * nloc) {
      __builtin_amdgcn_fence(__ATOMIC_RELEASE, "agent");
      asm volatile("s_waitcnt vmcnt(0)" ::: "memory");
      const unsigned og = xb_add(&bar[XB_TOP], 1u);
      const unsigned tg = og / nx;
      if (og + 1u == (tg + 1u) * nx) xb_add(&bar[XB_TOPGEN], 1u);
      else XB_SPIN(xb_ld(&bar[XB_TOPGEN]) == tg, bar);
      __builtin_amdgcn_fence(__ATOMIC_ACQUIRE, "agent");
      xb_add(&bar[XB_XGEN(b.x)], 1u);
      asm volatile("s_waitcnt vmcnt(0)" ::: "memory");
    } else {
      XB_SPIN(xb_ld(&bar[XB_XGEN(b.x)]) == gen, bar);
      __builtin_amdgcn_fence(__ATOMIC_ACQUIRE, "agent");
      asm volatile("s_waitcnt vmcnt(0)" ::: "memory");
    }
  }
  __syncthreads();
}

__global__ void __launch_bounds__(512) fwd_mega(Params p) {
  extern __shared__ __attribute__((aligned(16))) char lds[];
  cg::grid_group grid = cg::this_grid();
  char* ws = p.ws;
  unsigned* barw = (unsigned*)(ws + OFF_BAR);
  if (blockIdx.x == 0) for (int i = otid(); i < XCD_BAR_WORDS + 256; i += 512) barw[i] = 0u;
  volatile LAS unsigned* xst = (volatile LAS unsigned*)(lds + LDS_BYTES - 16);
  if (otid() == 0) { xst[0] = 0u; xst[1] = 0u; }
  grid.sync();
  const XcdBarrier xb = xcd_barrier_post(barw, xst);
  if (otid() == 0) { const unsigned xc = xb_xcc_id(); xst[2] = xb_add(&barw[XCD_BAR_WORDS + 16 * xc], 1u); xst[3] = blockIdx.x; }
  phase_prep(p, lds);
  for (int g = 0; g < NGRP; ++g) {
    if (g == 0) { phase_hn(p, 0, 0); xcd_barrier(xb); }
    if (g == 0) {
      if (otid() == 0) { const unsigned xc = xb_xcc_id(); unsigned base = 0;
        for (unsigned j = 0; j < 16; ++j) { const unsigned c = xb_ld(&barw[XCD_BAR_WORDS + 16 * j]); base += (j < xc) ? c : 0u; }
        xst[3] = base + xst[2]; }
      __syncthreads();
    }
    { pg8::StaticOrder so; so.init(GR, 6400, (int)gridDim.x, (gridDim.x == 256) ? ((vbid(lds) & 31) * 8 + (vbid(lds) >> 5)) : (int)blockIdx.x);
      pg8::EpiGinT e{(u16*)(ws + OFF_P), (u16*)(ws + OFF_HALO), (u16*)(ws + OFF_Z), (float*)(ws + OFF_BA)};
      pg8::gemm_phase<pg8::EpiGinT, pg8::StaticOrder, false>((PG8_LAS unsigned char*)lds, pg8::Gemm{(const u16*)(ws + OFF_HN), (const u16*)(ws + OFF_WGIN), GR, 6400, 1024}, so, e, nullptr); }
    xcd_barrier(xb);
    phase_chunk(p, lds);
    xcd_barrier(xb);
    for (int rep = 0; rep < REP_SCAN; ++rep) phase_scan(p, lds);
    xcd_barrier(xb);
    phase_gate(p);
    xcd_barrier(xb);
    { pg8::StaticOrder so; so.init(GR, 1024, (int)gridDim.x, (gridDim.x == 256) ? ((vbid(lds) & 31) * 8 + (vbid(lds) >> 5)) : (int)blockIdx.x);
      pg8::EpiGoutT e{p, g, (float*)(ws + OFF_H1M)};
      pg8::gemm_phase<pg8::EpiGoutT, pg8::StaticOrder, false>((PG8_LAS unsigned char*)lds, pg8::Gemm{(const u16*)(ws + OFF_OF), (const u16*)(ws + OFF_WGOUT), GR, 1024, 2048}, so, e, nullptr); }
    xcd_barrier(xb);
    phase_hn(p, g, 1);
    xcd_barrier(xb);
    { pg8::StaticOrder so; so.init(GR, 3072, (int)gridDim.x, (gridDim.x == 256) ? ((vbid(lds) & 31) * 8 + (vbid(lds) >> 5)) : (int)blockIdx.x);
      pg8::EpiMinT e{(u16*)(ws + OFF_CQ), (u16*)(ws + OFF_CKV), (u16*)(ws + OFF_Z), (float*)(ws + OFF_KPE)};
      pg8::gemm_phase<pg8::EpiMinT, pg8::StaticOrder, false>((PG8_LAS unsigned char*)lds, pg8::Gemm{(const u16*)(ws + OFF_HN), (const u16*)(ws + OFF_WMIN), GR, 3072, 1024}, so, e, nullptr); }
    xcd_barrier(xb);
    phase_rowstats(p);
    xcd_barrier(xb);
    { EpiQ e{(const float*)(ws + OFF_ROWST), p.m_qg, (const float*)(ws + OFF_ROPE), (u16*)(ws + OFF_QM)};
      for (int rep = 0; rep < REP_GEMM; ++rep) gemm_phase<8, 1, 1, 6>((const u16*)(ws + OFF_CQ), 512, (const u16*)(ws + OFF_WUQ), 512, 512, 3072, lds, e); }
    { EpiKV e{(const float*)(ws + OFF_ROWST), p.m_kg, (const float*)(ws + OFF_KPER), (u16*)(ws + OFF_KM), (u16*)(ws + OFF_VM)};
      for (int rep = 0; rep < REP_GEMM; ++rep) gemm_phase<8, 1, 1, 4>((const u16*)(ws + OFF_CKV), 256, (const u16*)(ws + OFF_WUKV), 256, 256, 4096, lds, e); }
    xcd_barrier(xb);
    for (int rep = 0; rep < REP_ATTN; ++rep) phase_attn(p, lds);
    xcd_barrier(xb);
    { pg8::StaticOrder so; so.init(GS * SEQ, 1024, (int)gridDim.x, (gridDim.x == 256) ? ((vbid(lds) & 31) * 8 + (vbid(lds) >> 5)) : (int)blockIdx.x);
      pg8::EpiMoutT e{p.out, g};
      pg8::gemm_phase<pg8::EpiMoutT, pg8::StaticOrder, false>((PG8_LAS unsigned char*)lds, pg8::Gemm{(const u16*)(ws + OFF_Y), (const u16*)(ws + OFF_WMOUT), GS * SEQ, 1024, 2048}, so, e, nullptr); }
    if (g + 1 < NGRP) phase_hn(p, g + 1, 0);
    xcd_barrier(xb);
  }
}

extern "C" void kernel_launch(void* const* d_in, const int* in_sizes, int n_in,
                              void* d_out, int out_size, void* d_ws, size_t ws_size,
                              hipStream_t stream) {
  static int grid_blocks = 0;
  if (!grid_blocks) {
    int dev = 0, cus = 0, per_cu = 0;
    (void)hipGetDevice(&dev);
    (void)hipDeviceGetAttribute(&cus, hipDeviceAttributeMultiprocessorCount, dev);
    (void)hipFuncSetAttribute((const void*)fwd_mega, hipFuncAttributeMaxDynamicSharedMemorySize, LDS_BYTES);
    (void)hipOccupancyMaxActiveBlocksPerMultiprocessor(&per_cu, fwd_mega, 512, LDS_BYTES);
    if (per_cu < 1) { fprintf(stderr, "occupancy query returned %d\n", per_cu); per_cu = 1; }
    if (per_cu > 1) per_cu = 1;
    grid_blocks = cus * per_cu;
  }
  if (ws_size < WS_NEED) { fprintf(stderr, "workspace too small: %zu < %zu\n", ws_size, (size_t)WS_NEED); return; }
  Params p{};
  p.xp = (const float*)d_in[0]; p.xs = (const float*)d_in[1]; p.meta = (const float*)d_in[2]; p.ln_g = (const float*)d_in[3];
  p.g_win = (const float*)d_in[4]; p.g_conv = (const float*)d_in[5]; p.g_alog = (const float*)d_in[6]; p.g_dtb = (const float*)d_in[7];
  p.g_onorm = (const float*)d_in[8]; p.g_wout = (const float*)d_in[9]; p.m_win = (const float*)d_in[10]; p.m_qn = (const float*)d_in[11];
  p.m_kvn = (const float*)d_in[12]; p.m_wuq = (const float*)d_in[13]; p.m_wukv = (const float*)d_in[14]; p.m_qg = (const float*)d_in[15];
  p.m_kg = (const float*)d_in[16]; p.m_wout = (const float*)d_in[17]; p.out = (float*)d_out; p.ws = (char*)d_ws;
  void* args[] = {&p};
  hipError_t e = hipLaunchCooperativeKernel((void*)fwd_mega, dim3(grid_blocks), dim3(512), args, LDS_BYTES, stream);
  if (e != hipSuccess) fprintf(stderr, "cooperative launch failed: %s (grid %d)\n", hipGetErrorString(e), grid_blocks);
}
```
